# Optimizing an MI355X kernel written in HIP

```python
import jax, jax.numpy as jnp
from jax import lax
import numpy as np

D_MODEL = 1024
BATCH = 8
SEQ = 2048
DEPTH = 1
DEC_BATCH = 128
DEC_SEQ = 4
PAST_LEN = 16384
PAGE_SIZE = 128

HGRN_HEADS = 8
HGRN_DK = 128
HGRN_DV = 128
HGRN_FDIM = HGRN_HEADS * HGRN_DK
HGRN_WIDTH = HGRN_HEADS * HGRN_DV
MLSTM_HEADS = 4
MLSTM_DH = 256
MLSTM_WIDTH = MLSTM_HEADS * MLSTM_DH
D_MIX = HGRN_WIDTH + MLSTM_WIDTH
CONV_WIDTH = 4
QKV_BLOCK = 4
CHUNK = 64
EPS = 1e-6
IN_SIZES = (HGRN_FDIM, HGRN_FDIM, HGRN_WIDTH, HGRN_WIDTH, MLSTM_WIDTH, MLSTM_WIDTH, MLSTM_WIDTH, MLSTM_HEADS, MLSTM_HEADS)
W_IN_COLS = sum(IN_SIZES)
SPLIT_IDX = tuple(int(s) for s in np.cumsum(IN_SIZES)[:-1])
FGATE_OFFSET = W_IN_COLS - MLSTM_HEADS

kernel_name = "hymba_hgrn2_mlstm_adaln_step"

F32 = jnp.float32


def _rms(x, g):
    xf = x.astype(F32)
    y = xf * lax.rsqrt(jnp.mean(xf * xf, -1, keepdims=True) + EPS)
    return (y * g.astype(F32)).astype(x.dtype)


def _head_rms(h, g):
    B, T, H, D = h.shape
    y = h * lax.rsqrt(jnp.mean(h * h, -1, keepdims=True) + EPS)
    return y.reshape(B, T, H * D) * g.astype(F32)


def _to_chunks(a, chunk):
    B, T = a.shape[:2]
    return a.reshape((B, T // chunk, chunk) + a.shape[2:]).swapaxes(0, 1)


def _from_chunks(a):
    n, B, L = a.shape[:3]
    return a.swapaxes(0, 1).reshape((B, n * L) + a.shape[3:])


def _hgrn2(q, logf, v, S0, chunk):
    k = -jnp.expm1(logf)
    L = chunk
    causal = jnp.tril(jnp.ones((L, L), bool))

    def step(S, inp):
        qc, lfc, kc, vc = inp
        G = jnp.cumsum(lfc, axis=1)
        diff = G[:, :, None] - G[:, None, :]
        decay = jnp.where(causal[None, :, :, None, None], jnp.exp(jnp.minimum(diff, 0.0)), 0.0)
        A = jnp.einsum('bthk,btjhk,bjhk->bhtj', qc, decay, kc)
        o_intra = jnp.einsum('bhtj,bjhv->bthv', A, vc)
        o_inter = jnp.einsum('bthk,bhkv->bthv', qc * jnp.exp(G), S)
        GL = G[:, -1]
        kdec = kc * jnp.exp(GL[:, None] - G)
        S_new = jnp.exp(GL)[..., None] * S + jnp.einsum('bjhk,bjhv->bhkv', kdec, vc)
        return S_new, o_intra + o_inter

    S_fin, o = lax.scan(step, S0, (_to_chunks(q, L), _to_chunks(logf, L), _to_chunks(k, L), _to_chunks(v, L)))
    return _from_chunks(o), S_fin


def _mlstm(q, k, v, ig, logf, C0, n0, m0, chunk):
    L = chunk
    causal = jnp.tril(jnp.ones((L, L), bool))

    def step(carry, inp):
        C, nv, m = carry
        qc, kc, vc, ic, fc = inp
        b = jnp.cumsum(fc, axis=1)
        logD = b[:, :, None, :] - b[:, None, :, :] + ic[:, None, :, :]
        logD = jnp.where(causal[None, :, :, None], logD, -jnp.inf)
        m_inter = b + m[:, None, :]
        m_t = jnp.maximum(m_inter, jnp.max(logD, axis=2))
        Dm = jnp.exp(logD - m_t[:, :, None, :])
        inter = jnp.exp(m_inter - m_t)
        s = jnp.einsum('bthd,bjhd->btjh', qc, kc) * Dm
        num = inter[..., None] * jnp.einsum('bthk,bhkv->bthv', qc, C) + jnp.einsum('btjh,bjhv->bthv', s, vc)
        den = inter * jnp.einsum('bthk,bhk->bth', qc, nv) + jnp.sum(s, axis=2)
        h = num / jnp.maximum(jnp.abs(den), jnp.exp(-m_t))[..., None]
        m_new = m_t[:, -1]
        wC = jnp.exp(b[:, -1:] - b + ic - m_new[:, None])
        dec = jnp.exp(b[:, -1] + m - m_new)
        C_new = dec[..., None, None] * C + jnp.einsum('bjh,bjhk,bjhv->bhkv', wC, kc, vc)
        n_new = dec[..., None] * nv + jnp.einsum('bjh,bjhk->bhk', wC, kc)
        return (C_new, n_new, m_new), h

    (C, nv, m), h = lax.scan(step, (C0, n0, m0), (_to_chunks(q, L), _to_chunks(k, L), _to_chunks(v, L), _to_chunks(ig, L), _to_chunks(logf, L)))
    return _from_chunks(h), C, nv, m


def _blockdiag(x, w):
    B, T, W = x.shape
    xb = x.reshape(B, T, W // QKV_BLOCK, QKV_BLOCK)
    return jnp.einsum('btgi,gij->btgj', xb, w).reshape(B, T, W)


def _layer(x, c, S_h, C_m, n_m, m_m, buf, chunk, lb, w_ada, b_ada, norm_g, w_in, b_in, hgrn_norm_g,
           conv_w, conv_b, wq, wk, wv, mnorm_g, skip, w_out):
    B, T, _ = x.shape
    mod = jnp.dot(jax.nn.silu(c), w_ada) + b_ada
    shift, scale, gate = jnp.split(mod, 3, axis=-1)
    h = _rms(x, norm_g) * (1 + scale[:, None]) + shift[:, None]
    proj = jnp.dot(h, w_in) + b_in
    hq, hf, hi, hz, mu, mz, mo, mi, mf = jnp.split(proj, SPLIT_IDX, axis=-1)

    f = lb + (1.0 - lb) * jax.nn.sigmoid(hf.astype(F32))
    logf = jnp.log(f).reshape(B, T, HGRN_HEADS, HGRN_DK)
    qh = hq.astype(F32).reshape(B, T, HGRN_HEADS, HGRN_DK)
    vh = hi.astype(F32).reshape(B, T, HGRN_HEADS, HGRN_DV)
    o_h, S_new = _hgrn2(qh, logf, vh, S_h.astype(F32), chunk)
    y_h = _head_rms(o_h, hgrn_norm_g) * jax.nn.silu(hz.astype(F32))

    ext = jnp.concatenate([buf.astype(mu.dtype), mu], axis=1)
    new_buf = ext[:, -(CONV_WIDTH - 1):]
    conv = lax.conv_general_dilated(ext, conv_w[:, None, :].astype(mu.dtype), (1,), 'VALID',
                                    dimension_numbers=('NWC', 'WIO', 'NWC'),
                                    feature_group_count=MLSTM_WIDTH) + conv_b
    xc = jax.nn.silu(conv)
    q = _blockdiag(xc, wq).astype(F32).reshape(B, T, MLSTM_HEADS, MLSTM_DH)
    k = (_blockdiag(xc, wk).astype(F32) * (MLSTM_DH ** -0.5)).reshape(B, T, MLSTM_HEADS, MLSTM_DH)
    v = _blockdiag(mu, wv).astype(F32).reshape(B, T, MLSTM_HEADS, MLSTM_DH)
    ig = mi.astype(F32)
    lfm = jax.nn.log_sigmoid(mf.astype(F32))
    h_m, C_new, n_new, m_new = _mlstm(q, k, v, ig, lfm, C_m.astype(F32), n_m.astype(F32), m_m.astype(F32), chunk)
    h_m = jax.nn.sigmoid(mo.astype(F32)).reshape(B, T, MLSTM_HEADS, MLSTM_DH) * h_m
    y_m = (_head_rms(h_m, mnorm_g) + skip.astype(F32) * xc.astype(F32)) * jax.nn.silu(mz.astype(F32))

    mix = jnp.concatenate([y_h, y_m], axis=-1).astype(x.dtype)
    out = x + gate[:, None] * jnp.dot(mix, w_out)
    return out, (S_new, C_new, n_new, m_new, new_buf)


def setup_inputs(seed: int = 0) -> dict:
    key = jax.random.key(seed)
    ks = jax.random.split(key, 32)
    nrm = jax.random.normal
    d = {}
    d['x_prompt'] = nrm(ks[0], (BATCH, SEQ, D_MODEL), F32)
    d['x_sample'] = nrm(ks[1], (DEC_BATCH, DEC_SEQ, D_MODEL), F32)
    d['c_prompt'] = nrm(ks[2], (BATCH, D_MODEL), F32)
    d['c_sample'] = nrm(ks[3], (DEC_BATCH, D_MODEL), F32)
    d['state_hgrn'] = 0.5 * nrm(ks[4], (DEPTH, DEC_BATCH, HGRN_HEADS, HGRN_DK, HGRN_DV), F32)
    d['state_mlstm_C'] = 0.1 * nrm(ks[5], (DEPTH, DEC_BATCH, MLSTM_HEADS, MLSTM_DH, MLSTM_DH), F32)
    d['state_mlstm_n'] = 0.5 * nrm(ks[6], (DEPTH, DEC_BATCH, MLSTM_HEADS, MLSTM_DH), F32)
    d['state_mlstm_m'] = 0.5 * nrm(ks[7], (DEPTH, DEC_BATCH, MLSTM_HEADS), F32)
    d['state_mlstm_conv'] = nrm(ks[8], (DEPTH, DEC_BATCH, CONV_WIDTH - 1, MLSTM_WIDTH), F32)
    d['w_ada'] = 0.5 * (D_MODEL ** -0.5) * nrm(ks[9], (DEPTH, D_MODEL, 3 * D_MODEL), F32)
    d['b_ada'] = 0.01 * nrm(ks[10], (DEPTH, 3 * D_MODEL), F32)
    d['norm_g'] = 1.0 + 0.01 * nrm(ks[11], (DEPTH, D_MODEL), F32)
    d['w_in'] = (D_MODEL ** -0.5) * nrm(ks[12], (DEPTH, D_MODEL, W_IN_COLS), F32)
    b_in = 0.01 * nrm(ks[13], (DEPTH, W_IN_COLS), F32)
    d['b_in'] = b_in.at[:, FGATE_OFFSET:].add(jnp.linspace(3.0, 6.0, MLSTM_HEADS, dtype=F32))
    d['hgrn_lb_logits'] = 0.1 * nrm(ks[14], (DEPTH + 1, HGRN_FDIM), F32)
    d['hgrn_norm_g'] = 1.0 + 0.01 * nrm(ks[15], (DEPTH, HGRN_WIDTH), F32)
    d['mlstm_conv_w'] = (CONV_WIDTH ** -0.5) * nrm(ks[16], (DEPTH, CONV_WIDTH, MLSTM_WIDTH), F32)
    d['mlstm_conv_b'] = 0.01 * nrm(ks[17], (DEPTH, MLSTM_WIDTH), F32)
    nb = MLSTM_WIDTH // QKV_BLOCK
    d['mlstm_wq'] = (QKV_BLOCK ** -0.5) * nrm(ks[18], (DEPTH, nb, QKV_BLOCK, QKV_BLOCK), F32)
    d['mlstm_wk'] = (QKV_BLOCK ** -0.5) * nrm(ks[19], (DEPTH, nb, QKV_BLOCK, QKV_BLOCK), F32)
    d['mlstm_wv'] = (QKV_BLOCK ** -0.5) * nrm(ks[20], (DEPTH, nb, QKV_BLOCK, QKV_BLOCK), F32)
    d['mlstm_norm_g'] = 1.0 + 0.01 * nrm(ks[21], (DEPTH, MLSTM_WIDTH), F32)
    d['mlstm_skip'] = 1.0 + 0.01 * nrm(ks[22], (DEPTH, MLSTM_WIDTH), F32)
    d['w_out'] = (D_MIX ** -0.5) * nrm(ks[23], (DEPTH, D_MIX, D_MODEL), F32)
    d['final_g'] = 1.0 + 0.01 * nrm(ks[24], (D_MODEL,), F32)
    return d


def reference(x_prompt, x_sample, c_prompt, c_sample, state_hgrn, state_mlstm_C, state_mlstm_n,
              state_mlstm_m, state_mlstm_conv, w_ada, b_ada, norm_g, w_in, b_in, hgrn_lb_logits,
              hgrn_norm_g, mlstm_conv_w, mlstm_conv_b, mlstm_wq, mlstm_wk, mlstm_wv, mlstm_norm_g,
              mlstm_skip, w_out, final_g):
    lb_all = jnp.cumsum(jax.nn.softmax(hgrn_lb_logits.astype(F32), axis=0), axis=0)
    xp, xs = x_prompt, x_sample
    Bp, Tp = xp.shape[0], xp.shape[1]
    Ts = xs.shape[1]
    chunk_p = CHUNK if Tp % CHUNK == 0 else Tp
    sp_all = [[], [], [], [], []]
    ss_all = [[], [], [], [], []]
    for l in range(DEPTH):
        wts = (lb_all[l], w_ada[l], b_ada[l], norm_g[l], w_in[l], b_in[l], hgrn_norm_g[l],
               mlstm_conv_w[l], mlstm_conv_b[l], mlstm_wq[l], mlstm_wk[l], mlstm_wv[l],
               mlstm_norm_g[l], mlstm_skip[l], w_out[l])
        zS = jnp.zeros((Bp, HGRN_HEADS, HGRN_DK, HGRN_DV), F32)
        zC = jnp.zeros((Bp, MLSTM_HEADS, MLSTM_DH, MLSTM_DH), F32)
        zn = jnp.zeros((Bp, MLSTM_HEADS, MLSTM_DH), F32)
        zm = jnp.zeros((Bp, MLSTM_HEADS), F32)
        zb = jnp.zeros((Bp, CONV_WIDTH - 1, MLSTM_WIDTH), xp.dtype)
        xp, sp = _layer(xp, c_prompt, zS, zC, zn, zm, zb, chunk_p, *wts)
        xs, ss = _layer(xs, c_sample, state_hgrn[l], state_mlstm_C[l], state_mlstm_n[l],
                        state_mlstm_m[l], state_mlstm_conv[l], Ts, *wts)
        for i in range(5):
            sp_all[i].append(sp[i])
            ss_all[i].append(ss[i])
    y_prompt = _rms(xp, final_g)
    y_sample = _rms(xs, final_g)
    hgrn_p = jnp.stack(sp_all[0]); C_p = jnp.stack(sp_all[1]); n_p = jnp.stack(sp_all[2])
    m_p = jnp.stack(sp_all[3]); conv_p = jnp.stack(sp_all[4])
    hgrn_s = jnp.stack(ss_all[0]); C_s = jnp.stack(ss_all[1]); n_s = jnp.stack(ss_all[2])
    m_s = jnp.stack(ss_all[3]); conv_s = jnp.stack(ss_all[4])
    return (y_prompt, y_sample, hgrn_p, C_p, n_p, m_p, conv_p, hgrn_s, C_s, n_s, m_s, conv_s)
```

```cpp
#include <hip/hip_runtime.h>
#include <cstdio>
#include <cstdint>

#define LAS __attribute__((address_space(3)))
typedef unsigned short bf16_t;
typedef short bf16x8 __attribute__((ext_vector_type(8)));
typedef short s16x4 __attribute__((ext_vector_type(4)));
typedef float f32x4 __attribute__((ext_vector_type(4)));
typedef float f32x16 __attribute__((ext_vector_type(16)));
typedef unsigned u32x4 __attribute__((ext_vector_type(4)));
typedef unsigned u32x2 __attribute__((ext_vector_type(2)));

namespace pg8 {
constexpr int BM = 256, BK = 64, HALF = 128, HTB = HALF * BK * 2, STAGE_BYTES = 8 * HTB, NXCD = 8, WGM = 8;
__host__ __device__ __forceinline__ int lds_byte(int r, int c) { const int st = (r >> 4) * 2 + (c >> 5), rr = r & 15, cc = c & 31, ob = rr * 64 + cc * 2; return st * 1024 + (ob ^ (((ob >> 9) & 1) << 5)); }
__host__ __device__ __forceinline__ void stage_rc(int b, int& R, int& C) { const int st = b / 1024, sb = b % 1024, swz = sb ^ (((sb >> 9) & 1) << 5); R = (st >> 1) * 16 + swz / 64; C = (st & 1) * 32 + (swz % 64) / 2; }
__host__ __device__ __forceinline__ int perm32(int rho) { const int n = rho >> 4, i = rho & 15; return 8 * (i >> 2) + 4 * n + (i & 3); }
struct Unit { int pm, pn; };
struct Gemm { const bf16_t* A; const bf16_t* Bt; int M, N, K; };
struct StaticOrder {
    int nM, nN, nwg, G, c;
    __host__ __device__ void init(int M, int N, int G_, int c_) { nM = M / BM; nN = N / BM; nwg = nM * nN; G = G_; c = c_; }
    __host__ __device__ bool next(int i, Unit& u) const {
        const long L = (long)i * G + c; if (L >= nwg) return false;
        int wgid = (int)L; { const int q = nwg / NXCD, r = nwg % NXCD, xcd = wgid % NXCD, off = wgid / NXCD; wgid = (xcd < r ? xcd * (q + 1) : r * (q + 1) + (xcd - r) * q) + off; }
        const int nig = WGM * nN, gid = wgid / nig, fm = gid * WGM, gsz = (nM - fm) < WGM ? (nM - fm) : WGM;
        u.pm = fm + ((wgid % nig) % gsz); u.pn = (wgid % nig) / gsz; return true;
    }
};
template <class Epi, class Sched, bool ALIGN_EPI = false, bool SP2 = false>
__device__ __forceinline__ void gemm_phase(LAS unsigned char* lds, const Gemm g, const Sched& S, const Epi& E) {
    const int tid = threadIdx.x, wid = __builtin_amdgcn_readfirstlane(tid >> 6), lane = tid & 63, wr = wid >> 2, wc = wid & 3, fr = lane & 15, fq = lane >> 4;
    const int K = g.K, nt = K / BK;
    unsigned voffA[2], voffB[2];
#pragma unroll
    for (int i = 0; i < 2; ++i) { int R, C; stage_rc(tid * 16 + i * 8192, R, C); const int Rb = Epi::PERM ? ((R & ~31) + perm32(R & 31)) : R;
        voffA[i] = (unsigned)(R * K + C) * 2u; voffB[i] = (unsigned)(Rb * K + C) * 2u; }
    const size_t kstep = (size_t)(BK * 2);
    const size_t hstep = (size_t)HALF * K * 2;
    const size_t tstep = 2 * hstep;
    const unsigned ldsw = (unsigned)wid * 1024u;
    const int aoff = lds_byte(wr * 64 + fr, fq * 8), boff = lds_byte(wc * 32 + fr, fq * 8);
#define PG8_SA(b, h) (((b) * 2 + (h)) * HTB)
#define PG8_SB(b, h) ((4 + (b) * 2 + (h)) * HTB)
#define PG8_STAGE(bufoff, gbase, voff) do { _Pragma("unroll") for (int _i = 0; _i < 2; ++_i) \
        __builtin_amdgcn_global_load_lds((const unsigned*)((const char*)(gbase) + (voff)[_i]), (LAS unsigned*)(lds + (bufoff) + ldsw + _i * 8192), 16, 0, 0); } while (0)
#define PG8_LDA(dst, b, h) do { _Pragma("unroll") for (int m = 0; m < 4; ++m) _Pragma("unroll") for (int k = 0; k < 2; ++k) dst[m][k] = *(const LAS bf16x8*)(lds + PG8_SA(b, h) + aoff + m * 2048 + k * 1024); } while (0)
#define PG8_LDB(dst, b, h) do { _Pragma("unroll") for (int n = 0; n < 2; ++n) _Pragma("unroll") for (int k = 0; k < 2; ++k) dst[n][k] = *(const LAS bf16x8*)(lds + PG8_SB(b, h) + boff + n * 2048 + k * 1024); } while (0)
#define PG8_MMA(ai, bj, At, Bt) do { __builtin_amdgcn_s_setprio(1); _Pragma("unroll") for (int m = 0; m < 4; ++m) _Pragma("unroll") for (int n = 0; n < 2; ++n) _Pragma("unroll") for (int k = 0; k < 2; ++k) \
        acc[ai][bj][m][n] = __builtin_amdgcn_mfma_f32_16x16x32_bf16(Bt[n][k], At[m][k], acc[ai][bj][m][n], 0, 0, 0); __builtin_amdgcn_s_setprio(0); } while (0)
#define PG8_WAIT_V(n) asm volatile("s_waitcnt vmcnt(" #n ")" ::: "memory")
#define PG8_WAIT_L(n) asm volatile("s_waitcnt lgkmcnt(" #n ")" ::: "memory")
#define PG8_BAR __builtin_amdgcn_s_barrier()
#define PG8_SCHED __builtin_amdgcn_sched_barrier(0)
    Unit cur, nxt; int ui = 0;
    if (!S.next(0, cur)) return;
    f32x4 acc[2][2][4][2];
#pragma unroll
    for (int a = 0; a < 2; ++a)
#pragma unroll
        for (int b = 0; b < 2; ++b)
#pragma unroll
            for (int m = 0; m < 4; ++m)
#pragma unroll
                for (int n = 0; n < 2; ++n) acc[a][b][m][n] = (f32x4){0.f, 0.f, 0.f, 0.f};
    bf16x8 At[4][2], B0[2][2], B1[2][2];
    const char* cA = (const char*)g.A + (size_t)cur.pm * tstep; const char* cB = (const char*)g.Bt + (size_t)cur.pn * tstep;
    if constexpr (SP2) {
        PG8_STAGE(PG8_SB(0, 0), cB, voffB); PG8_STAGE(PG8_SB(0, 1), cB + hstep, voffB); PG8_STAGE(PG8_SA(0, 0), cA, voffA); PG8_STAGE(PG8_SA(0, 1), cA + hstep, voffA);
        if (wr == 1) PG8_BAR;
        PG8_WAIT_V(2); PG8_BAR;
        PG8_STAGE(PG8_SB(1, 0), cB + kstep, voffB); PG8_STAGE(PG8_SA(1, 0), cA + kstep, voffA); PG8_STAGE(PG8_SB(1, 1), cB + hstep + kstep, voffB);
        PG8_WAIT_V(6); PG8_BAR;
    } else {
        PG8_STAGE(PG8_SB(0, 0), cB, voffB); PG8_STAGE(PG8_SA(0, 0), cA, voffA); PG8_STAGE(PG8_SB(0, 1), cB + hstep, voffB); PG8_STAGE(PG8_SA(0, 1), cA + hstep, voffA);
        if (wr == 1) PG8_BAR;
        PG8_WAIT_V(4); PG8_BAR;
        PG8_STAGE(PG8_SB(1, 0), cB + kstep, voffB); PG8_STAGE(PG8_SA(1, 0), cA + kstep, voffA); PG8_STAGE(PG8_SB(1, 1), cB + hstep + kstep, voffB);
        PG8_WAIT_V(6); PG8_BAR;
    }
    for (;;) {
        const bool has_next = S.next(ui + 1, nxt);
        const char* nA = has_next ? (const char*)g.A + (size_t)nxt.pm * tstep : cA; const char* nB = has_next ? (const char*)g.Bt + (size_t)nxt.pn * tstep : cB;
        for (int t = 0; t < nt; t += 2) {
            const bool last = (t == nt - 2);
            const char* a1 = cA + (size_t)(t + 1) * kstep;
            const char* a2 = last ? nA : cA + (size_t)(t + 2) * kstep; const char* b2 = last ? nB : cB + (size_t)(t + 2) * kstep;
            const char* a3 = a2 + kstep; const char* b3 = b2 + kstep;
            if constexpr (SP2) {
            PG8_LDB(B0, 0, 0); PG8_LDB(B1, 0, 1); PG8_SCHED; PG8_LDA(At, 0, 0); PG8_STAGE(PG8_SA(1, 1), a1 + hstep, voffA);
            PG8_WAIT_V(8); PG8_WAIT_L(0); PG8_BAR; PG8_MMA(0, 0, At, B0); PG8_MMA(0, 1, At, B1); PG8_BAR; PG8_SCHED;
            PG8_LDA(At, 0, 1); PG8_STAGE(PG8_SB(0, 0), b2, voffB); PG8_STAGE(PG8_SB(0, 1), b2 + hstep, voffB); PG8_STAGE(PG8_SA(0, 0), a2, voffA);
            PG8_WAIT_V(8); PG8_WAIT_L(0); PG8_BAR; PG8_MMA(1, 0, At, B0); PG8_MMA(1, 1, At, B1); PG8_BAR; PG8_SCHED;
            PG8_LDB(B0, 1, 0); PG8_LDB(B1, 1, 1); PG8_SCHED; PG8_LDA(At, 1, 0); PG8_STAGE(PG8_SA(0, 1), a2 + hstep, voffA);
            PG8_WAIT_V(8); PG8_WAIT_L(0); PG8_BAR; PG8_MMA(0, 0, At, B0); PG8_MMA(0, 1, At, B1); PG8_BAR; PG8_SCHED;
            PG8_LDA(At, 1, 1); PG8_STAGE(PG8_SB(1, 0), b3, voffB); PG8_STAGE(PG8_SB(1, 1), b3 + hstep, voffB); PG8_STAGE(PG8_SA(1, 0), a3, voffA);
            PG8_WAIT_V(8); PG8_WAIT_L(0); PG8_BAR; PG8_MMA(1, 0, At, B0); PG8_MMA(1, 1, At, B1); PG8_BAR; PG8_SCHED;
            } else {
            PG8_LDB(B0, 0, 0); PG8_SCHED; PG8_LDA(At, 0, 0); PG8_STAGE(PG8_SA(1, 1), a1 + hstep, voffA);
            PG8_WAIT_L(8); PG8_BAR; PG8_WAIT_L(0); PG8_MMA(0, 0, At, B0); PG8_BAR; PG8_SCHED;
            PG8_LDB(B1, 0, 1); PG8_STAGE(PG8_SB(0, 0), b2, voffB);
            PG8_BAR; PG8_WAIT_L(0); PG8_MMA(0, 1, At, B1); PG8_BAR;
            PG8_LDA(At, 0, 1); PG8_STAGE(PG8_SA(0, 0), a2, voffA);
            PG8_BAR; PG8_WAIT_L(0); PG8_MMA(1, 0, At, B0); PG8_BAR; PG8_SCHED;
            PG8_STAGE(PG8_SB(0, 1), b2 + hstep, voffB);
            PG8_WAIT_V(6); PG8_BAR; PG8_MMA(1, 1, At, B1); PG8_BAR;
            PG8_LDB(B0, 1, 0); PG8_SCHED; PG8_LDA(At, 1, 0); PG8_STAGE(PG8_SA(0, 1), a2 + hstep, voffA);
            PG8_WAIT_L(8); PG8_BAR; PG8_WAIT_L(0); PG8_MMA(0, 0, At, B0); PG8_BAR; PG8_SCHED;
            PG8_LDB(B1, 1, 1); PG8_STAGE(PG8_SB(1, 0), b3, voffB);
            PG8_BAR; PG8_WAIT_L(0); PG8_MMA(0, 1, At, B1); PG8_BAR;
            PG8_LDA(At, 1, 1); PG8_STAGE(PG8_SA(1, 0), a3, voffA);
            PG8_BAR; PG8_WAIT_L(0); PG8_MMA(1, 0, At, B0); PG8_BAR; PG8_SCHED;
            PG8_STAGE(PG8_SB(1, 1), b3 + hstep, voffB);
            PG8_WAIT_V(6); PG8_BAR; PG8_MMA(1, 1, At, B1); PG8_BAR;
            }
        }
        if constexpr (ALIGN_EPI) { if (wr == 0) PG8_BAR; }
        if constexpr (!Epi::AFTER_DRAIN) E(acc, cur, wr, wc, fr, fq);
        if (!has_next) break;
#pragma unroll
        for (int a = 0; a < 2; ++a)
#pragma unroll
            for (int b = 0; b < 2; ++b)
#pragma unroll
                for (int m = 0; m < 4; ++m)
#pragma unroll
                    for (int n = 0; n < 2; ++n) acc[a][b][m][n] = (f32x4){0.f, 0.f, 0.f, 0.f};
        cur = nxt; cA = nA; cB = nB; ++ui;
        if constexpr (ALIGN_EPI) { if (wr == 1) PG8_BAR; }
    }
    PG8_WAIT_V(0);
    if constexpr (!ALIGN_EPI) { if (wr == 0) PG8_BAR; }
    PG8_BAR;
    if constexpr (Epi::AFTER_DRAIN) E.fused(acc, cur, wr, wc, fr, fq, lds, wid, lane);
#undef PG8_SA
#undef PG8_SB
#undef PG8_STAGE
#undef PG8_LDA
#undef PG8_LDB
#undef PG8_MMA
#undef PG8_WAIT_V
#undef PG8_WAIT_L
#undef PG8_BAR
#undef PG8_SCHED
}
}

constexpr int NWAVES = 8, NTHR = 512;
constexpr int DM = 1024;
constexpr int BP = 8, TP = 2048, MP = BP * TP;
constexpr int BS = 128, TS = 4, MS = BS * TS;
constexpr int MT = MP + MS;
constexpr int NMOD = BP + BS;
constexpr int WIN_LD = 7176, NPROJ = 7168, DMIX = 2048;
constexpr int NCH = TP / 64;
constexpr float EPS = 1e-6f;

constexpr size_t SEGSZ = (size_t)MP * 1024;
constexpr size_t PS_OFF = 7 * SEGSZ;
__device__ __forceinline__ size_t hg_tile(int seg, int b, int c, int head) { return (size_t)seg * SEGSZ + ((size_t)((b * NCH + c) * 8 + head) << 13); }
__device__ __forceinline__ size_t ml_tile(int seg, int b, int c, int h) { return (size_t)seg * SEGSZ + ((size_t)((b * NCH + c) * 4 + h) << 14); }
constexpr size_t MiB = 1u << 20;
constexpr size_t WS_CTL = 0, CTL_ZERO_BYTES = 1 * MiB;
constexpr size_t WS_WIN = 2 * MiB;
constexpr size_t WS_WOUT = 16 * MiB;
constexpr size_t WS_MOD = 20 * MiB;
constexpr size_t WS_GATE = 22 * MiB;
constexpr size_t WS_DEC = 23 * MiB;
constexpr size_t WS_BT = 24 * MiB;
constexpr size_t WS_RS = 24 * MiB + 512 * 1024;
constexpr size_t WS_CSK = 25 * MiB;
constexpr size_t WS_RL = 26 * MiB;
constexpr size_t WS_GW = 26 * MiB + 64 * 1024;
constexpr size_t WS_LOGFS = 26 * MiB + 512 * 1024;
constexpr size_t WS_AH = 30 * MiB;
constexpr size_t WS_AM = 46 * MiB;
constexpr size_t WS_XN = 54 * MiB;
constexpr size_t WS_QM = WS_XN;
constexpr size_t WS_PROJ = 88 * MiB;
constexpr size_t WS_LOGF = 320 * MiB;
constexpr size_t WS_MIX = WS_LOGF;
constexpr size_t WS_KM = 388 * MiB, WS_VM = 420 * MiB, WS_XC = 452 * MiB;
constexpr size_t WS_END = 484 * MiB;
constexpr size_t O_Y = 0;
constexpr size_t O_HP = (size_t)MT * DM;
constexpr size_t O_CP = O_HP + (size_t)BP * 8 * 128 * 128;
constexpr size_t O_NP = O_CP + (size_t)BP * 4 * 256 * 256;
constexpr size_t O_MP = O_NP + (size_t)BP * 4 * 256;
constexpr size_t O_VP = O_MP + (size_t)BP * 4;
constexpr size_t O_HS = O_VP + (size_t)BP * 3 * 1024;
constexpr size_t O_CS = O_HS + (size_t)BS * 8 * 128 * 128;
constexpr size_t O_NS = O_CS + (size_t)BS * 4 * 256 * 256;
constexpr size_t O_MS = O_NS + (size_t)BS * 4 * 256;
constexpr size_t O_VS = O_MS + (size_t)BS * 4;
constexpr size_t O_END = O_VS + (size_t)BS * 3 * 1024;

constexpr int RING_BYTES = 131072, LDS_BYTES = 147456, MISC_OFF = LDS_BYTES - 1024;
constexpr int CW_BAR = 4096, CW_QUEUE = 2048, CW_PANEL = 8192, CW_SROW = 12288;

#define LDS_WAIT() asm volatile("s_waitcnt lgkmcnt(0)" ::: "memory")
__device__ __forceinline__ float bf2f(unsigned u16) { return __uint_as_float(u16 << 16); }
__device__ __forceinline__ float bflo(unsigned w) { return __uint_as_float(w << 16); }
__device__ __forceinline__ float bfhi(unsigned w) { return __uint_as_float(w & 0xffff0000u); }
typedef __bf16 bf16v2_t __attribute__((ext_vector_type(2)));
__device__ __forceinline__ unsigned pk2(float lo, float hi) { bf16v2_t v; v[0] = (__bf16)lo; v[1] = (__bf16)hi; return __builtin_bit_cast(unsigned, v); }
__device__ __forceinline__ bf16_t f2bf(float f) { return __builtin_bit_cast(bf16_t, (__bf16)f); }
__device__ __forceinline__ float wave_sum(float v) {
#pragma unroll
    for (int o = 1; o < 64; o <<= 1) v += __shfl_xor(v, o);
    return v;
}
__device__ __forceinline__ float sigmoidf_(float x) { return __builtin_amdgcn_rcpf(1.f + __expf(-x)); }

#define XB_TMO      128
#define XB_XCNT(j)  (256  + 64 * (j))
#define XB_XSUB(j)  (1280 + 64 * (j))
#define XB_XGEN(j)  (2304 + 64 * (j))
#define XB_TOP      3328
#define XB_TOPGEN   3392
#define XCD_BAR_WORDS 3456
#define XB_SPIN_CAP (1u << 18)
__device__ __forceinline__ unsigned xb_ld(unsigned* p)              { return __hip_atomic_load(p, __ATOMIC_RELAXED, __HIP_MEMORY_SCOPE_AGENT); }
__device__ __forceinline__ unsigned xb_add(unsigned* p, unsigned v) { return __hip_atomic_fetch_add(p, v, __ATOMIC_RELAXED, __HIP_MEMORY_SCOPE_AGENT); }
__device__ __forceinline__ unsigned xb_xcc_id() { return (unsigned)__builtin_amdgcn_s_getreg((3 << 11) | 20) & 0xFu; }
#define XB_SPIN(cond, bar) do { unsigned _sp = 0; while (cond) { __builtin_amdgcn_s_sleep(1); \
    if ((++_sp & 255u) == 0u) { if (xb_ld(&(bar)[XB_TMO])) break; if (_sp > XB_SPIN_CAP) { atomicAdd(&(bar)[XB_TMO], 1u); break; } } } } while (0)
struct XcdBarrier { unsigned* bar; unsigned x; volatile LAS unsigned* st; };
__device__ __forceinline__ XcdBarrier xcd_barrier_post(unsigned* bar, volatile LAS unsigned* st) {
    XcdBarrier b; b.bar = bar; b.x = xb_xcc_id(); b.st = st;
    if (threadIdx.x == 0) (void)xb_add(&bar[XB_XCNT(b.x)], 1u);
    return b;
}
__device__ __forceinline__ void xcd_barrier_complete(unsigned* bar, unsigned x, unsigned& nloc, unsigned& nx) {
    const unsigned G = gridDim.x * gridDim.y * gridDim.z;
    unsigned sum, cnt, mine, sp = 0u;
    for (;;) {
        sum = 0u; cnt = 0u; mine = 0u;
#pragma unroll
        for (unsigned j = 0; j < 16; ++j) { const unsigned c = xb_ld(&bar[XB_XCNT(j)]); sum += c; cnt += (c > 0u) ? 1u : 0u; mine = (j == x) ? c : mine; }
        if (sum == G) break;
        __builtin_amdgcn_s_sleep(1);
        if ((++sp & 255u) == 0u) { if (xb_ld(&bar[XB_TMO])) break; if (sp > XB_SPIN_CAP) { atomicAdd(&bar[XB_TMO], 1u); break; } }
    }
    nloc = mine > 0u ? mine : 1u; nx = cnt > 0u ? cnt : 1u;
}
__device__ __forceinline__ void xcd_barrier(const XcdBarrier& b) {
    asm volatile("s_waitcnt vmcnt(0)" ::: "memory");
    __syncthreads();
    if (threadIdx.x == 0) {
        unsigned* bar = b.bar;
        __builtin_amdgcn_s_waitcnt(0);
        unsigned nloc = b.st[0], nx = b.st[1];
        if (nloc == 0u) { xcd_barrier_complete(bar, b.x, nloc, nx); b.st[0] = nloc; b.st[1] = nx; }
        const unsigned old = xb_add(&bar[XB_XSUB(b.x)], 1u);
        const unsigned gen = old / nloc;
        if (old + 1u == (gen + 1u) * nloc) {
            __builtin_amdgcn_fence(__ATOMIC_RELEASE, "agent");
            asm volatile("s_waitcnt vmcnt(0)" ::: "memory");
            const unsigned og = xb_add(&bar[XB_TOP], 1u);
            const unsigned tg = og / nx;
            if (og + 1u == (tg + 1u) * nx) xb_add(&bar[XB_TOPGEN], 1u);
            else XB_SPIN(xb_ld(&bar[XB_TOPGEN]) == tg, bar);
            __builtin_amdgcn_fence(__ATOMIC_ACQUIRE, "agent");
            xb_add(&bar[XB_XGEN(b.x)], 1u);
            asm volatile("s_waitcnt vmcnt(0)" ::: "memory");
        } else {
            XB_SPIN(xb_ld(&bar[XB_XGEN(b.x)]) == gen, bar);
            __builtin_amdgcn_fence(__ATOMIC_ACQUIRE, "agent");
            asm volatile("s_waitcnt vmcnt(0)" ::: "memory");
        }
    }
    __syncthreads();
}

struct Args {
    const float *x_p, *x_s, *c_p, *c_s, *st_h, *st_C, *st_n, *st_m, *st_conv, *w_ada, *b_ada, *norm_g, *w_in, *b_in, *lb_logits, *hnorm_g,
                *conv_w, *conv_b, *wq, *wk, *wv, *mnorm_g, *skip, *w_out, *final_g;
    float* out; unsigned char* ws;
};

__device__ __forceinline__ void transposes(const Args& a, LAS unsigned char* lds, int vcu, int G, int tid, int wave, int lane);
__device__ __forceinline__ void phase1(const Args& a, LAS unsigned char* lds, int vcu, int G, int tid, int wave, int lane) {
    LAS float* sg = (LAS float*)lds;
    { const float* GW = (const float*)(a.ws + WS_GW); f32x4 tv[4];
#pragma unroll
      for (int i = 0; i < 4; ++i) tv[i] = *(const f32x4*)(GW + 4 * (tid + NTHR * i));
#pragma unroll
      for (int i = 0; i < 4; ++i) *(LAS f32x4*)(sg + 4 * (tid + NTHR * i)) = tv[i]; }
    __syncthreads();
    const float* MOD = (const float*)(a.ws + WS_MOD);
    bf16_t* XN = (bf16_t*)(a.ws + WS_XN); float* GATE = (float*)(a.ws + WS_GATE);
    const int gw = vcu * NWAVES + wave, NGW = G * NWAVES;
    f32x4 nx[4];
    if (gw < MT) { const float* xr = gw < MP ? a.x_p + (size_t)gw * DM : a.x_s + (size_t)(gw - MP) * DM;
#pragma unroll
        for (int j = 0; j < 4; ++j) nx[j] = *(const f32x4*)(xr + 4 * lane + 256 * j); }
    for (int r = gw; r < MT; r += NGW) {
        const int mb = r < MP ? (r >> 11) : BP + ((r - MP) >> 2);
        const float* shift = MOD + (size_t)mb * 3072; const float* scale = shift + 1024;
        f32x4 v[4]; float s = 0.f;
#pragma unroll
        for (int j = 0; j < 4; ++j) { v[j] = nx[j]; s += (v[j].x * v[j].x + v[j].y * v[j].y) + (v[j].z * v[j].z + v[j].w * v[j].w); }
        if (r + NGW < MT) { const int rn = r + NGW; const float* xr = rn < MP ? a.x_p + (size_t)rn * DM : a.x_s + (size_t)(rn - MP) * DM;
#pragma unroll
            for (int j = 0; j < 4; ++j) nx[j] = *(const f32x4*)(xr + 4 * lane + 256 * j); }
        const float rinv = 1.0f / sqrtf(wave_sum(s) * (1.f / DM) + EPS);
        float gd[8];
#pragma unroll
        for (int gi = 0; gi < 8; ++gi) gd[gi] = 0.f;
#pragma unroll
        for (int j = 0; j < 4; ++j) {
            const int col = 4 * lane + 256 * j;
            const f32x4 g = *(const f32x4*)(a.norm_g + col), sc = *(const f32x4*)(scale + col), sh = *(const f32x4*)(shift + col);
            f32x4 h = v[j] * rinv * g * (sc + 1.0f) + sh;
            u32x2 o; o.x = pk2(h.x, h.y); o.y = pk2(h.z, h.w);
            *(u32x2*)(XN + (size_t)r * DM + col) = o;
#pragma unroll
            for (int gi = 0; gi < 8; ++gi) { const f32x4 w = *(const LAS f32x4*)(sg + gi * 1024 + col); gd[gi] += (h.x * w.x + h.y * w.y) + (h.z * w.z + h.w * w.w); }
        }
#pragma unroll
        for (int gi = 0; gi < 8; ++gi) gd[gi] = wave_sum(gd[gi]);
        if (lane < 8) {
            float val = 0.f;
#pragma unroll
            for (int gi = 0; gi < 8; ++gi) val = (lane == gi) ? gd[gi] : val;
            val += a.b_in[NPROJ + lane];
            if (lane >= 4) val = fminf(val, 0.f) - log1pf(__expf(-fabsf(val)));
            GATE[(size_t)r * 8 + lane] = val;
        }
    }
}

__device__ __forceinline__ void store_wt_f32(float* p, float v) { asm volatile("global_store_dword %0, %1, off sc1\n\ts_nop 1" :: "v"(p), "v"(v) : "memory"); }
struct EpiProj {
    static constexpr bool PERM = true, AFTER_DRAIN = false;
    bf16_t* PROJ; float* LOGF; float* LOGFS; const float* bias; const float* lbl;
    __device__ __forceinline__ void operator()(const f32x4 (&acc)[2][2][4][2], const pg8::Unit& u, int wr, int wc, int fr, int fq) const {
        const int seg = u.pn >> 2;
        const int row0 = u.pm * 256 + wr * 64 + fr, col0 = u.pn * 256 + wc * 32 + 8 * fq, cs0 = col0 & 1023;
        const bool prompt = u.pm < MP / 256;
        unsigned cpart[2];
#pragma unroll
        for (int bj = 0; bj < 2; ++bj) { const int cs = cs0 + bj * 128; cpart[bj] = seg < 4 ? (unsigned)(((cs >> 7) << 13) + (cs & 127)) : (unsigned)(((cs >> 8) << 14) + (cs & 255)); }
        const int tsh = seg < 4 ? 7 : 8;
        f32x4 bv[2][2], lb[2][2];
#pragma unroll
        for (int bj = 0; bj < 2; ++bj)
#pragma unroll
            for (int n = 0; n < 2; ++n) {
                bv[bj][n] = *(const f32x4*)(bias + col0 + bj * 128 + 4 * n);
                if (seg == 1) { const int c = col0 - 1024 + bj * 128 + 4 * n; const f32x4 l0 = *(const f32x4*)(lbl + c), l1 = *(const f32x4*)(lbl + 1024 + c);
                    f32x4 t; t.x = 1.f / (1.f + __expf(l1.x - l0.x)); t.y = 1.f / (1.f + __expf(l1.y - l0.y)); t.z = 1.f / (1.f + __expf(l1.z - l0.z)); t.w = 1.f / (1.f + __expf(l1.w - l0.w)); lb[bj][n] = t; }
                else lb[bj][n] = (f32x4){0.f, 0.f, 0.f, 0.f};
            }
#pragma unroll
        for (int ai = 0; ai < 2; ++ai)
#pragma unroll
            for (int m = 0; m < 4; ++m) {
                const int row = row0 + ai * 128 + m * 16;
                const size_t rpart = prompt ? ((size_t)(row >> 6) << 16) + (size_t)((row & 63) << tsh) : 0;
#pragma unroll
                for (int bj = 0; bj < 2; ++bj) {
                    f32x4 v0 = acc[ai][bj][m][0] + bv[bj][0], v1 = acc[ai][bj][m][1] + bv[bj][1];
                    if (seg == 1) {
                        float* dst = prompt ? LOGF + rpart + cpart[bj] : LOGFS + (size_t)(row - MP) * 1024 + cs0 + bj * 128;
                        f32x4 o0, o1;
#pragma unroll
                        for (int e = 0; e < 4; ++e) { const float l0 = lb[bj][0][e], l1 = lb[bj][1][e];
                            o0[e] = __logf(l0 + (1.f - l0) * sigmoidf_(v0[e])); o1[e] = __logf(l1 + (1.f - l1) * sigmoidf_(v1[e])); }
                        *(f32x4*)dst = o0; *(f32x4*)(dst + 4) = o1;
                    } else {
                        if (seg == 3 || seg == 5) {
#pragma unroll
                            for (int e = 0; e < 4; ++e) { v0[e] = v0[e] * sigmoidf_(v0[e]); v1[e] = v1[e] * sigmoidf_(v1[e]); }
                        } else if (seg == 6) {
#pragma unroll
                            for (int e = 0; e < 4; ++e) { v0[e] = sigmoidf_(v0[e]); v1[e] = sigmoidf_(v1[e]); }
                        }
                        u32x4 w; w.x = pk2(v0[0], v0[1]); w.y = pk2(v0[2], v0[3]); w.z = pk2(v1[0], v1[1]); w.w = pk2(v1[2], v1[3]);
                        bf16_t* dst = prompt ? PROJ + (size_t)seg * SEGSZ + rpart + cpart[bj] : PROJ + PS_OFF + (size_t)(row - MP) * NPROJ + col0 + bj * 128;
                        *(u32x4*)dst = w;
                    }
                }
            }
    }
};
struct EpiOut {
    static constexpr bool PERM = true, AFTER_DRAIN = false;
    float* Y; const float* xp; const float* xs; const float* MOD;
    __device__ __forceinline__ void operator()(const f32x4 (&acc)[2][2][4][2], const pg8::Unit& u, int wr, int wc, int fr, int fq) const {
        const int row0 = u.pm * 256 + wr * 64 + fr, col0 = u.pn * 256 + wc * 32 + 8 * fq;
#pragma unroll
        for (int ai = 0; ai < 2; ++ai)
#pragma unroll
            for (int m = 0; m < 4; ++m) {
                const int row = row0 + ai * 128 + m * 16;
                const float* xr = row < MP ? xp + (size_t)row * DM : xs + (size_t)(row - MP) * DM;
                const int mb = row < MP ? (row >> 11) : BP + ((row - MP) >> 2);
                const float* gate = MOD + (size_t)mb * 3072 + 2048;
#pragma unroll
                for (int bj = 0; bj < 2; ++bj)
#pragma unroll
                    for (int n = 0; n < 2; ++n) {
                        const int col = col0 + bj * 128 + 4 * n;
                        const f32x4 xv = *(const f32x4*)(xr + col), gv = *(const f32x4*)(gate + col);
                        *(f32x4*)(Y + (size_t)row * DM + col) = xv + gv * acc[ai][bj][m][n];
                    }
            }
    }
};

struct EpiOutFused {
    static constexpr bool PERM = true, AFTER_DRAIN = true;
    float* Y; const float* xp; const float* MOD; const float* fg; float* STATS; unsigned* cnt;
    __device__ __forceinline__ void operator()(const f32x4 (&)[2][2][4][2], const pg8::Unit&, int, int, int, int) const {}
    __device__ __forceinline__ void fused(f32x4 (&acc)[2][2][4][2], const pg8::Unit& u, int wr, int wc, int fr, int fq, LAS unsigned char* lds, int wid, int lane) const {
        LAS float* P = (LAS float*)lds;
        LAS float* S = (LAS float*)(lds + 4096);
        const int tid = wid * 64 + lane;
        const int row0 = u.pm * 256 + wr * 64 + fr, col0 = u.pn * 256 + wc * 32 + 8 * fq;
        const float* gate = MOD + (size_t)(u.pm >> 3) * 3072 + 2048;
        f32x4 gv[2][2];
#pragma unroll
        for (int bj = 0; bj < 2; ++bj)
#pragma unroll
            for (int n = 0; n < 2; ++n) gv[bj][n] = *(const f32x4*)(gate + col0 + bj * 128 + 4 * n);
#pragma unroll
        for (int ai = 0; ai < 2; ++ai)
#pragma unroll
            for (int m = 0; m < 4; ++m) {
                const int row = row0 + ai * 128 + m * 16; float sq = 0.f;
#pragma unroll
                for (int bj = 0; bj < 2; ++bj)
#pragma unroll
                    for (int n = 0; n < 2; ++n) { const f32x4 xv = *(const f32x4*)(xp + (size_t)row * DM + col0 + bj * 128 + 4 * n);
                        const f32x4 v = xv + gv[bj][n] * acc[ai][bj][m][n]; acc[ai][bj][m][n] = v; sq += (v.x * v.x + v.y * v.y) + (v.z * v.z + v.w * v.w); }
                sq += __shfl_xor(sq, 16); sq += __shfl_xor(sq, 32);
                if (fq == 0) P[(ai * 128 + wr * 64 + m * 16 + fr) * 4 + wc] = sq;
            }
        __syncthreads();
        if (tid < 256) { const f32x4 p4 = *(const LAS f32x4*)(P + tid * 4);
            __hip_atomic_store(STATS + ((size_t)u.pm * 256 + tid) * 4 + u.pn, (p4.x + p4.y) + (p4.z + p4.w), __ATOMIC_RELAXED, __HIP_MEMORY_SCOPE_AGENT); }
        asm volatile("s_waitcnt vmcnt(0)" ::: "memory");
        __syncthreads();
        if (tid == 0) { (void)xb_add(cnt + 64 * u.pm, 1u);
            unsigned sp = 0; while (xb_ld(cnt + 64 * u.pm) < 4u) { __builtin_amdgcn_s_sleep(1); if (++sp > (1u << 20)) break; } }
        __syncthreads();
        if (tid < 256) { const float* st = STATS + ((size_t)u.pm * 256 + tid) * 4; float t = 0.f;
#pragma unroll
            for (int j = 0; j < 4; ++j) t += __hip_atomic_load(st + j, __ATOMIC_RELAXED, __HIP_MEMORY_SCOPE_AGENT);
            S[tid] = 1.0f / sqrtf(t * (1.f / DM) + EPS); }
        __syncthreads();
        f32x4 fgv[2][2];
#pragma unroll
        for (int bj = 0; bj < 2; ++bj)
#pragma unroll
            for (int n = 0; n < 2; ++n) fgv[bj][n] = *(const f32x4*)(fg + col0 + bj * 128 + 4 * n);
#pragma unroll
        for (int ai = 0; ai < 2; ++ai)
#pragma unroll
            for (int m = 0; m < 4; ++m) {
                const int rl = ai * 128 + wr * 64 + m * 16 + fr; const float ri = S[rl];
#pragma unroll
                for (int bj = 0; bj < 2; ++bj)
#pragma unroll
                    for (int n = 0; n < 2; ++n) *(f32x4*)(Y + (size_t)(u.pm * 256 + rl) * DM + col0 + bj * 128 + 4 * n) = acc[ai][bj][m][n] * ri * fgv[bj][n];
            }
    }
};
#define LDSP(type, off) ((LAS type*)(lds + (off)))
__device__ __forceinline__ unsigned lp_row(int lane, unsigned RS) { return (unsigned)(lane & 31) * RS + 16u * (unsigned)(lane >> 5); }
__device__ __forceinline__ unsigned lp_perm(int lane, unsigned RS) { return (unsigned)(lane & 31) * RS + 8u * (unsigned)(lane >> 5); }
__device__ __forceinline__ unsigned lp_tr(int lane, unsigned RS) { return ((unsigned)(lane >> 5) * 8u + (unsigned)((lane & 15) >> 2)) * RS + (((unsigned)(lane >> 4) & 1u) * 16u + (unsigned)(lane & 3) * 4u) * 2u; }
__device__ __forceinline__ bf16x8 frag_row(LAS unsigned char* lds, unsigned off) { return *LDSP(const bf16x8, off); }
__device__ __forceinline__ bf16x8 frag_perm(LAS unsigned char* lds, unsigned off) {
    const s16x4 lo = *LDSP(const s16x4, off), hi = *LDSP(const s16x4, off + 16);
    bf16x8 r; r[0] = lo[0]; r[1] = lo[1]; r[2] = lo[2]; r[3] = lo[3]; r[4] = hi[0]; r[5] = hi[1]; r[6] = hi[2]; r[7] = hi[3]; return r;
}
template <unsigned RS> __device__ __forceinline__ bf16x8 frag_tr(LAS unsigned char* lds, unsigned off) {
    const s16x4 lo = __builtin_amdgcn_ds_read_tr16_b64_v4i16(LDSP(s16x4, off));
    const s16x4 hi = __builtin_amdgcn_ds_read_tr16_b64_v4i16(LDSP(s16x4, off + 4 * RS));
    bf16x8 r; r[0] = lo[0]; r[1] = lo[1]; r[2] = lo[2]; r[3] = lo[3]; r[4] = hi[0]; r[5] = hi[1]; r[6] = hi[2]; r[7] = hi[3]; return r;
}
template <int S> __device__ __forceinline__ bf16x8 acc_frag(const f32x16& x) {
    u32x4 w; w.x = pk2(x[8 * S + 0], x[8 * S + 1]); w.y = pk2(x[8 * S + 2], x[8 * S + 3]); w.z = pk2(x[8 * S + 4], x[8 * S + 5]); w.w = pk2(x[8 * S + 6], x[8 * S + 7]);
    return __builtin_bit_cast(bf16x8, w);
}
#define MFMA32(a, b, c) __builtin_amdgcn_mfma_f32_32x32x16_bf16(a, b, c, 0, 0, 0)
__device__ __forceinline__ int accrow(int i, int h) { return (i & 3) + 8 * (i >> 2) + 4 * h; }
#define ACCROW0(i) (((i) & 3) + 8 * ((i) >> 2))

__device__ __forceinline__ void p0_transpose_tile(const float* W, int ldw, int K, bf16_t* WT, LAS unsigned char* lds, int kb, int nb, int tid, int wave, int lane) {
    constexpr unsigned RS = 528;
    const int k0 = 64 * kb, n0 = 256 * nb;
    f32x4 v[8];
#pragma unroll
    for (int i = 0; i < 8; ++i) { const int idx = tid + NTHR * i, k = idx >> 6, nq = idx & 63; v[i] = *(const f32x4*)(W + (size_t)(k0 + k) * ldw + n0 + 4 * nq); }
#pragma unroll
    for (int i = 0; i < 8; ++i) { const int idx = tid + NTHR * i, k = idx >> 6, nq = idx & 63; u32x2 o; o.x = pk2(v[i].x, v[i].y); o.y = pk2(v[i].z, v[i].w); *LDSP(u32x2, k * RS + 8 * nq) = o; }
    __syncthreads();
    const unsigned ot = lp_tr(lane, RS) + 64u * wave;
#pragma unroll
    for (int rb = 0; rb < 4; ++rb) { const bf16x8 f = frag_tr<RS>(lds, ot + 16 * rb * RS);
        *(bf16x8*)(WT + (size_t)(n0 + 32 * wave + (lane & 31)) * K + k0 + 16 * rb + 8 * (lane >> 5)) = f; }
    __syncthreads();
}
__device__ __forceinline__ void transposes(const Args& a, LAS unsigned char* lds, int vcu, int G, int tid, int wave, int lane);
__device__ __forceinline__ void phase0(const Args& a, LAS unsigned char* lds, int vcu, int G, int tid, int wave, int lane) {
    float* MOD = (float*)(a.ws + WS_MOD);
    for (int cb = vcu; cb < 96; cb += G) {
        const int c0 = 32 * cb;
#pragma unroll
        for (int hb = 0; hb < 2; ++hb) { f32x4 v[8];
#pragma unroll
            for (int i = 0; i < 8; ++i) { const int k = (tid >> 3) + 64 * (8 * hb + i); v[i] = *(const f32x4*)(a.w_ada + (size_t)k * 3072 + c0 + 4 * (tid & 7)); }
#pragma unroll
            for (int i = 0; i < 8; ++i) { const int k = (tid >> 3) + 64 * (8 * hb + i); u32x2 o; o.x = pk2(v[i].x, v[i].y); o.y = pk2(v[i].z, v[i].w); *LDSP(u32x2, k * 80 + 8 * (tid & 7)) = o; } }
        __syncthreads();
        if (wave < 5) {
            const int hl = lane >> 5, rr = 32 * wave + (lane & 31), rc = rr < NMOD ? rr : NMOD - 1;
            const float* cr = (rc < BP ? a.c_p + (size_t)rc * DM : a.c_s + (size_t)(rc - BP) * DM) + 8 * hl;
            const unsigned ot = lp_tr(lane, 80);
            f32x16 acc;
#pragma unroll
            for (int i = 0; i < 16; ++i) acc[i] = 0.f;
            f32x4 cv[8][2], cnx[8][2];
#pragma unroll
            for (int j = 0; j < 8; ++j) { cnx[j][0] = *(const f32x4*)(cr + 16 * j); cnx[j][1] = *(const f32x4*)(cr + 16 * j + 4); }
#pragma unroll 1
            for (int k0 = 0; k0 < DM; k0 += 128) {
#pragma unroll
                for (int j = 0; j < 8; ++j) { cv[j][0] = cnx[j][0]; cv[j][1] = cnx[j][1]; }
                { const int kn = (k0 + 128 < DM) ? k0 + 128 : k0;
#pragma unroll
                  for (int j = 0; j < 8; ++j) { cnx[j][0] = *(const f32x4*)(cr + kn + 16 * j); cnx[j][1] = *(const f32x4*)(cr + kn + 16 * j + 4); } }
#pragma unroll
                for (int j = 0; j < 8; ++j) {
                    float sv[8];
#pragma unroll
                    for (int e = 0; e < 4; ++e) { sv[e] = cv[j][0][e] * sigmoidf_(cv[j][0][e]); sv[4 + e] = cv[j][1][e] * sigmoidf_(cv[j][1][e]); }
                    u32x4 w; w.x = pk2(sv[0], sv[1]); w.y = pk2(sv[2], sv[3]); w.z = pk2(sv[4], sv[5]); w.w = pk2(sv[6], sv[7]);
                    acc = MFMA32(__builtin_bit_cast(bf16x8, w), frag_tr<80>(lds, ot + (unsigned)(k0 + 16 * j) * 80u), acc);
                }
            }
#pragma unroll
            for (int i = 0; i < 16; ++i) { const int r = 32 * wave + accrow(i, hl);
                if (r < NMOD) MOD[(size_t)r * 3072 + c0 + (lane & 31)] = acc[i] + a.b_ada[c0 + (lane & 31)]; }
        }
        __syncthreads();
    }
    if (vcu >= 96) transposes(a, lds, vcu - 96, G - 96, tid, wave, lane);
    if (vcu == G - 1) {
        float* GW = (float*)(a.ws + WS_GW);
        float tv[16];
#pragma unroll
        for (int i = 0; i < 16; ++i) { const int idx = tid + NTHR * i; tv[i] = a.w_in[(size_t)(idx >> 3) * WIN_LD + NPROJ + (idx & 7)]; }
#pragma unroll
        for (int i = 0; i < 16; ++i) { const int idx = tid + NTHR * i; GW[(idx & 7) * 1024 + (idx >> 3)] = tv[i]; }
    }
}
__device__ __forceinline__ void transposes(const Args& a, LAS unsigned char* lds, int vcu, int G, int tid, int wave, int lane) {
    bf16_t* WinT = (bf16_t*)(a.ws + WS_WIN); bf16_t* WoutT = (bf16_t*)(a.ws + WS_WOUT);
    constexpr int I_IN = (DM / 64) * (NPROJ / 256), I_OUT = (DMIX / 64) * (DM / 256);
    for (int it = vcu; it < I_IN + I_OUT; it += G) {
        if (it < I_IN) p0_transpose_tile(a.w_in, WIN_LD, DM, WinT, lds, it / (NPROJ / 256), it % (NPROJ / 256), tid, wave, lane);
        else { const int u = it - I_IN; p0_transpose_tile(a.w_out, DM, DMIX, WoutT, lds, u / (DM / 256), u % (DM / 256), tid, wave, lane); }
    }
}

__device__ __forceinline__ unsigned p3a_touch(const Args& a, int t, int tid) {
    const bf16_t* PROJ = (const bf16_t*)(a.ws + WS_PROJ);
    const unsigned* p;
    if (t < 1024) { const int b = t >> 7, c = (t >> 2) & 31, h = t & 3;
        p = (const unsigned*)(PROJ + ml_tile(4, b, c, h) + (tid & 255) * 64); }
    else { const int u = t - 1024, b = u >> 8, c = (u >> 3) & 31, h = u & 7;
        if (tid < 256) p = (const unsigned*)((const float*)(a.ws + WS_LOGF) + ((size_t)((b * NCH + c) * 8 + h) << 13) + tid * 32);
        else p = (const unsigned*)(PROJ + hg_tile(0, b, c, h) + (tid & 127) * 64); }
    return *p;
}
__device__ __forceinline__ void p3a_hgrn(const Args& a, LAS unsigned char* lds, int b, int c, int h, int tid, int wave, int lane, int tnext) {
    constexpr unsigned RS = 272, OQT = 8192, OKT = 8192 + 17408;
    bf16_t* PROJ = (bf16_t*)(a.ws + WS_PROJ);
    const float* LOGF = (const float*)(a.ws + WS_LOGF);
    const size_t r0 = (size_t)b * TP + (size_t)c * 64;
    const size_t task = ((size_t)b * NCH + c) * 8 + h;
    const int cq = tid & 31, tseg = tid >> 5;
    f32x4 lf[4]; u32x2 qw[4];
#pragma unroll
    for (int i = 0; i < 4; ++i) { const int t = 4 * tseg + i; lf[i] = *(const f32x4*)(LOGF + (task << 13) + t * 128 + 4 * cq); qw[i] = *(const u32x2*)(PROJ + hg_tile(0, b, c, h) + t * 128 + 4 * cq); }
    const unsigned pf = (tnext >= 0) ? p3a_touch(a, tnext, tid) : 0u;
    f32x4 gl[4]; gl[0] = lf[0]; gl[1] = gl[0] + lf[1]; gl[2] = gl[1] + lf[2]; gl[3] = gl[2] + lf[3];
    *LDSP(f32x4, (tseg * 128 + 4 * cq) * 4) = gl[3];
    __syncthreads();
    f32x4 off = {0.f, 0.f, 0.f, 0.f}, Gm = off, GL = off;
#pragma unroll
    for (int sg = 0; sg < 16; ++sg) { const f32x4 v = *LDSP(const f32x4, (sg * 128 + 4 * cq) * 4); GL += v; if (sg < 8) Gm += v; if (sg < tseg) off += v; }
#pragma unroll
    for (int i = 0; i < 4; ++i) { const int t = 4 * tseg + i;
        const f32x4 G = off + gl[i];
        const float q[4] = {bflo(qw[i].x), bfhi(qw[i].x), bflo(qw[i].y), bfhi(qw[i].y)};
        float qe[4], ke[4], qt[4], kt[4];
#pragma unroll
        for (int e = 0; e < 4; ++e) { const float kk = 1.f - __expf(lf[i][e]);
            qe[e] = q[e] * __expf(G[e]); ke[e] = kk * __expf(GL[e] - G[e]); qt[e] = q[e] * __expf(G[e] - Gm[e]); kt[e] = kk * __expf(Gm[e] - G[e]); }
        bf16_t* qp = PROJ + hg_tile(0, b, c, h) + t * 128 + 4 * cq;
        u32x2 o; o.x = pk2(qe[0], qe[1]); o.y = pk2(qe[2], qe[3]); *(u32x2*)qp = o;
        o.x = pk2(ke[0], ke[1]); o.y = pk2(ke[2], ke[3]); *(u32x2*)(qp + SEGSZ) = o;
        o.x = pk2(qt[0], qt[1]); o.y = pk2(qt[2], qt[3]); *LDSP(u32x2, OQT + t * RS + 8 * cq) = o;
        o.x = pk2(kt[0], kt[1]); o.y = pk2(kt[2], kt[3]); *LDSP(u32x2, OKT + t * RS + 8 * cq) = o;
    }
    if (tseg == 15) { f32x4 d; d.x = __expf(GL.x); d.y = __expf(GL.y); d.z = __expf(GL.z); d.w = __expf(GL.w); *(f32x4*)((float*)(a.ws + WS_DEC) + task * 128 + 4 * cq) = d; }
    __syncthreads();
    bf16_t* AH = (bf16_t*)(a.ws + WS_AH) + task * 4096;
    if (wave < 4) {
        const int ti = (wave == 0 || wave == 3) ? 0 : 1, tj = (wave == 2 || wave == 3) ? 1 : 0;
        const int hh = lane >> 5, c31 = lane & 31;
        f32x16 acc = {0.f, 0.f, 0.f, 0.f, 0.f, 0.f, 0.f, 0.f, 0.f, 0.f, 0.f, 0.f, 0.f, 0.f, 0.f, 0.f};
        if (wave < 3) {
            unsigned oa = OQT + lp_row(lane, RS) + 32u * ti * RS, ob = OKT + lp_row(lane, RS) + 32u * tj * RS;
#pragma unroll 4
            for (int ks = 0; ks < 8; ++ks) { acc = MFMA32(frag_row(lds, oa), frag_row(lds, ob), acc); oa += 32; ob += 32; }
        }
#pragma unroll
        for (int i = 0; i < 16; ++i) { const int t = 32 * ti + accrow(i, hh), j = 32 * tj + c31;
            AH[t * 64 + j] = f2bf((wave < 3 && j <= t) ? acc[i] : 0.f); }
    }
    asm volatile("" :: "v"(pf));
    __syncthreads();
}
__device__ __forceinline__ void p3a_mlstm(const Args& a, LAS unsigned char* lds, int b, int c, int h, int tid, int wave, int lane, int tnext) {
    constexpr unsigned RS = 528, OK_ = 33792, ORS_ = 67584, OCS_ = 67584 + 256;
    const bf16_t* PROJ = (const bf16_t*)(a.ws + WS_PROJ);
    const float* GATE = (const float*)(a.ws + WS_GATE);
    const size_t r0 = (size_t)b * TP + (size_t)c * 64;
    const size_t task = ((size_t)b * NCH + c) * 4 + h;
    if (tid < 64) *LDSP(float, ORS_ + tid * 4) = 0.f;
    const int tg = tid & 7, g = tid >> 3, ch = h * 256 + 4 * g, gg = h * 64 + g;
    const float ig = GATE[(r0 + lane) * 8 + h], lfg = GATE[(r0 + lane) * 8 + 4 + h];
    u32x2 muw[11];
#pragma unroll
    for (int rr = 0; rr < 11; ++rr) { const int t = 8 * tg - 3 + rr; const bool pad = (c == 0 && t < 0);
        const int tt_ = pad ? 0 : t;
        const u32x2 w = *(const u32x2*)(PROJ + ml_tile(4, b, tt_ < 0 ? c - 1 : c, h) + (tt_ & 63) * 256 + 4 * g);
        muw[rr].x = pad ? 0u : w.x; muw[rr].y = pad ? 0u : w.y; }
    float cw[4][4], cb[4], wq[4][4], wk[4][4], wv[4][4];
#pragma unroll
    for (int w = 0; w < 4; ++w) { const f32x4 t = *(const f32x4*)(a.conv_w + w * 1024 + ch); cw[w][0] = t.x; cw[w][1] = t.y; cw[w][2] = t.z; cw[w][3] = t.w; }
    { const f32x4 t = *(const f32x4*)(a.conv_b + ch); cb[0] = t.x; cb[1] = t.y; cb[2] = t.z; cb[3] = t.w; }
#pragma unroll
    for (int i = 0; i < 4; ++i) { const f32x4 t0 = *(const f32x4*)(a.wq + gg * 16 + 4 * i), t1 = *(const f32x4*)(a.wk + gg * 16 + 4 * i), t2 = *(const f32x4*)(a.wv + gg * 16 + 4 * i);
#pragma unroll
        for (int j = 0; j < 4; ++j) { wq[i][j] = t0[j]; wk[i][j] = t1[j] * 0.0625f; wv[i][j] = t2[j]; } }
    const unsigned pf = (tnext >= 0) ? p3a_touch(a, tnext, tid) : 0u;
    float bt = lfg;
#pragma unroll
    for (int o = 1; o < 64; o <<= 1) { const float n = __shfl_up(bt, o); if (lane >= o) bt += n; }
    const float av = ig - bt; float R = av;
#pragma unroll
    for (int o = 1; o < 64; o <<= 1) R = fmaxf(R, __shfl_xor(R, o));
    const float wtok = __expf(av - R);
    if (wave == 0) { ((float*)(a.ws + WS_BT))[task * 64 + lane] = bt; if (lane == 0) ((float*)(a.ws + WS_RL))[task] = R; }
    {
        bf16_t* XC = (bf16_t*)(a.ws + WS_XC); bf16_t* QM = (bf16_t*)(a.ws + WS_QM); bf16_t* KM = (bf16_t*)(a.ws + WS_KM); bf16_t* VM = (bf16_t*)(a.ws + WS_VM);
        float cs[4] = {0.f, 0.f, 0.f, 0.f};
        u32x4 kT[4], vT[4];
#pragma unroll
        for (int tp = 0; tp < 4; ++tp) { float k2[2][4], v2[2][4];
#pragma unroll
          for (int u = 0; u < 2; ++u) { const int tt = 2 * tp + u; const int t = 8 * tg + tt; const float wt = __shfl(wtok, t);
            float m0[4], m1[4], m2[4], m3[4];
            m0[0] = bflo(muw[tt].x); m0[1] = bfhi(muw[tt].x); m0[2] = bflo(muw[tt].y); m0[3] = bfhi(muw[tt].y);
            m1[0] = bflo(muw[tt + 1].x); m1[1] = bfhi(muw[tt + 1].x); m1[2] = bflo(muw[tt + 1].y); m1[3] = bfhi(muw[tt + 1].y);
            m2[0] = bflo(muw[tt + 2].x); m2[1] = bfhi(muw[tt + 2].x); m2[2] = bflo(muw[tt + 2].y); m2[3] = bfhi(muw[tt + 2].y);
            m3[0] = bflo(muw[tt + 3].x); m3[1] = bfhi(muw[tt + 3].x); m3[2] = bflo(muw[tt + 3].y); m3[3] = bfhi(muw[tt + 3].y);
            float xc[4], q[4], k[4];
#pragma unroll
            for (int i = 0; i < 4; ++i) { const float cv = cb[i] + cw[0][i] * m0[i] + cw[1][i] * m1[i] + cw[2][i] * m2[i] + cw[3][i] * m3[i]; xc[i] = cv * sigmoidf_(cv); }
#pragma unroll
            for (int j = 0; j < 4; ++j) { q[j] = xc[0] * wq[0][j] + xc[1] * wq[1][j] + xc[2] * wq[2][j] + xc[3] * wq[3][j];
                k[j] = (xc[0] * wk[0][j] + xc[1] * wk[1][j] + xc[2] * wk[2][j] + xc[3] * wk[3][j]) * wt;
                v2[u][j] = m3[0] * wv[0][j] + m3[1] * wv[1][j] + m3[2] * wv[2][j] + m3[3] * wv[3][j]; cs[j] += k[j]; k2[u][j] = k[j]; }
            const size_t go = (task << 14) + t * 256 + 4 * g;
            u32x2 o; o.x = pk2(xc[0], xc[1]); o.y = pk2(xc[2], xc[3]); *(u32x2*)(XC + go) = o;
            o.x = pk2(q[0], q[1]); o.y = pk2(q[2], q[3]); *(u32x2*)(QM + go) = o; *LDSP(u32x2, t * RS + 8 * g) = o;
            o.x = pk2(k[0], k[1]); o.y = pk2(k[2], k[3]); *LDSP(u32x2, OK_ + t * RS + 8 * g) = o;
          }
#pragma unroll
          for (int j = 0; j < 4; ++j) { kT[j][tp] = pk2(k2[0][j], k2[1][j]); vT[j][tp] = pk2(v2[0][j], v2[1][j]); }
        }
#pragma unroll
        for (int j = 0; j < 4; ++j) { const size_t go = (task << 14) + (size_t)(4 * g + j) * 64 + 8 * tg;
            *(u32x4*)(KM + go) = kT[j]; *(u32x4*)(VM + go) = vT[j]; }
#pragma unroll
        for (int j = 0; j < 4; ++j) { cs[j] += __shfl_xor(cs[j], 1); cs[j] += __shfl_xor(cs[j], 2); cs[j] += __shfl_xor(cs[j], 4); }
        if (tg == 0) *LDSP(f32x4, OCS_ + 16 * g) = (f32x4){cs[0], cs[1], cs[2], cs[3]};
        if (c == NCH - 1 && tg == 7) {
#pragma unroll
            for (int j = 0; j < 3; ++j) *(f32x4*)(a.out + O_VP + ((size_t)b * 3 + j) * 1024 + ch) = (f32x4){bflo(muw[8 + j].x), bfhi(muw[8 + j].x), bflo(muw[8 + j].y), bfhi(muw[8 + j].y)};
        }
    }
    __syncthreads();
    bf16_t* AM = (bf16_t*)(a.ws + WS_AM) + task * 4096;
    if (wave < 4) {
        const int ti = (wave == 0 || wave == 3) ? 0 : 1, tj = (wave == 2 || wave == 3) ? 1 : 0;
        const int hh = lane >> 5, c31 = lane & 31;
        f32x16 acc = {0.f, 0.f, 0.f, 0.f, 0.f, 0.f, 0.f, 0.f, 0.f, 0.f, 0.f, 0.f, 0.f, 0.f, 0.f, 0.f};
        if (wave < 3) {
            unsigned oa = lp_row(lane, RS) + 32u * ti * RS, ob = OK_ + lp_row(lane, RS) + 32u * tj * RS;
#pragma unroll 4
            for (int ks = 0; ks < 16; ++ks) { acc = MFMA32(frag_row(lds, oa), frag_row(lds, ob), acc); oa += 32; ob += 32; }
        }
        float pv[16];
#pragma unroll
        for (int i = 0; i < 16; ++i) { const int t = 32 * ti + accrow(i, hh), j = 32 * tj + c31;
            pv[i] = (wave < 3 && j <= t) ? acc[i] : 0.f;
            AM[t * 64 + j] = f2bf(pv[i]); }
        if (wave < 3) {
#pragma unroll
            for (int bit = 8; bit >= 1; bit >>= 1) {
#pragma unroll
                for (int m = 0; m < bit; ++m) { const bool up = (lane & bit) != 0; const float send = up ? pv[m] : pv[m + bit], keep = up ? pv[m + bit] : pv[m];
                    pv[m] = keep + __shfl_xor(send, bit); }
            }
            const float tot = pv[0] + __shfl_xor(pv[0], 16);
            if ((lane & 16) == 0) { const int i = lane & 15; atomicAdd((float*)LDSP(float, ORS_ + (32 * ti + accrow(i, hh)) * 4), tot); }
        }
    }
    asm volatile("" :: "v"(pf));
    __syncthreads();
    if (tid < 64) ((float*)(a.ws + WS_RS))[task * 64 + tid] = *LDSP(const float, ORS_ + tid * 4);
    if (tid < 256) ((float*)(a.ws + WS_CSK))[task * 256 + tid] = *LDSP(const float, OCS_ + tid * 4);
    __syncthreads();
}

constexpr int NPART = 4, CPP = NCH / NPART;
constexpr size_t WS_SUMH = 2 * MiB;
constexpr size_t WS_DTOT = 14 * MiB;
constexpr size_t WS_SUMM = 484 * MiB;
constexpr size_t WS_SUMN = 508 * MiB;
constexpr size_t WS_SUMS = 508 * MiB + 512 * 1024;
constexpr size_t WS_STATS = 509 * MiB;
constexpr size_t WS_END2 = 510 * MiB;

template <int MODE>
__device__ __forceinline__ void p3b_hgrn(const Args& a, LAS unsigned char* lds, int b, int hp, int part, int tid, int wave, int lane) {
    constexpr unsigned RS = 272, RSA = 144, HB = 62464;
    constexpr unsigned OKE = 17408, OV = 34816, OA = 52224, ODEC = 61440;
    const int hhd = wave >> 2, vb = wave & 3, hl = lane >> 5, c31 = lane & 31;
    const bf16_t* PROJ = (const bf16_t*)(a.ws + WS_PROJ);
    const bf16_t* AH = (const bf16_t*)(a.ws + WS_AH);
    const float* DEC = (const float*)(a.ws + WS_DEC);
    bf16_t* MIX = (bf16_t*)(a.ws + WS_MIX);
    float* SUMH = (float*)(a.ws + WS_SUMH); float* DTOT = (float*)(a.ws + WS_DTOT);
    f32x16 acc[4];
#pragma unroll
    for (int kt = 0; kt < 4; ++kt)
#pragma unroll
        for (int i = 0; i < 16; ++i) acc[kt][i] = 0.f;
    unsigned hb = (unsigned)hhd * HB;
    unsigned o_perm = hb + lp_perm(lane, RS), o_rowA = hb + OA + lp_row(lane, RSA), o_trV = hb + OV + lp_tr(lane, RS) + 64u * vb, o_trK = hb + OKE + lp_tr(lane, RS);
    unsigned o_dec = hb + ODEC + 16u * hl, o_st = hb + 4u * hl * RS + (32u * vb + c31) * 2u;
    const size_t sbase = ((size_t)b * 4 + hp) * 3;
    if (MODE == 1) {
        for (int q = 0; q < part; ++q) {
            __syncthreads();
            if (tid < 256) *LDSP(float, (tid >> 7) * HB + ODEC + (tid & 127) * 4) = DTOT[(sbase + q) * 256 + tid];
            __syncthreads();
            const float* su = SUMH + ((sbase + q) * 2 + hhd) * 16384 + (size_t)(vb * 4) * 1024 + lane;
#pragma unroll
            for (int kt = 0; kt < 4; ++kt)
#pragma unroll
                for (int g4 = 0; g4 < 4; ++g4) { const f32x4 d = *LDSP(const f32x4, o_dec + (32 * kt + 8 * g4) * 4);
#pragma unroll
                    for (int e = 0; e < 4; ++e) acc[kt][4 * g4 + e] = acc[kt][4 * g4 + e] * d[e] + su[kt * 1024 + (4 * g4 + e) * 64]; }
        }
    }
    float dprod = 1.f;
    constexpr int NT = (MODE == 0) ? 8 : 12;
    u32x4 pre[NT], preA[2]; float preD = 0.f;
#define HG_TILE(idx, tile, head, which) const int tile = (MODE == 0) ? ((idx) >> 10) : ((idx) >> 10), head = (MODE == 0) ? (tile >> 1) : (tile / 3), which = (MODE == 0) ? (1 + (tile & 1)) : (tile % 3)
#define HG_ISSUE(cc) do { \
        _Pragma("unroll") for (int i = 0; i < NT; ++i) { const int idx = tl + NTHR * i; HG_TILE(idx, tile, head, which); const int rem = idx & 1023; \
            pre[i] = *(const u32x4*)(PROJ + hg_tile(which, b, (cc), 2 * hp + head) + rem * 8); } \
        if (MODE == 1) { _Pragma("unroll") for (int i = 0; i < 2; ++i) { const int idx = tl + NTHR * i, head = idx >> 9, rem = idx & 511; \
            preA[i] = *(const u32x4*)(AH + (((size_t)b * NCH + (cc)) * 8 + 2 * hp + head) * 4096 + rem * 8); } } \
        if (tl < 256) preD = DEC[(((size_t)b * NCH + (cc)) * 8 + 2 * hp + (tl >> 7)) * 128 + (tl & 127)]; } while (0)
    { int tl = tid; HG_ISSUE(part * CPP); }
    for (int c = part * CPP; c < (part + 1) * CPP; ++c) {
        int tl = tid; asm volatile("" : "+v"(tl));
        asm volatile("" : "+v"(o_perm), "+v"(o_rowA), "+v"(o_trV), "+v"(o_trK), "+v"(o_dec), "+v"(o_st));
        __syncthreads();
#pragma unroll
        for (int i = 0; i < NT; ++i) { const int idx = tl + NTHR * i; HG_TILE(idx, tile, head, which); const int rem = idx & 1023, row = rem >> 4, ch = rem & 15;
            *LDSP(u32x4, head * HB + which * 17408 + row * RS + 16 * ch) = pre[i]; }
        if (MODE == 1) {
#pragma unroll
            for (int i = 0; i < 2; ++i) { const int idx = tl + NTHR * i, head = idx >> 9, rem = idx & 511, row = rem >> 3, ch = rem & 7;
                *LDSP(u32x4, head * HB + OA + row * RSA + 16 * ch) = preA[i]; } }
        if (tl < 256) { *LDSP(float, (tl >> 7) * HB + ODEC + (tl & 127) * 4) = preD; dprod *= preD; }
        __syncthreads();
        if (c + 1 < (part + 1) * CPP) HG_ISSUE(c + 1);
        f32x16 o0, o1; bf16x8 vf[4];
        if (MODE == 1) {
#pragma unroll
            for (int i = 0; i < 16; ++i) { o0[i] = 0.f; o1[i] = 0.f; }
#pragma unroll
            for (int kt = 0; kt < 4; ++kt) {
                { const bf16x8 bf = acc_frag<0>(acc[kt]);
                  o0 = MFMA32(frag_perm(lds, o_perm + 64 * kt), bf, o0); o1 = MFMA32(frag_perm(lds, o_perm + 32 * RS + 64 * kt), bf, o1); }
                { const bf16x8 bf = acc_frag<1>(acc[kt]);
                  o0 = MFMA32(frag_perm(lds, o_perm + 64 * kt + 32), bf, o0); o1 = MFMA32(frag_perm(lds, o_perm + 32 * RS + 64 * kt + 32), bf, o1); }
                asm volatile("" : "+v"(o0), "+v"(o1) :: "memory");
            }
        }
#pragma unroll
        for (int js = 0; js < 4; ++js) vf[js] = frag_tr<RS>(lds, o_trV + 16 * js * RS);
        if (MODE == 1) {
#pragma unroll
            for (int js = 0; js < 4; ++js) { o0 = MFMA32(frag_row(lds, o_rowA + 32 * js), vf[js], o0); o1 = MFMA32(frag_row(lds, o_rowA + 32 * RSA + 32 * js), vf[js], o1); }
            asm volatile("" : "+v"(o0), "+v"(o1) :: "memory");
        }
#pragma unroll
        for (int kt = 0; kt < 4; ++kt) {
#pragma unroll
            for (int g4 = 0; g4 < 4; ++g4) { const f32x4 d = *LDSP(const f32x4, o_dec + (32 * kt + 8 * g4) * 4);
                acc[kt][4 * g4 + 0] *= d.x; acc[kt][4 * g4 + 1] *= d.y; acc[kt][4 * g4 + 2] *= d.z; acc[kt][4 * g4 + 3] *= d.w; }
            asm volatile("" : "+v"(acc[kt]) :: "memory"); }
#pragma unroll
        for (int kt = 0; kt < 4; ++kt) {
#pragma unroll
            for (int js = 0; js < 4; ++js) acc[kt] = MFMA32(frag_tr<RS>(lds, o_trK + 16 * js * RS + 64 * kt), vf[js], acc[kt]);
            asm volatile("" : "+v"(acc[kt]) :: "memory"); }
        if (MODE == 1) {
            __builtin_amdgcn_sched_barrier(0);
            __syncthreads();
#pragma unroll
            for (int i = 0; i < 16; ++i) {
                *LDSP(bf16_t, o_st + ACCROW0(i) * RS) = f2bf(o0[i]);
                *LDSP(bf16_t, o_st + (32 + ACCROW0(i)) * RS) = f2bf(o1[i]);
            }
            __syncthreads();
            const size_t r0 = (size_t)b * TP + (size_t)c * 64;
#pragma unroll
            for (int i = 0; i < 4; ++i) { const int idx = tl + NTHR * i, head = idx >> 10, rem = idx & 1023, row = rem >> 4, ch = rem & 15;
                const u32x4 w = *LDSP(const u32x4, head * HB + row * RS + 16 * ch);
                float v[8] = {bflo(w.x), bfhi(w.x), bflo(w.y), bfhi(w.y), bflo(w.z), bfhi(w.z), bflo(w.w), bfhi(w.w)};
                float ss = 0.f;
#pragma unroll
                for (int e = 0; e < 8; ++e) ss += v[e] * v[e];
                ss += __shfl_xor(ss, 1); ss += __shfl_xor(ss, 2); ss += __shfl_xor(ss, 4); ss += __shfl_xor(ss, 8);
                const float rn = 1.0f / sqrtf(ss * (1.f / 128.f) + EPS);
                const int col = (2 * hp + head) * 128 + 8 * ch;
                const u32x4 z = *(const u32x4*)(PROJ + hg_tile(3, b, c, 2 * hp + head) + rem * 8);
                const f32x4 g0 = *(const f32x4*)(a.hnorm_g + col), g1 = *(const f32x4*)(a.hnorm_g + col + 4);
                u32x4 o; o.x = pk2(v[0] * rn * g0.x * bflo(z.x), v[1] * rn * g0.y * bfhi(z.x)); o.y = pk2(v[2] * rn * g0.z * bflo(z.y), v[3] * rn * g0.w * bfhi(z.y));
                o.z = pk2(v[4] * rn * g1.x * bflo(z.z), v[5] * rn * g1.y * bfhi(z.z)); o.w = pk2(v[6] * rn * g1.z * bflo(z.w), v[7] * rn * g1.w * bfhi(z.w));
                *(u32x4*)(MIX + (r0 + row) * DMIX + col) = o;
            }
        }
    }
    if (MODE == 0) {
        float* su = SUMH + ((sbase + part) * 2 + hhd) * 16384 + (size_t)(vb * 4) * 1024 + lane;
#pragma unroll
        for (int kt = 0; kt < 4; ++kt)
#pragma unroll
            for (int i = 0; i < 16; ++i) su[kt * 1024 + i * 64] = acc[kt][i];
        if (tid < 256) DTOT[(sbase + part) * 256 + tid] = dprod;
    } else if (part == NPART - 1) {
        float* SP = a.out + O_HP + ((size_t)b * 8 + 2 * hp + hhd) * 128 * 128 + (size_t)(4 * hl) * 128 + 32 * vb + c31;
#pragma unroll
        for (int kt = 0; kt < 4; ++kt)
#pragma unroll
            for (int i = 0; i < 16; ++i) SP[(size_t)(32 * kt + ACCROW0(i)) * 128] = acc[kt][i];
    }
    __syncthreads();
#undef HG_TILE
#undef HG_ISSUE
}

template <int MODE>
__device__ __forceinline__ void p3b_mlstm(const Args& a, LAS unsigned char* lds, int b, int h, int part, int tid, int wave, int lane) {
    constexpr unsigned RS = 528;
    constexpr unsigned OKE = (MODE == 1) ? 33792u : 0u, OV = OKE + 32768u, OA = OV + 32768u;
    constexpr unsigned ON = (MODE == 1) ? OA + 8192u : 131072u, OD = ON + 1024, OBT = OD + 256, ORS = OBT + 256, OCS = ORS + 256, OSTG = OCS + 1024 + 256;
    static_assert(MODE == 0 || OSTG + 64 * RS <= (unsigned)MISC_OFF, "LDS layout");
    const int hl = lane >> 5, c31 = lane & 31;
    const bf16_t* PROJ = (const bf16_t*)(a.ws + WS_PROJ);
    const bf16_t* QM = (const bf16_t*)(a.ws + WS_QM); const bf16_t* KM = (const bf16_t*)(a.ws + WS_KM); const bf16_t* VM = (const bf16_t*)(a.ws + WS_VM); const bf16_t* XC = (const bf16_t*)(a.ws + WS_XC);
    const bf16_t* AM = (const bf16_t*)(a.ws + WS_AM);
    bf16_t* MIX = (bf16_t*)(a.ws + WS_MIX);
    float* SUMM = (float*)(a.ws + WS_SUMM); float* SUMN = (float*)(a.ws + WS_SUMN); float* SUMS = (float*)(a.ws + WS_SUMS);
    f32x16 acc[8];
#pragma unroll
    for (int kt = 0; kt < 8; ++kt)
#pragma unroll
        for (int i = 0; i < 16; ++i) acc[kt][i] = 0.f;
    if (tid < 256) *LDSP(float, ON + tid * 4) = 0.f;
    float mu = 0.f, mrun = (MODE == 0) ? -1e30f : 0.f, bsum = 0.f;
    const size_t sbase = ((size_t)b * 4 + h) * 3;
    if (MODE == 1 && part > 0) {
        float muU[3], Bq[3], Mq[3], cq[3];
#pragma unroll
        for (int q = 0; q < 3; ++q) { const float* s3 = SUMS + (sbase + (q < part ? q : 0)) * 4; muU[q] = s3[0]; Bq[q] = s3[1]; Mq[q] = s3[2]; }
        float sb = 0.f, mus = -1e30f, e[3];
#pragma unroll
        for (int q = 2; q >= 0; --q) { if (q < part) { e[q] = muU[q] + sb; mus = fmaxf(mus, e[q]); sb += Bq[q]; } else e[q] = -1e30f; }
#pragma unroll
        for (int q = 0; q < 3; ++q) { cq[q] = (q < part) ? __expf(e[q] - mus) : 0.f; if (q < part) mrun = fmaxf(mrun + Bq[q], Mq[q]); }
        mu = mus;
        const float* su0 = SUMM + (sbase + 0) * 65536 + (size_t)(wave * 8) * 1024 + lane * 16;
#pragma unroll
        for (int kp = 0; kp < 4; ++kp) {
            f32x4 t[3][2][4];
#pragma unroll
            for (int q = 0; q < 3; ++q) { const float* su = su0 + (size_t)(q < part ? q : 0) * 65536;
#pragma unroll
                for (int k2 = 0; k2 < 2; ++k2)
#pragma unroll
                    for (int g = 0; g < 4; ++g) t[q][k2][g] = *(const f32x4*)(su + (2 * kp + k2) * 1024 + 4 * g); }
#pragma unroll
            for (int k2 = 0; k2 < 2; ++k2)
#pragma unroll
                for (int g = 0; g < 4; ++g)
#pragma unroll
                    for (int e4 = 0; e4 < 4; ++e4) acc[2 * kp + k2][4 * g + e4] = cq[0] * t[0][k2][g][e4] + cq[1] * t[1][k2][g][e4] + cq[2] * t[2][k2][g][e4];
            asm volatile("" : "+v"(acc[2 * kp]), "+v"(acc[2 * kp + 1]) :: "memory");
        }
        if (tid < 256) { float n = 0.f;
#pragma unroll
            for (int q = 0; q < 3; ++q) n += cq[q] * SUMN[(sbase + (q < part ? q : 0)) * 256 + tid];
            *LDSP(float, ON + tid * 4) = n; }
    }
    const unsigned xs_ = (unsigned)((c31 >> 1) & 7);
    const unsigned fb_ = (unsigned)c31 * 128u + (((unsigned)hl ^ (xs_ & 1u)) << 4) + ((xs_ >> 1) << 5);
    unsigned o_perm = lp_perm(lane, RS), o_rowA = OA + fb_, o_trV = OV + 4096u * (unsigned)wave + fb_, o_trK = OKE + fb_;
    unsigned o_st = OSTG + 4u * hl * RS + (32u * wave + c31) * 2u, o_h = 16u * hl;
    const int c_end = (part + 1) * CPP;
    float preRL = 0.f, preC = 0.f, preBL = 0.f;
#define ML_DMA_TILE(gsrc, ldsoff, n) do { const char* g_ = (const char*)(gsrc) + vK; \
        _Pragma("unroll") for (int i_ = 0; i_ < (n); ++i_) __builtin_amdgcn_global_load_lds((const unsigned*)(g_ + i_ * 8192), (LAS unsigned*)(lds + (ldsoff) + i_ * 8192u + 1024u * (unsigned)wave), 16, 0, 0); } while (0)
#define ML_ISSUE(cc, bufo) do { const size_t task_ = ((size_t)b * NCH + (cc)) * 4 + h; \
        const unsigned vK = (unsigned)(tl >> 3) * 128u + ((((unsigned)tl & 7u) ^ (((unsigned)tl >> 4) & 7u)) << 4); \
        ML_DMA_TILE(KM + (task_ << 14), (bufo) + OKE, 4); ML_DMA_TILE(VM + (task_ << 14), (bufo) + OV, 4); \
        if (MODE == 1) { ML_DMA_TILE(AM + task_ * 4096, OA, 1); \
            if (wave < 4) __builtin_amdgcn_global_load_lds((const unsigned*)((const float*)(a.ws + WS_CSK) + task_ * 256 + (tl & 255)), (LAS unsigned*)(lds + OCS + 256u * (unsigned)wave), 4, 0, 0); \
            else if (wave == 4) __builtin_amdgcn_global_load_lds((const unsigned*)((const float*)(a.ws + WS_BT) + task_ * 64 + (tl & 63)), (LAS unsigned*)(lds + OBT), 4, 0, 0); \
            else if (wave == 5) __builtin_amdgcn_global_load_lds((const unsigned*)((const float*)(a.ws + WS_RS) + task_ * 64 + (tl & 63)), (LAS unsigned*)(lds + ORS), 4, 0, 0); \
            _Pragma("unroll") for (int i_ = 0; i_ < 5; ++i_) { if (i_ < 4 || wave == 0) { const unsigned q_ = 512u * i_ + (unsigned)tl, row_ = (q_ * 1986u) >> 16; unsigned cp_ = q_ - 33u * row_; cp_ = cp_ > 31u ? 31u : cp_;   \
                __builtin_amdgcn_global_load_lds((const unsigned*)((const char*)(QM + (task_ << 14)) + (row_ * 32u + cp_) * 16u), (LAS unsigned*)(lds + i_ * 8192u + 1024u * (unsigned)wave), 16, 0, 0); } } } \
        else { preC = ((const float*)(a.ws + WS_CSK))[task_ * 256 + (tl & 255)]; preBL = ((const float*)(a.ws + WS_BT))[task_ * 64 + 63]; } \
        preRL = ((const float*)(a.ws + WS_RL))[task_]; } while (0)
    __syncthreads();
    { int tl = tid; asm volatile("" : "+v"(tl)); ML_ISSUE(part * CPP, 0u); }
    for (int c = part * CPP; c < c_end; ++c) {
        int tl = tid; asm volatile("" : "+v"(tl));
        asm volatile("" : "+v"(o_perm), "+v"(o_rowA), "+v"(o_trV), "+v"(o_trK), "+v"(o_st), "+v"(o_h));
        const size_t r0 = (size_t)b * TP + (size_t)c * 64;
        const size_t task = ((size_t)b * NCH + c) * 4 + h;
        const float R = preRL, cskv = preC, bL0 = preBL;
        if (MODE == 1) {
            if (c == part * CPP) asm volatile("s_waitcnt vmcnt(0)" ::: "memory"); else asm volatile("s_waitcnt vmcnt(4)" ::: "memory");
        } else asm volatile("s_waitcnt vmcnt(0)" ::: "memory");
        __syncthreads();
        const unsigned bo = (MODE == 0) ? (unsigned)((c - part * CPP) & 1) * 65536u : 0u;
        if (MODE == 0) { if (c + 1 < c_end) ML_ISSUE(c + 1, 65536u - bo); }
        const float sc = __expf(mu - R);
        f32x16 o0, o1; bf16x8 vf[4];
        if (MODE == 1) {
            { const int t = tl >> 3, sub = tl & 7; float p = 0.f;
#pragma unroll
              for (int j = 0; j < 4; ++j) { const u32x4 w = *LDSP(const u32x4, t * RS + (sub * 32 + 8 * j) * 2);
                  const f32x4 n0 = *LDSP(const f32x4, ON + (sub * 32 + 8 * j) * 4), n1 = *LDSP(const f32x4, ON + (sub * 32 + 8 * j + 4) * 4);
                  p += bflo(w.x) * n0.x + bfhi(w.x) * n0.y + bflo(w.y) * n0.z + bfhi(w.y) * n0.w + bflo(w.z) * n1.x + bfhi(w.z) * n1.y + bflo(w.w) * n1.z + bfhi(w.w) * n1.w; }
              p += __shfl_xor(p, 1); p += __shfl_xor(p, 2); p += __shfl_xor(p, 4);
              if (sub == 0) { const float den = fmaxf(fabsf(sc * p + *LDSP(const float, ORS + t * 4)), __expf(-(*LDSP(const float, OBT + t * 4) + R)));
                  *LDSP(float, OD + t * 4) = __builtin_amdgcn_rcpf(den); } }
        }
#pragma unroll
        for (int kt = 0; kt < 8; ++kt)
#pragma unroll
            for (int i = 0; i < 16; ++i) acc[kt][i] *= sc;
        if (MODE == 1) {
#pragma unroll
            for (int i = 0; i < 16; ++i) { o0[i] = 0.f; o1[i] = 0.f; }
#pragma unroll
            for (int kt = 0; kt < 8; ++kt) {
                { const bf16x8 bf = acc_frag<0>(acc[kt]);
                  o0 = MFMA32(frag_perm(lds, o_perm + 64 * kt), bf, o0); o1 = MFMA32(frag_perm(lds, o_perm + 32 * RS + 64 * kt), bf, o1); }
                { const bf16x8 bf = acc_frag<1>(acc[kt]);
                  o0 = MFMA32(frag_perm(lds, o_perm + 64 * kt + 32), bf, o0); o1 = MFMA32(frag_perm(lds, o_perm + 32 * RS + 64 * kt + 32), bf, o1); }
                asm volatile("" : "+v"(o0), "+v"(o1) :: "memory");
            }
        }
#pragma unroll
        for (int js = 0; js < 4; ++js) vf[js] = frag_row(lds, ((o_trV + bo) ^ (32u * js)));
        if (MODE == 1) {
#pragma unroll
            for (int js = 0; js < 4; ++js) { const unsigned oa = o_rowA ^ (32u * js); o0 = MFMA32(frag_row(lds, oa), vf[js], o0); o1 = MFMA32(frag_row(lds, oa + 4096u), vf[js], o1); }
            asm volatile("" : "+v"(o0), "+v"(o1) :: "memory");
        }
        { unsigned okj[4];
#pragma unroll
          for (int js = 0; js < 4; ++js) okj[js] = (o_trK + bo) ^ (32u * js);
#pragma unroll
          for (int kt = 0; kt < 8; ++kt) {
#pragma unroll
            for (int js = 0; js < 4; ++js) acc[kt] = MFMA32(frag_row(lds, okj[js] + 4096u * kt), vf[js], acc[kt]);
            asm volatile("" : "+v"(acc[kt]) :: "memory"); } }
        const float bL = (MODE == 1) ? *LDSP(const float, OBT + 63 * 4) : bL0;
#ifndef RPN
#define RPN 2
#endif
        u32x4 rpm[4], rpz[4], rpx[4];
        if (MODE == 1) {
#pragma unroll
            for (int i = 0; i < RPN; ++i) { const int idx = tl + NTHR * i;
                rpm[i] = *(const u32x4*)(PROJ + ml_tile(6, b, c, h) + idx * 8);
                rpz[i] = *(const u32x4*)(PROJ + ml_tile(5, b, c, h) + idx * 8);
                rpx[i] = *(const u32x4*)(XC + (task << 14) + idx * 8); }
        }
        if (MODE == 0) { if (tl < 256) *LDSP(float, ON + tl * 4) = sc * *LDSP(const float, ON + tl * 4) + cskv; }
        if (MODE == 1) {
            __builtin_amdgcn_sched_barrier(0);
            __syncthreads();
            if (tl < 256) *LDSP(float, ON + tl * 4) = sc * *LDSP(const float, ON + tl * 4) + *LDSP(const float, OCS + tl * 4);
            if (c + 1 < c_end) ML_ISSUE(c + 1, 0u);
#pragma unroll
            for (int g4 = 0; g4 < 4; ++g4) {
                const f32x4 d0 = *LDSP(const f32x4, OD + o_h + 32 * g4), d1 = *LDSP(const f32x4, OD + o_h + 128 + 32 * g4);
#pragma unroll
                for (int e = 0; e < 4; ++e) {
                    *LDSP(bf16_t, o_st + (8 * g4 + e) * RS) = f2bf(o0[4 * g4 + e] * d0[e]);
                    *LDSP(bf16_t, o_st + (32 + 8 * g4 + e) * RS) = f2bf(o1[4 * g4 + e] * d1[e]);
                }
            }
            __syncthreads();
#pragma unroll
            for (int i = 0; i < 4; ++i) { const int idx = tl + NTHR * i, row = idx >> 5, ch = idx & 31, col = h * 256 + 8 * ch;
                const u32x4 w = *LDSP(const u32x4, OSTG + row * RS + 16 * ch);
                const u32x4 mo = (i < RPN) ? rpm[i] : *(const u32x4*)(PROJ + ml_tile(6, b, c, h) + idx * 8);
                float v[8] = {bflo(w.x) * bflo(mo.x), bfhi(w.x) * bfhi(mo.x), bflo(w.y) * bflo(mo.y), bfhi(w.y) * bfhi(mo.y), bflo(w.z) * bflo(mo.z), bfhi(w.z) * bfhi(mo.z), bflo(w.w) * bflo(mo.w), bfhi(w.w) * bfhi(mo.w)};
                float ss = 0.f;
#pragma unroll
                for (int e = 0; e < 8; ++e) ss += v[e] * v[e];
                ss += __shfl_xor(ss, 1); ss += __shfl_xor(ss, 2); ss += __shfl_xor(ss, 4); ss += __shfl_xor(ss, 8); ss += __shfl_xor(ss, 16);
                const float rn = 1.0f / sqrtf(ss * (1.f / 256.f) + EPS);
                const u32x4 z = (i < RPN) ? rpz[i] : *(const u32x4*)(PROJ + ml_tile(5, b, c, h) + idx * 8);
                const u32x4 xc = (i < RPN) ? rpx[i] : *(const u32x4*)(XC + (task << 14) + idx * 8);
                const f32x4 g0 = *(const f32x4*)(a.mnorm_g + col), g1 = *(const f32x4*)(a.mnorm_g + col + 4), k0 = *(const f32x4*)(a.skip + col), k1 = *(const f32x4*)(a.skip + col + 4);
                u32x4 o;
                o.x = pk2((v[0] * rn * g0.x + k0.x * bflo(xc.x)) * bflo(z.x), (v[1] * rn * g0.y + k0.y * bfhi(xc.x)) * bfhi(z.x));
                o.y = pk2((v[2] * rn * g0.z + k0.z * bflo(xc.y)) * bflo(z.y), (v[3] * rn * g0.w + k0.w * bfhi(xc.y)) * bfhi(z.y));
                o.z = pk2((v[4] * rn * g1.x + k1.x * bflo(xc.z)) * bflo(z.z), (v[5] * rn * g1.y + k1.y * bfhi(xc.z)) * bfhi(z.z));
                o.w = pk2((v[6] * rn * g1.z + k1.z * bflo(xc.w)) * bflo(z.w), (v[7] * rn * g1.w + k1.w * bfhi(xc.w)) * bfhi(z.w));
                *(u32x4*)(MIX + (r0 + row) * DMIX + 1024 + col) = o;
            }
        }
        mu = bL + R; mrun = bL + fmaxf(mrun, R); bsum += bL;
    }
    __syncthreads();
    if (MODE == 0) {
        float* su = SUMM + (sbase + part) * 65536 + (size_t)(wave * 8) * 1024 + lane * 16;
#pragma unroll
        for (int kt = 0; kt < 8; ++kt)
#pragma unroll
            for (int g = 0; g < 4; ++g) *(f32x4*)(su + kt * 1024 + 4 * g) = (f32x4){acc[kt][4 * g], acc[kt][4 * g + 1], acc[kt][4 * g + 2], acc[kt][4 * g + 3]};
        if (tid < 256) SUMN[(sbase + part) * 256 + tid] = *LDSP(const float, ON + tid * 4);
        if (tid == 0) { float* s3 = SUMS + (sbase + part) * 4; s3[0] = mu; s3[1] = bsum; s3[2] = mrun; }
    } else if (part == NPART - 1) {
        const float fs = __expf(mu - mrun);
        float* CP = a.out + O_CP + ((size_t)b * 4 + h) * 65536 + (size_t)(4 * hl) * 256 + 32 * wave + c31;
#pragma unroll
        for (int kt = 0; kt < 8; ++kt)
#pragma unroll
            for (int i = 0; i < 16; ++i) CP[(size_t)(32 * kt + ACCROW0(i)) * 256] = acc[kt][i] * fs;
        if (tid < 256) a.out[O_NP + ((size_t)b * 4 + h) * 256 + tid] = *LDSP(const float, ON + tid * 4) * fs;
        if (tid == 0) a.out[O_MP + b * 4 + h] = mrun;
    }
    __syncthreads();
#undef ML_ISSUE
#undef ML_DMA_TILE
}

__device__ __forceinline__ void p3b_sample_hgrn(const Args& a, LAS unsigned char* lds, int b, int h, int tid, int wave, int lane) {
    LAS float* sq = (LAS float*)lds; LAS float* sf = sq + 512; LAS float* sk = sf + 512; LAS float* sv = sk + 512;
    LAS float* sPO = sv + 512;
    const bf16_t* PROJ = (const bf16_t*)(a.ws + WS_PROJ) + PS_OFF - (size_t)MP * NPROJ;   const float* LOGFS = (const float*)(a.ws + WS_LOGFS);
    const size_t rb = (size_t)MP + (size_t)b * 4;
    const int vq = tid & 31, kr = tid >> 5;
    const float* S0 = a.st_h + ((size_t)b * 8 + h) * 16384; float* S1 = a.out + O_HS + ((size_t)b * 8 + h) * 16384;
    f32x4 S[8];
#pragma unroll
    for (int i = 0; i < 8; ++i) S[i] = __builtin_nontemporal_load((const f32x4*)(S0 + (size_t)(kr + 16 * i) * 128 + 4 * vq));
    __syncthreads();
    { const int t = tid >> 7, k = tid & 127; const float f = __expf(LOGFS[((size_t)b * 4 + t) * 1024 + h * 128 + k]);
      sf[tid] = f; sk[tid] = 1.f - f; sq[tid] = bf2f(PROJ[(rb + t) * NPROJ + h * 128 + k]); sv[tid] = bf2f(PROJ[(rb + t) * NPROJ + 2048 + h * 128 + k]); }
    __syncthreads();
    f32x4 vv[4], po[4];
#pragma unroll
    for (int t = 0; t < 4; ++t) { vv[t] = *(const LAS f32x4*)(sv + t * 128 + 4 * vq); po[t] = (f32x4){0.f, 0.f, 0.f, 0.f}; }
#pragma unroll
    for (int i = 0; i < 8; ++i) { const int k = kr + 16 * i;
#pragma unroll
        for (int t = 0; t < 4; ++t) { S[i] = S[i] * sf[t * 128 + k] + vv[t] * sk[t * 128 + k]; po[t] += S[i] * sq[t * 128 + k]; }
        __builtin_nontemporal_store(S[i], (f32x4*)(S1 + (size_t)k * 128 + 4 * vq)); }
#pragma unroll
    for (int t = 0; t < 4; ++t) *(LAS f32x4*)(sPO + (kr * 4 + t) * 128 + 4 * vq) = po[t];
    __syncthreads();
    if (wave < 4) { const int t = wave; float o[2]; float ss = 0.f;
#pragma unroll
        for (int j = 0; j < 2; ++j) { const int v = lane + 64 * j; float s = 0.f;
#pragma unroll
            for (int r = 0; r < 16; ++r) s += sPO[(r * 4 + t) * 128 + v];
            o[j] = s; ss += s * s; }
        ss = wave_sum(ss); const float rn = 1.0f / sqrtf(ss * (1.f / 128.f) + EPS);
#pragma unroll
        for (int j = 0; j < 2; ++j) { const int col = h * 128 + lane + 64 * j;
            const float z = bf2f(PROJ[(rb + t) * NPROJ + 3072 + col]);
            ((bf16_t*)(a.ws + WS_MIX))[(rb + t) * DMIX + col] = f2bf(o[j] * rn * a.hnorm_g[col] * z); }
    }
}
__device__ __forceinline__ void p3b_sample_mlstm(const Args& a, LAS unsigned char* lds, int b, int h, int tid, int wave, int lane) {
    LAS float* sxc = (LAS float*)lds; LAS float* sq = sxc + 1024; LAS float* sk = sq + 1024; LAS float* sv = sk + 1024;
    LAS float* sDen = sv + 1024;
    LAS float* sPN = sDen + 16;
    LAS float* sA4 = sPN + 8192;
    LAS float* sB4 = sA4 + 1024;
    LAS float* sMM = sB4 + 1024;
    const bf16_t* PROJ = (const bf16_t*)(a.ws + WS_PROJ) + PS_OFF - (size_t)MP * NPROJ;   const float* GATE = (const float*)(a.ws + WS_GATE);
    const size_t rb = (size_t)MP + (size_t)b * 4;
    const int vq = tid & 63, kr = tid >> 6;
    const float* C0 = a.st_C + ((size_t)b * 4 + h) * 65536; float* C1 = a.out + O_CS + ((size_t)b * 4 + h) * 65536;
    f32x4 C[16];
#pragma unroll
    for (int i = 0; i < 16; ++i) C[i] = __builtin_nontemporal_load((const f32x4*)(C0 + (size_t)(kr + 8 * i) * 256 + 4 * vq));
    __syncthreads();
    if (tid < 256) {
        const int t = tid >> 6, g = tid & 63, ch = h * 256 + 4 * g, gg = h * 64 + g;
        float e[4][4];
#pragma unroll
        for (int w = 0; w < 4; ++w) { const int idx = t + w;
            if (idx < 3) { const f32x4 x = *(const f32x4*)(a.st_conv + ((size_t)b * 3 + idx) * 1024 + ch); e[w][0] = x.x; e[w][1] = x.y; e[w][2] = x.z; e[w][3] = x.w; }
            else { const u32x2 x = *(const u32x2*)(PROJ + (rb + idx - 3) * NPROJ + 4096 + ch); e[w][0] = bflo(x.x); e[w][1] = bfhi(x.x); e[w][2] = bflo(x.y); e[w][3] = bfhi(x.y); } }
        float xc[4];
#pragma unroll
        for (int i = 0; i < 4; ++i) { float cv = a.conv_b[ch + i];
#pragma unroll
            for (int w = 0; w < 4; ++w) cv += a.conv_w[w * 1024 + ch + i] * e[w][i];
            xc[i] = cv * sigmoidf_(cv); }
#pragma unroll
        for (int j = 0; j < 4; ++j) { float q = 0.f, k = 0.f, v = 0.f;
#pragma unroll
            for (int i = 0; i < 4; ++i) { q += xc[i] * a.wq[gg * 16 + 4 * i + j]; k += xc[i] * a.wk[gg * 16 + 4 * i + j]; v += e[3][i] * a.wv[gg * 16 + 4 * i + j]; }
            sxc[t * 256 + 4 * g + j] = xc[j]; sq[t * 256 + 4 * g + j] = q; sk[t * 256 + 4 * g + j] = k * 0.0625f; sv[t * 256 + 4 * g + j] = v; }
        if (t == 3) {
#pragma unroll
            for (int j = 0; j < 3; ++j) *(f32x4*)(a.out + O_VS + ((size_t)b * 3 + j) * 1024 + ch) = (f32x4){e[1 + j][0], e[1 + j][1], e[1 + j][2], e[1 + j][3]};
        }
    }
    float fd[4], iw[4], mt[4];
    { float m = a.st_m[b * 4 + h];
#pragma unroll
      for (int t = 0; t < 4; ++t) { const float ig = GATE[(rb + t) * 8 + h], lf = GATE[(rb + t) * 8 + 4 + h]; const float mn = fmaxf(lf + m, ig);
          fd[t] = __expf(lf + m - mn); iw[t] = __expf(ig - mn); mt[t] = mn; m = mn; } }
    __syncthreads();
    const float P0 = fd[0], P1 = P0 * fd[1], P2 = P1 * fd[2], P3 = P2 * fd[3];
    if (tid < 256) { float n = a.st_n[((size_t)b * 4 + h) * 256 + tid]; float pd[4];
        const float q0 = sq[tid], q1 = sq[256 + tid], q2 = sq[512 + tid], q3 = sq[768 + tid], k0 = sk[tid], k1 = sk[256 + tid], k2 = sk[512 + tid], k3 = sk[768 + tid];
#pragma unroll
        for (int t = 0; t < 4; ++t) { n = fd[t] * n + iw[t] * sk[t * 256 + tid]; pd[t] = sq[t * 256 + tid] * n; }
        a.out[O_NS + ((size_t)b * 4 + h) * 256 + tid] = n;
#pragma unroll
        for (int t = 0; t < 4; ++t) { const float s = wave_sum(pd[t]); if (lane == 0) sDen[wave * 4 + t] = s; }
        *(LAS f32x4*)(sA4 + 4 * tid) = (f32x4){q0 * P0, q1 * P1, q2 * P2, q3 * P3};
        *(LAS f32x4*)(sB4 + 4 * tid) = (f32x4){k0 * (fd[1] * fd[2] * fd[3]), k1 * (fd[2] * fd[3]), k2 * fd[3], k3};
        const float d[10] = {q0 * k0, q1 * k0, q1 * k1, q2 * k0, q2 * k1, q2 * k2, q3 * k0, q3 * k1, q3 * k2, q3 * k3};
#pragma unroll
        for (int m = 0; m < 10; ++m) { const float s = wave_sum(d[m]); if (lane == 0) sMM[wave * 10 + m] = s; } }
    f32x4 vv[4], pn[4];
#pragma unroll
    for (int t = 0; t < 4; ++t) { vv[t] = *(const LAS f32x4*)(sv + t * 256 + 4 * vq) * iw[t]; pn[t] = (f32x4){0.f, 0.f, 0.f, 0.f}; }
    __syncthreads();
    f32x4 An = *(const LAS f32x4*)(sA4 + 4 * kr), Bn = *(const LAS f32x4*)(sB4 + 4 * kr);
#pragma unroll
    for (int i = 0; i < 32; ++i) { const int k = kr + 8 * i, ci = i & 15;
        const f32x4 A4 = An, B4 = Bn;
        if (i + 1 < 32) { An = *(const LAS f32x4*)(sA4 + 4 * (k + 8)); Bn = *(const LAS f32x4*)(sB4 + 4 * (k + 8)); }
        asm volatile("" ::: "memory");
        pn[0] += C[ci] * A4.x; pn[1] += C[ci] * A4.y; pn[2] += C[ci] * A4.z; pn[3] += C[ci] * A4.w;
        C[ci] = C[ci] * P3 + vv[0] * B4.x + vv[1] * B4.y + vv[2] * B4.z + vv[3] * B4.w;
        __builtin_nontemporal_store(C[ci], (f32x4*)(C1 + (size_t)k * 256 + 4 * vq));
        if (i < 16) C[ci] = __builtin_nontemporal_load((const f32x4*)(C0 + (size_t)(k + 128) * 256 + 4 * vq)); }
#pragma unroll
    for (int t = 0; t < 4; ++t) *(LAS f32x4*)(sPN + (kr * 4 + t) * 256 + 4 * vq) = pn[t];
    __syncthreads();
    if (wave < 4) { const int t = wave;
        const float den = sDen[t] + sDen[4 + t] + sDen[8 + t] + sDen[12 + t];
        const float hden = fmaxf(fabsf(den), __expf(-mt[t]));
        float mm[4];
#pragma unroll
        for (int j = 0; j < 4; ++j) { float gpr = iw[j];
#pragma unroll
            for (int m = 1; m < 4; ++m) if (m > j && m <= t) gpr *= fd[m];
            const int mi = (t * (t + 1)) / 2 + (j <= t ? j : 0);
            mm[j] = (j <= t) ? gpr * (sMM[mi] + sMM[10 + mi] + sMM[20 + mi] + sMM[30 + mi]) : 0.f; }
        float hm[4]; float ss = 0.f;
#pragma unroll
        for (int j = 0; j < 4; ++j) { const int v = lane + 64 * j; float s = 0.f;
#pragma unroll
            for (int r = 0; r < 8; ++r) s += sPN[(r * 4 + t) * 256 + v];
            s += mm[0] * sv[v] + mm[1] * sv[256 + v] + mm[2] * sv[512 + v] + mm[3] * sv[768 + v];
            hm[j] = s / hden * bf2f(PROJ[(rb + t) * NPROJ + 6144 + h * 256 + v]); ss += hm[j] * hm[j]; }
        ss = wave_sum(ss); const float rn = 1.0f / sqrtf(ss * (1.f / 256.f) + EPS);
#pragma unroll
        for (int j = 0; j < 4; ++j) { const int v = lane + 64 * j, col = h * 256 + v;
            const float z = bf2f(PROJ[(rb + t) * NPROJ + 5120 + col]);
            ((bf16_t*)(a.ws + WS_MIX))[(rb + t) * DMIX + 1024 + col] = f2bf((hm[j] * rn * a.mnorm_g[col] + a.skip[col] * sxc[t * 256 + v]) * z); }
        if (t == 3 && lane == 0) a.out[O_MS + b * 4 + h] = mt[3];
    }
}

typedef float f32x4v __attribute__((ext_vector_type(4)));
__device__ __forceinline__ void small_gemm_out(const Args& a, int vcu, int G, int wave, int lane, unsigned* cnt_s) {
    const bf16_t* MIX = (const bf16_t*)(a.ws + WS_MIX); const bf16_t* WoutT = (const bf16_t*)(a.ws + WS_WOUT); const float* MOD = (const float*)(a.ws + WS_MOD);
    const int r = lane & 15, kq = lane >> 4;
    for (int t = vcu * NWAVES + wave; t < 32 * 64; t += G * NWAVES) {
        const int mt = t >> 6, nt = t & 63;
        const bf16_t* ap = MIX + (size_t)(MP + 16 * mt + r) * DMIX + 8 * kq;
        const bf16_t* bp = WoutT + (size_t)(16 * nt + r) * DMIX + 8 * kq;
        f32x4v acc = {0.f, 0.f, 0.f, 0.f};
        bf16x8 af[8], bfr[8], an[8], bn[8];
#pragma unroll
        for (int j = 0; j < 8; ++j) { af[j] = *(const bf16x8*)(ap + 32 * j); bfr[j] = *(const bf16x8*)(bp + 32 * j); }
#pragma unroll 1
        for (int k0 = 0; k0 < DMIX; k0 += 512) {
#pragma unroll
            for (int j = 0; j < 8; ++j) { an[j] = *(const bf16x8*)(ap + k0 + 256 + 32 * j); bn[j] = *(const bf16x8*)(bp + k0 + 256 + 32 * j); }
#pragma unroll
            for (int j = 0; j < 8; ++j) acc = __builtin_amdgcn_mfma_f32_16x16x32_bf16(af[j], bfr[j], acc, 0, 0, 0);
            const int kn = (k0 + 512 < DMIX) ? k0 + 512 : k0;
#pragma unroll
            for (int j = 0; j < 8; ++j) { af[j] = *(const bf16x8*)(ap + kn + 32 * j); bfr[j] = *(const bf16x8*)(bp + kn + 32 * j); }
#pragma unroll
            for (int j = 0; j < 8; ++j) acc = __builtin_amdgcn_mfma_f32_16x16x32_bf16(an[j], bn[j], acc, 0, 0, 0);
        }
        const int col = 16 * nt + r;
#pragma unroll
        for (int i = 0; i < 4; ++i) { const int row = 16 * mt + 4 * kq + i;
            const float g = MOD[(size_t)(BP + (row >> 2)) * 3072 + 2048 + col];
            const float v = a.x_s[(size_t)row * DM + col] + g * acc[i];
            if (cnt_s) store_wt_f32(a.out + O_Y + (size_t)(MP + row) * DM + col, v); else a.out[O_Y + (size_t)(MP + row) * DM + col] = v; }
        if (cnt_s) { asm volatile("s_waitcnt vmcnt(0)" ::: "memory"); if (lane == 0) (void)xb_add(cnt_s + 64 * mt, 1u); }
    }
}
__device__ __forceinline__ void rms_row_inplace(const Args& a, size_t r, int lane) {
    float* yr = a.out + O_Y + r * DM;
    f32x4 v[4]; float s = 0.f;
#pragma unroll
    for (int j = 0; j < 4; ++j) { v[j] = *(const f32x4*)(yr + 4 * lane + 256 * j); s += (v[j].x * v[j].x + v[j].y * v[j].y) + (v[j].z * v[j].z + v[j].w * v[j].w); }
    const float rinv = 1.0f / sqrtf(wave_sum(s) * (1.f / DM) + EPS);
#pragma unroll
    for (int j = 0; j < 4; ++j) { const f32x4 g = *(const f32x4*)(a.final_g + 4 * lane + 256 * j); *(f32x4*)(yr + 4 * lane + 256 * j) = v[j] * rinv * g; }
}

__device__ __forceinline__ void phase5(const Args& a, int vcu, int G, int wave, int lane) {
    const int gw = vcu * NWAVES + wave, NGW = G * NWAVES;
    f32x4 nx[4];
    if (gw < MT) {
#pragma unroll
        for (int j = 0; j < 4; ++j) nx[j] = *(const f32x4*)(a.out + O_Y + (size_t)gw * DM + 4 * lane + 256 * j);
    }
    f32x4 g[4];
#pragma unroll
    for (int j = 0; j < 4; ++j) g[j] = *(const f32x4*)(a.final_g + 4 * lane + 256 * j);
    for (int r = gw; r < MT; r += NGW) {
        float* yr = a.out + O_Y + (size_t)r * DM;
        f32x4 v[4]; float s = 0.f;
#pragma unroll
        for (int j = 0; j < 4; ++j) { v[j] = nx[j]; s += (v[j].x * v[j].x + v[j].y * v[j].y) + (v[j].z * v[j].z + v[j].w * v[j].w); }
        if (r + NGW < MT) {
#pragma unroll
            for (int j = 0; j < 4; ++j) nx[j] = *(const f32x4*)(yr + (size_t)NGW * DM + 4 * lane + 256 * j);
        }
        const float rinv = 1.0f / sqrtf(wave_sum(s) * (1.f / DM) + EPS);
#pragma unroll
        for (int j = 0; j < 4; ++j) *(f32x4*)(yr + 4 * lane + 256 * j) = v[j] * rinv * g[j];
    }
}

__global__ void __launch_bounds__(NTHR, 2) mk_fwd(Args a) {
    extern __shared__ __attribute__((aligned(16))) unsigned char lds_raw[];
    LAS unsigned char* lds = (LAS unsigned char*)lds_raw;
    volatile LAS unsigned* MISC = (volatile LAS unsigned*)(lds + MISC_OFF);
    int tid = threadIdx.x, lane = tid & 63, wave = __builtin_amdgcn_readfirstlane(tid >> 6);
#define RELAUNDER() do { asm volatile("" : "+v"(tid)); lane = tid & 63; wave = __builtin_amdgcn_readfirstlane(tid >> 6); } while (0)
    const int G = gridDim.x; const int bx = blockIdx.x; const int vcu = (G % 8 == 0) ? (bx % 8) * (G / 8) + bx / 8 : bx;
    for (int u = tid; u < (LDS_BYTES - MISC_OFF) / 4; u += NTHR) ((LAS unsigned*)(lds + MISC_OFF))[u] = 0u;
    __syncthreads();
    XcdBarrier bar = xcd_barrier_post((unsigned*)(a.ws + WS_CTL) + CW_BAR, MISC + 8);

    phase0(a, lds, vcu, G, tid, wave, lane);
    xcd_barrier(bar); RELAUNDER();
    phase1(a, lds, vcu, G, tid, wave, lane);
    xcd_barrier(bar); RELAUNDER();
    {
        pg8::Gemm g{(const bf16_t*)(a.ws + WS_XN), (const bf16_t*)(a.ws + WS_WIN), MT, NPROJ, DM};
        pg8::StaticOrder S; S.init(MT, NPROJ, G, bx);
        EpiProj E{(bf16_t*)(a.ws + WS_PROJ), (float*)(a.ws + WS_LOGF), (float*)(a.ws + WS_LOGFS), a.b_in, a.lb_logits};
        pg8::gemm_phase<EpiProj, pg8::StaticOrder, true, true>(lds, g, S, E);
    }
    xcd_barrier(bar); RELAUNDER();
    for (int t = vcu; t < 3072; t += G) {
        RELAUNDER();
        const int tn = -1;
        if (t < 1024) p3a_mlstm(a, lds, t >> 7, (t >> 2) & 31, t & 3, tid, wave, lane, tn);
        else { const int u = t - 1024; p3a_hgrn(a, lds, u >> 8, (u >> 3) & 31, u & 7, tid, wave, lane, tn); }
    }
    xcd_barrier(bar); RELAUNDER();
    const int rid = bx;
    if (rid < 96) p3b_mlstm<0>(a, lds, rid / 12, (rid / 3) & 3, rid % 3, tid, wave, lane);
    else if (rid < 192) { const int u = rid - 96; p3b_hgrn<0>(a, lds, u / 12, (u / 3) & 3, u % 3, tid, wave, lane);
        RELAUNDER(); { const int t = 128 + u; p3b_sample_mlstm(a, lds, t >> 2, t & 3, tid, wave, lane); } }
    else {
        for (int k = 0; k < 2; ++k) { RELAUNDER(); const int t = (rid - 192) * 2 + k; p3b_sample_mlstm(a, lds, t >> 2, t & 3, tid, wave, lane); }
    }
    xcd_barrier(bar); RELAUNDER();
    if (rid < 128) p3b_mlstm<1>(a, lds, rid >> 4, (rid >> 2) & 3, rid & 3, tid, wave, lane);
    else { const int u = rid - 128; p3b_hgrn<1>(a, lds, u >> 4, (u >> 2) & 3, u & 3, tid, wave, lane); }
    for (;;) {
        RELAUNDER();
        __syncthreads();
        if (tid == 0) MISC[16] = 224u + __hip_atomic_fetch_add((unsigned*)(a.ws + WS_CTL) + CW_QUEUE, 1u, __ATOMIC_RELAXED, __HIP_MEMORY_SCOPE_AGENT);
        __syncthreads();
        const int t = (int)MISC[16];
        if (t >= 1536) break;
        if (t < 512) p3b_sample_mlstm(a, lds, t >> 2, t & 3, tid, wave, lane);
        else { const int u = t - 512; p3b_sample_hgrn(a, lds, u >> 3, u & 7, tid, wave, lane); }
    }
    xcd_barrier(bar); RELAUNDER();
    {
        pg8::Gemm g{(const bf16_t*)(a.ws + WS_MIX), (const bf16_t*)(a.ws + WS_WOUT), MP, DM, DMIX};
        pg8::StaticOrder S; S.init(MP, DM, G, bx);
        unsigned* ctl = (unsigned*)(a.ws + WS_CTL);
        if (G == 256) {
            EpiOutFused E{a.out + O_Y, a.x_p, (const float*)(a.ws + WS_MOD), a.final_g, (float*)(a.ws + WS_STATS), ctl + CW_PANEL};
            pg8::gemm_phase<EpiOutFused, pg8::StaticOrder, true, true>(lds, g, S, E);
            small_gemm_out(a, vcu, G, wave, lane, ctl + CW_SROW);
            { const int t = vcu * NWAVES + wave;
              if ((t & 3) == 0) { unsigned* cs = ctl + CW_SROW + 64 * (t >> 6); unsigned sp = 0;
                  while (xb_ld(cs) < 64u) { __builtin_amdgcn_s_sleep(1); if (++sp > (1u << 20)) break; }
                  __builtin_amdgcn_fence(__ATOMIC_ACQUIRE, "agent"); asm volatile("s_waitcnt vmcnt(0)" ::: "memory");
                  rms_row_inplace(a, (size_t)MP + (t >> 2), lane); } }
        } else {
            EpiOut E{a.out + O_Y, a.x_p, a.x_s, (const float*)(a.ws + WS_MOD)};
            pg8::gemm_phase<EpiOut, pg8::StaticOrder, true, true>(lds, g, S, E);
            small_gemm_out(a, vcu, G, wave, lane, nullptr);
            xcd_barrier(bar); RELAUNDER();
            phase5(a, vcu, G, wave, lane);
        }
    }
}

extern "C" void kernel_launch(void* const* d_in, const int* in_sizes, int n_in, void* d_out, int out_size, void* d_ws, size_t ws_size, hipStream_t stream) {
    static int grid = 0;
    if (grid == 0) {
        if (n_in != 25 || (size_t)out_size != O_END || ws_size < WS_END2) { fprintf(stderr, "kernel_launch: unexpected shapes: n_in %d out %d (want %zu) ws %zu (want %zu)\n", n_in, out_size, (size_t)O_END, ws_size, (size_t)WS_END); grid = -1; return; }
        int dev = 0, cus = 0, per_cu = 0;
        if (hipGetDevice(&dev) != hipSuccess || hipDeviceGetAttribute(&cus, hipDeviceAttributeMultiprocessorCount, dev) != hipSuccess) { grid = -1; return; }
        if (hipFuncSetAttribute((const void*)mk_fwd, hipFuncAttributeMaxDynamicSharedMemorySize, LDS_BYTES) != hipSuccess) { fprintf(stderr, "hipFuncSetAttribute failed\n"); grid = -1; return; }
        if (hipOccupancyMaxActiveBlocksPerMultiprocessor(&per_cu, (const void*)mk_fwd, NTHR, LDS_BYTES) != hipSuccess || per_cu < 1) { fprintf(stderr, "occupancy query: %d\n", per_cu); grid = -1; return; }
        (void)hipGetLastError();
        grid = cus;
    }
    if (grid < 0) return;
    (void)hipMemsetAsync((char*)d_ws + WS_CTL, 0, CTL_ZERO_BYTES, stream);
    Args a{};
    const float** ap = (const float**)&a;
    for (int i = 0; i < 25; ++i) ap[i] = (const float*)d_in[i];
    a.out = (float*)d_out; a.ws = (unsigned char*)d_ws;
    void* args[] = {&a};
    hipError_t e = hipLaunchCooperativeKernel((const void*)mk_fwd, dim3(grid), dim3(NTHR), args, LDS_BYTES, stream);
    if (e != hipSuccess) fprintf(stderr, "cooperative launch failed: %s (grid %d)\n", hipGetErrorString(e), grid);
}
```

```cpp
#include <hip/hip_runtime.h>
#include <cstdio>
#include <cstdint>

#define LAS __attribute__((address_space(3)))
typedef unsigned short bf16_t;
typedef short bf16x8 __attribute__((ext_vector_type(8)));
typedef short s16x4 __attribute__((ext_vector_type(4)));
typedef float f32x4 __attribute__((ext_vector_type(4)));
typedef float f32x16 __attribute__((ext_vector_type(16)));
typedef unsigned u32x4 __attribute__((ext_vector_type(4)));
typedef unsigned u32x2 __attribute__((ext_vector_type(2)));

namespace pg8 {
constexpr int BM = 256, BK = 64, HALF = 128, HTB = HALF * BK * 2, STAGE_BYTES = 8 * HTB, NXCD = 8, WGM = 8;
__host__ __device__ __forceinline__ int lds_byte(int r, int c) { const int st = (r >> 4) * 2 + (c >> 5), rr = r & 15, cc = c & 31, ob = rr * 64 + cc * 2; return st * 1024 + (ob ^ (((ob >> 9) & 1) << 5)); }
__host__ __device__ __forceinline__ void stage_rc(int b, int& R, int& C) { const int st = b / 1024, sb = b % 1024, swz = sb ^ (((sb >> 9) & 1) << 5); R = (st >> 1) * 16 + swz / 64; C = (st & 1) * 32 + (swz % 64) / 2; }
__host__ __device__ __forceinline__ int perm32(int rho) { const int n = rho >> 4, i = rho & 15; return 8 * (i >> 2) + 4 * n + (i & 3); }
struct Unit { int pm, pn; };
struct Gemm { const bf16_t* A; const bf16_t* Bt; int M, N, K; };
struct StaticOrder {
    int nM, nN, nwg, G, c;
    __host__ __device__ void init(int M, int N, int G_, int c_) { nM = M / BM; nN = N / BM; nwg = nM * nN; G = G_; c = c_; }
    __host__ __device__ bool next(int i, Unit& u) const {
        const long L = (long)i * G + c; if (L >= nwg) return false;
        int wgid = (int)L; { const int q = nwg / NXCD, r = nwg % NXCD, xcd = wgid % NXCD, off = wgid / NXCD; wgid = (xcd < r ? xcd * (q + 1) : r * (q + 1) + (xcd - r) * q) + off; }
        const int nig = WGM * nN, gid = wgid / nig, fm = gid * WGM, gsz = (nM - fm) < WGM ? (nM - fm) : WGM;
        u.pm = fm + ((wgid % nig) % gsz); u.pn = (wgid % nig) / gsz; return true;
    }
};
template <class Epi, class Sched, bool ALIGN_EPI = false, bool SP2 = false>
__device__ __forceinline__ void gemm_phase(LAS unsigned char* lds, const Gemm g, const Sched& S, const Epi& E) {
    const int tid = threadIdx.x, wid = __builtin_amdgcn_readfirstlane(tid >> 6), lane = tid & 63, wr = wid >> 2, wc = wid & 3, fr = lane & 15, fq = lane >> 4;
    const int K = g.K, nt = K / BK;
    unsigned voffA[2], voffB[2];
#pragma unroll
    for (int i = 0; i < 2; ++i) { int R, C; stage_rc(tid * 16 + i * 8192, R, C); const int Rb = Epi::PERM ? ((R & ~31) + perm32(R & 31)) : R;
        voffA[i] = (unsigned)(R * K + C) * 2u; voffB[i] = (unsigned)(Rb * K + C) * 2u; }
    const size_t kstep = (size_t)(BK * 2);
    const size_t hstep = (size_t)HALF * K * 2;
    const size_t tstep = 2 * hstep;
    const unsigned ldsw = (unsigned)wid * 1024u;
    const int aoff = lds_byte(wr * 64 + fr, fq * 8), boff = lds_byte(wc * 32 + fr, fq * 8);
#define PG8_SA(b, h) (((b) * 2 + (h)) * HTB)
#define PG8_SB(b, h) ((4 + (b) * 2 + (h)) * HTB)
#define PG8_STAGE(bufoff, gbase, voff) do { _Pragma("unroll") for (int _i = 0; _i < 2; ++_i) \
        __builtin_amdgcn_global_load_lds((const unsigned*)((const char*)(gbase) + (voff)[_i]), (LAS unsigned*)(lds + (bufoff) + ldsw + _i * 8192), 16, 0, 0); } while (0)
#define PG8_LDA(dst, b, h) do { _Pragma("unroll") for (int m = 0; m < 4; ++m) _Pragma("unroll") for (int k = 0; k < 2; ++k) dst[m][k] = *(const LAS bf16x8*)(lds + PG8_SA(b, h) + aoff + m * 2048 + k * 1024); } while (0)
#define PG8_LDB(dst, b, h) do { _Pragma("unroll") for (int n = 0; n < 2; ++n) _Pragma("unroll") for (int k = 0; k < 2; ++k) dst[n][k] = *(const LAS bf16x8*)(lds + PG8_SB(b, h) + boff + n * 2048 + k * 1024); } while (0)
#define PG8_MMA(ai, bj, At, Bt) do { __builtin_amdgcn_s_setprio(1); _Pragma("unroll") for (int m = 0; m < 4; ++m) _Pragma("unroll") for (int n = 0; n < 2; ++n) _Pragma("unroll") for (int k = 0; k < 2; ++k) \
        acc[ai][bj][m][n] = __builtin_amdgcn_mfma_f32_16x16x32_bf16(Bt[n][k], At[m][k], acc[ai][bj][m][n], 0, 0, 0); __builtin_amdgcn_s_setprio(0); } while (0)
#define PG8_WAIT_V(n) asm volatile("s_waitcnt vmcnt(" #n ")" ::: "memory")
#define PG8_WAIT_L(n) asm volatile("s_waitcnt lgkmcnt(" #n ")" ::: "memory")
#define PG8_BAR __builtin_amdgcn_s_barrier()
#define PG8_SCHED __builtin_amdgcn_sched_barrier(0)
    Unit cur, nxt; int ui = 0;
    if (!S.next(0, cur)) return;
    f32x4 acc[2][2][4][2];
#pragma unroll
    for (int a = 0; a < 2; ++a)
#pragma unroll
        for (int b = 0; b < 2; ++b)
#pragma unroll
            for (int m = 0; m < 4; ++m)
#pragma unroll
                for (int n = 0; n < 2; ++n) acc[a][b][m][n] = (f32x4){0.f, 0.f, 0.f, 0.f};
    bf16x8 At[4][2], B0[2][2], B1[2][2];
    const char* cA = (const char*)g.A + (size_t)cur.pm * tstep; const char* cB = (const char*)g.Bt + (size_t)cur.pn * tstep;
    if constexpr (SP2) {
        PG8_STAGE(PG8_SB(0, 0), cB, voffB); PG8_STAGE(PG8_SB(0, 1), cB + hstep, voffB); PG8_STAGE(PG8_SA(0, 0), cA, voffA); PG8_STAGE(PG8_SA(0, 1), cA + hstep, voffA);
        if (wr == 1) PG8_BAR;
        PG8_WAIT_V(2); PG8_BAR;
        PG8_STAGE(PG8_SB(1, 0), cB + kstep, voffB); PG8_STAGE(PG8_SA(1, 0), cA + kstep, voffA); PG8_STAGE(PG8_SB(1, 1), cB + hstep + kstep, voffB);
        PG8_WAIT_V(6); PG8_BAR;
    } else {
        PG8_STAGE(PG8_SB(0, 0), cB, voffB); PG8_STAGE(PG8_SA(0, 0), cA, voffA); PG8_STAGE(PG8_SB(0, 1), cB + hstep, voffB); PG8_STAGE(PG8_SA(0, 1), cA + hstep, voffA);
        if (wr == 1) PG8_BAR;
        PG8_WAIT_V(4); PG8_BAR;
        PG8_STAGE(PG8_SB(1, 0), cB + kstep, voffB); PG8_STAGE(PG8_SA(1, 0), cA + kstep, voffA); PG8_STAGE(PG8_SB(1, 1), cB + hstep + kstep, voffB);
        PG8_WAIT_V(6); PG8_BAR;
    }
    for (;;) {
        const bool has_next = S.next(ui + 1, nxt);
        const char* nA = has_next ? (const char*)g.A + (size_t)nxt.pm * tstep : cA; const char* nB = has_next ? (const char*)g.Bt + (size_t)nxt.pn * tstep : cB;
        for (int t = 0; t < nt; t += 2) {
            const bool last = (t == nt - 2);
            const char* a1 = cA + (size_t)(t + 1) * kstep;
            const char* a2 = last ? nA : cA + (size_t)(t + 2) * kstep; const char* b2 = last ? nB : cB + (size_t)(t + 2) * kstep;
            const char* a3 = a2 + kstep; const char* b3 = b2 + kstep;
            if constexpr (SP2) {
            PG8_LDB(B0, 0, 0); PG8_LDB(B1, 0, 1); PG8_SCHED; PG8_LDA(At, 0, 0); PG8_STAGE(PG8_SA(1, 1), a1 + hstep, voffA);
            PG8_WAIT_V(8); PG8_WAIT_L(0); PG8_BAR; PG8_MMA(0, 0, At, B0); PG8_MMA(0, 1, At, B1); PG8_BAR; PG8_SCHED;
            PG8_LDA(At, 0, 1); PG8_STAGE(PG8_SB(0, 0), b2, voffB); PG8_STAGE(PG8_SB(0, 1), b2 + hstep, voffB); PG8_STAGE(PG8_SA(0, 0), a2, voffA);
            PG8_WAIT_V(8); PG8_WAIT_L(0); PG8_BAR; PG8_MMA(1, 0, At, B0); PG8_MMA(1, 1, At, B1); PG8_BAR; PG8_SCHED;
            PG8_LDB(B0, 1, 0); PG8_LDB(B1, 1, 1); PG8_SCHED; PG8_LDA(At, 1, 0); PG8_STAGE(PG8_SA(0, 1), a2 + hstep, voffA);
            PG8_WAIT_V(8); PG8_WAIT_L(0); PG8_BAR; PG8_MMA(0, 0, At, B0); PG8_MMA(0, 1, At, B1); PG8_BAR; PG8_SCHED;
            PG8_LDA(At, 1, 1); PG8_STAGE(PG8_SB(1, 0), b3, voffB); PG8_STAGE(PG8_SB(1, 1), b3 + hstep, voffB); PG8_STAGE(PG8_SA(1, 0), a3, voffA);
            PG8_WAIT_V(8); PG8_WAIT_L(0); PG8_BAR; PG8_MMA(1, 0, At, B0); PG8_MMA(1, 1, At, B1); PG8_BAR; PG8_SCHED;
            } else {
            PG8_LDB(B0, 0, 0); PG8_SCHED; PG8_LDA(At, 0, 0); PG8_STAGE(PG8_SA(1, 1), a1 + hstep, voffA);
            PG8_WAIT_L(8); PG8_BAR; PG8_WAIT_L(0); PG8_MMA(0, 0, At, B0); PG8_BAR; PG8_SCHED;
            PG8_LDB(B1, 0, 1); PG8_STAGE(PG8_SB(0, 0), b2, voffB);
            PG8_BAR; PG8_WAIT_L(0); PG8_MMA(0, 1, At, B1); PG8_BAR;
            PG8_LDA(At, 0, 1); PG8_STAGE(PG8_SA(0, 0), a2, voffA);
            PG8_BAR; PG8_WAIT_L(0); PG8_MMA(1, 0, At, B0); PG8_BAR; PG8_SCHED;
            PG8_STAGE(PG8_SB(0, 1), b2 + hstep, voffB);
            PG8_WAIT_V(6); PG8_BAR; PG8_MMA(1, 1, At, B1); PG8_BAR;
            PG8_LDB(B0, 1, 0); PG8_SCHED; PG8_LDA(At, 1, 0); PG8_STAGE(PG8_SA(0, 1), a2 + hstep, voffA);
            PG8_WAIT_L(8); PG8_BAR; PG8_WAIT_L(0); PG8_MMA(0, 0, At, B0); PG8_BAR; PG8_SCHED;
            PG8_LDB(B1, 1, 1); PG8_STAGE(PG8_SB(1, 0), b3, voffB);
            PG8_BAR; PG8_WAIT_L(0); PG8_MMA(0, 1, At, B1); PG8_BAR;
            PG8_LDA(At, 1, 1); PG8_STAGE(PG8_SA(1, 0), a3, voffA);
            PG8_BAR; PG8_WAIT_L(0); PG8_MMA(1, 0, At, B0); PG8_BAR; PG8_SCHED;
            PG8_STAGE(PG8_SB(1, 1), b3 + hstep, voffB);
            PG8_WAIT_V(6); PG8_BAR; PG8_MMA(1, 1, At, B1); PG8_BAR;
            }
        }
        if constexpr (ALIGN_EPI) { if (wr == 0) PG8_BAR; }
        if constexpr (!Epi::AFTER_DRAIN) E(acc, cur, wr, wc, fr, fq);
        if (!has_next) break;
#pragma unroll
        for (int a = 0; a < 2; ++a)
#pragma unroll
            for (int b = 0; b < 2; ++b)
#pragma unroll
                for (int m = 0; m < 4; ++m)
#pragma unroll
                    for (int n = 0; n < 2; ++n) acc[a][b][m][n] = (f32x4){0.f, 0.f, 0.f, 0.f};
        cur = nxt; cA = nA; cB = nB; ++ui;
        if constexpr (ALIGN_EPI) { if (wr == 1) PG8_BAR; }
    }
    PG8_WAIT_V(0);
    if constexpr (!ALIGN_EPI) { if (wr == 0) PG8_BAR; }
    PG8_BAR;
    if constexpr (Epi::AFTER_DRAIN) E.fused(acc, cur, wr, wc, fr, fq, lds, wid, lane);
#undef PG8_SA
#undef PG8_SB
#undef PG8_STAGE
#undef PG8_LDA
#undef PG8_LDB
#undef PG8_MMA
#undef PG8_WAIT_V
#undef PG8_WAIT_L
#undef PG8_BAR
#undef PG8_SCHED
}
}

constexpr int NWAVES = 8, NTHR = 512;
constexpr int DM = 1024;
constexpr int BP = 8, TP = 2048, MP = BP * TP;
constexpr int BS = 128, TS = 4, MS = BS * TS;
constexpr int MT = MP + MS;
constexpr int NMOD = BP + BS;
constexpr int WIN_LD = 7176, NPROJ = 7168, DMIX = 2048;
constexpr int NCH = TP / 64;
constexpr float EPS = 1e-6f;

constexpr size_t SEGSZ = (size_t)MP * 1024;
constexpr size_t PS_OFF = 7 * SEGSZ;
__device__ __forceinline__ size_t hg_tile(int seg, int b, int c, int head) { return (size_t)seg * SEGSZ + ((size_t)((b * NCH + c) * 8 + head) << 13); }
__device__ __forceinline__ size_t ml_tile(int seg, int b, int c, int h) { return (size_t)seg * SEGSZ + ((size_t)((b * NCH + c) * 4 + h) << 14); }
constexpr size_t MiB = 1u << 20;
constexpr size_t WS_CTL = 0, CTL_ZERO_BYTES = 1 * MiB;
constexpr size_t WS_WIN = 2 * MiB;
constexpr size_t WS_WOUT = 16 * MiB;
constexpr size_t WS_MOD = 20 * MiB;
constexpr size_t WS_GATE = 22 * MiB;
constexpr size_t WS_DEC = 23 * MiB;
constexpr size_t WS_BT = 24 * MiB;
constexpr size_t WS_RS = 24 * MiB + 512 * 1024;
constexpr size_t WS_CSK = 25 * MiB;
constexpr size_t WS_RL = 26 * MiB;
constexpr size_t WS_GW = 26 * MiB + 64 * 1024;
constexpr size_t WS_LOGFS = 26 * MiB + 512 * 1024;
constexpr size_t WS_AH = 30 * MiB;
constexpr size_t WS_AM = 46 * MiB;
constexpr size_t WS_XN = 54 * MiB;
constexpr size_t WS_QM = WS_XN;
constexpr size_t WS_PROJ = 88 * MiB;
constexpr size_t WS_LOGF = 320 * MiB;
constexpr size_t WS_MIX = WS_LOGF;
constexpr size_t WS_KM = 388 * MiB, WS_VM = 420 * MiB, WS_XC = 452 * MiB;
constexpr size_t WS_END = 484 * MiB;
constexpr size_t O_Y = 0;
constexpr size_t O_HP = (size_t)MT * DM;
constexpr size_t O_CP = O_HP + (size_t)BP * 8 * 128 * 128;
constexpr size_t O_NP = O_CP + (size_t)BP * 4 * 256 * 256;
constexpr size_t O_MP = O_NP + (size_t)BP * 4 * 256;
constexpr size_t O_VP = O_MP + (size_t)BP * 4;
constexpr size_t O_HS = O_VP + (size_t)BP * 3 * 1024;
constexpr size_t O_CS = O_HS + (size_t)BS * 8 * 128 * 128;
constexpr size_t O_NS = O_CS + (size_t)BS * 4 * 256 * 256;
constexpr size_t O_MS = O_NS + (size_t)BS * 4 * 256;
constexpr size_t O_VS = O_MS + (size_t)BS * 4;
constexpr size_t O_END = O_VS + (size_t)BS * 3 * 1024;

constexpr int RING_BYTES = 131072, LDS_BYTES = 147456, MISC_OFF = LDS_BYTES - 1024;
constexpr int CW_BAR = 4096, CW_QUEUE = 2048, CW_PANEL = 8192, CW_SROW = 12288;

#define LDS_WAIT() asm volatile("s_waitcnt lgkmcnt(0)" ::: "memory")
__device__ __forceinline__ float bf2f(unsigned u16) { return __uint_as_float(u16 << 16); }
__device__ __forceinline__ float bflo(unsigned w) { return __uint_as_float(w << 16); }
__device__ __forceinline__ float bfhi(unsigned w) { return __uint_as_float(w & 0xffff0000u); }
typedef __bf16 bf16v2_t __attribute__((ext_vector_type(2)));
__device__ __forceinline__ unsigned pk2(float lo, float hi) { bf16v2_t v; v[0] = (__bf16)lo; v[1] = (__bf16)hi; return __builtin_bit_cast(unsigned, v); }
__device__ __forceinline__ bf16_t f2bf(float f) { return __builtin_bit_cast(bf16_t, (__bf16)f); }
__device__ __forceinline__ float wave_sum(float v) {
#pragma unroll
    for (int o = 1; o < 64; o <<= 1) v += __shfl_xor(v, o);
    return v;
}
__device__ __forceinline__ float sigmoidf_(float x) { return __builtin_amdgcn_rcpf(1.f + __expf(-x)); }

#define XB_TMO      128
#define XB_XCNT(j)  (256  + 64 * (j))
#define XB_XSUB(j)  (1280 + 64 * (j))
#define XB_XGEN(j)  (2304 + 64 * (j))
#define XB_TOP      3328
#define XB_TOPGEN   3392
#define XCD_BAR_WORDS 3456
#define XB_SPIN_CAP (1u << 18)
__device__ __forceinline__ unsigned xb_ld(unsigned* p)              { return __hip_atomic_load(p, __ATOMIC_RELAXED, __HIP_MEMORY_SCOPE_AGENT); }
__device__ __forceinline__ unsigned xb_add(unsigned* p, unsigned v) { return __hip_atomic_fetch_add(p, v, __ATOMIC_RELAXED, __HIP_MEMORY_SCOPE_AGENT); }
__device__ __forceinline__ unsigned xb_xcc_id() { return (unsigned)__builtin_amdgcn_s_getreg((3 << 11) | 20) & 0xFu; }
#define XB_SPIN(cond, bar) do { unsigned _sp = 0; while (cond) { __builtin_amdgcn_s_sleep(1); \
    if ((++_sp & 255u) == 0u) { if (xb_ld(&(bar)[XB_TMO])) break; if (_sp > XB_SPIN_CAP) { atomicAdd(&(bar)[XB_TMO], 1u); break; } } } } while (0)
struct XcdBarrier { unsigned* bar; unsigned x; volatile LAS unsigned* st; };
__device__ __forceinline__ XcdBarrier xcd_barrier_post(unsigned* bar, volatile LAS unsigned* st) {
    XcdBarrier b; b.bar = bar; b.x = xb_xcc_id(); b.st = st;
    if (threadIdx.x == 0) (void)xb_add(&bar[XB_XCNT(b.x)], 1u);
    return b;
}
__device__ __forceinline__ void xcd_barrier_complete(unsigned* bar, unsigned x, unsigned& nloc, unsigned& nx) {
    const unsigned G = gridDim.x * gridDim.y * gridDim.z;
    unsigned sum, cnt, mine, sp = 0u;
    for (;;) {
        sum = 0u; cnt = 0u; mine = 0u;
#pragma unroll
        for (unsigned j = 0; j < 16; ++j) { const unsigned c = xb_ld(&bar[XB_XCNT(j)]); sum += c; cnt += (c > 0u) ? 1u : 0u; mine = (j == x) ? c : mine; }
        if (sum == G) break;
        __builtin_amdgcn_s_sleep(1);
        if ((++sp & 255u) == 0u) { if (xb_ld(&bar[XB_TMO])) break; if (sp > XB_SPIN_CAP) { atomicAdd(&bar[XB_TMO], 1u); break; } }
    }
    nloc = mine > 0u ? mine : 1u; nx = cnt > 0u ? cnt : 1u;
}
__device__ __forceinline__ void xcd_barrier(const XcdBarrier& b) {
    asm volatile("s_waitcnt vmcnt(0)" ::: "memory");
    __syncthreads();
    if (threadIdx.x == 0) {
        unsigned* bar = b.bar;
        __builtin_amdgcn_s_waitcnt(0);
        unsigned nloc = b.st[0], nx = b.st[1];
        if (nloc == 0u) { xcd_barrier_complete(bar, b.x, nloc, nx); b.st[0] = nloc; b.st[1] = nx; }
        const unsigned old = xb_add(&bar[XB_XSUB(b.x)], 1u);
        const unsigned gen = old / nloc;
        if (old + 1u == (gen + 1u) * nloc) {
            __builtin_amdgcn_fence(__ATOMIC_RELEASE, "agent");
            asm volatile("s_waitcnt vmcnt(0)" ::: "memory");
            const unsigned og = xb_add(&bar[XB_TOP], 1u);
            const unsigned tg = og / nx;
            if (og + 1u == (tg + 1u) * nx) xb_add(&bar[XB_TOPGEN], 1u);
            else XB_SPIN(xb_ld(&bar[XB_TOPGEN]) == tg, bar);
            __builtin_amdgcn_fence(__ATOMIC_ACQUIRE, "agent");
            xb_add(&bar[XB_XGEN(b.x)], 1u);
            asm volatile("s_waitcnt vmcnt(0)" ::: "memory");
        } else {
            XB_SPIN(xb_ld(&bar[XB_XGEN(b.x)]) == gen, bar);
            __builtin_amdgcn_fence(__ATOMIC_ACQUIRE, "agent");
            asm volatile("s_waitcnt vmcnt(0)" ::: "memory");
        }
    }
    __syncthreads();
}

struct Args {
    const float *x_p, *x_s, *c_p, *c_s, *st_h, *st_C, *st_n, *st_m, *st_conv, *w_ada, *b_ada, *norm_g, *w_in, *b_in, *lb_logits, *hnorm_g,
                *conv_w, *conv_b, *wq, *wk, *wv, *mnorm_g, *skip, *w_out, *final_g;
    float* out; unsigned char* ws;
};

__device__ __forceinline__ void transposes(const Args& a, LAS unsigned char* lds, int vcu, int G, int tid, int wave, int lane);
__device__ __forceinline__ void phase1(const Args& a, LAS unsigned char* lds, int vcu, int G, int tid, int wave, int lane) {
    LAS float* sg = (LAS float*)lds;
    { const float* GW = (const float*)(a.ws + WS_GW); f32x4 tv[4];
#pragma unroll
      for (int i = 0; i < 4; ++i) tv[i] = *(const f32x4*)(GW + 4 * (tid + NTHR * i));
#pragma unroll
      for (int i = 0; i < 4; ++i) *(LAS f32x4*)(sg + 4 * (tid + NTHR * i)) = tv[i]; }
    __syncthreads();
    const float* MOD = (const float*)(a.ws + WS_MOD);
    bf16_t* XN = (bf16_t*)(a.ws + WS_XN); float* GATE = (float*)(a.ws + WS_GATE);
    const int gw = vcu * NWAVES + wave, NGW = G * NWAVES;
    f32x4 nx[4];
    if (gw < MT) { const float* xr = gw < MP ? a.x_p + (size_t)gw * DM : a.x_s + (size_t)(gw - MP) * DM;
#pragma unroll
        for (int j = 0; j < 4; ++j) nx[j] = *(const f32x4*)(xr + 4 * lane + 256 * j); }
    for (int r = gw; r < MT; r += NGW) {
        const int mb = r < MP ? (r >> 11) : BP + ((r - MP) >> 2);
        const float* shift = MOD + (size_t)mb * 3072; const float* scale = shift + 1024;
        f32x4 v[4]; float s = 0.f;
#pragma unroll
        for (int j = 0; j < 4; ++j) { v[j] = nx[j]; s += (v[j].x * v[j].x + v[j].y * v[j].y) + (v[j].z * v[j].z + v[j].w * v[j].w); }
        if (r + NGW < MT) { const int rn = r + NGW; const float* xr = rn < MP ? a.x_p + (size_t)rn * DM : a.x_s + (size_t)(rn - MP) * DM;
#pragma unroll
            for (int j = 0; j < 4; ++j) nx[j] = *(const f32x4*)(xr + 4 * lane + 256 * j); }
        const float rinv = 1.0f / sqrtf(wave_sum(s) * (1.f / DM) + EPS);
        float gd[8];
#pragma unroll
        for (int gi = 0; gi < 8; ++gi) gd[gi] = 0.f;
#pragma unroll
        for (int j = 0; j < 4; ++j) {
            const int col = 4 * lane + 256 * j;
            const f32x4 g = *(const f32x4*)(a.norm_g + col), sc = *(const f32x4*)(scale + col), sh = *(const f32x4*)(shift + col);
            f32x4 h = v[j] * rinv * g * (sc + 1.0f) + sh;
            u32x2 o; o.x = pk2(h.x, h.y); o.y = pk2(h.z, h.w);
            *(u32x2*)(XN + (size_t)r * DM + col) = o;
#pragma unroll
            for (int gi = 0; gi < 8; ++gi) { const f32x4 w = *(const LAS f32x4*)(sg + gi * 1024 + col); gd[gi] += (h.x * w.x + h.y * w.y) + (h.z * w.z + h.w * w.w); }
        }
#pragma unroll
        for (int gi = 0; gi < 8; ++gi) gd[gi] = wave_sum(gd[gi]);
        if (lane < 8) {
            float val = 0.f;
#pragma unroll
            for (int gi = 0; gi < 8; ++gi) val = (lane == gi) ? gd[gi] : val;
            val += a.b_in[NPROJ + lane];
            if (lane >= 4) val = fminf(val, 0.f) - log1pf(__expf(-fabsf(val)));
            GATE[(size_t)r * 8 + lane] = val;
        }
    }
}

__device__ __forceinline__ void store_wt_f32(float* p, float v) { asm volatile("global_store_dword %0, %1, off sc1\n\ts_nop 1" :: "v"(p), "v"(v) : "memory"); }
struct EpiProj {
    static constexpr bool PERM = true, AFTER_DRAIN = false;
    bf16_t* PROJ; float* LOGF; float* LOGFS; const float* bias; const float* lbl;
    __device__ __forceinline__ void operator()(const f32x4 (&acc)[2][2][4][2], const pg8::Unit& u, int wr, int wc, int fr, int fq) const {
        const int seg = u.pn >> 2;
        const int row0 = u.pm * 256 + wr * 64 + fr, col0 = u.pn * 256 + wc * 32 + 8 * fq, cs0 = col0 & 1023;
        const bool prompt = u.pm < MP / 256;
        unsigned cpart[2];
#pragma unroll
        for (int bj = 0; bj < 2; ++bj) { const int cs = cs0 + bj * 128; cpart[bj] = seg < 4 ? (unsigned)(((cs >> 7) << 13) + (cs & 127)) : (unsigned)(((cs >> 8) << 14) + (cs & 255)); }
        const int tsh = seg < 4 ? 7 : 8;
        f32x4 bv[2][2], lb[2][2];
#pragma unroll
        for (int bj = 0; bj < 2; ++bj)
#pragma unroll
            for (int n = 0; n < 2; ++n) {
                bv[bj][n] = *(const f32x4*)(bias + col0 + bj * 128 + 4 * n);
                if (seg == 1) { const int c = col0 - 1024 + bj * 128 + 4 * n; const f32x4 l0 = *(const f32x4*)(lbl + c), l1 = *(const f32x4*)(lbl + 1024 + c);
                    f32x4 t; t.x = 1.f / (1.f + __expf(l1.x - l0.x)); t.y = 1.f / (1.f + __expf(l1.y - l0.y)); t.z = 1.f / (1.f + __expf(l1.z - l0.z)); t.w = 1.f / (1.f + __expf(l1.w - l0.w)); lb[bj][n] = t; }
                else lb[bj][n] = (f32x4){0.f, 0.f, 0.f, 0.f};
            }
#pragma unroll
        for (int ai = 0; ai < 2; ++ai)
#pragma unroll
            for (int m = 0; m < 4; ++m) {
                const int row = row0 + ai * 128 + m * 16;
                const size_t rpart = prompt ? ((size_t)(row >> 6) << 16) + (size_t)((row & 63) << tsh) : 0;
#pragma unroll
                for (int bj = 0; bj < 2; ++bj) {
                    f32x4 v0 = acc[ai][bj][m][0] + bv[bj][0], v1 = acc[ai][bj][m][1] + bv[bj][1];
                    if (seg == 1) {
                        float* dst = prompt ? LOGF + rpart + cpart[bj] : LOGFS + (size_t)(row - MP) * 1024 + cs0 + bj * 128;
                        f32x4 o0, o1;
#pragma unroll
                        for (int e = 0; e < 4; ++e) { const float l0 = lb[bj][0][e], l1 = lb[bj][1][e];
                            o0[e] = __logf(l0 + (1.f - l0) * sigmoidf_(v0[e])); o1[e] = __logf(l1 + (1.f - l1) * sigmoidf_(v1[e])); }
                        *(f32x4*)dst = o0; *(f32x4*)(dst + 4) = o1;
                    } else {
                        if (seg == 3 || seg == 5) {
#pragma unroll
                            for (int e = 0; e < 4; ++e) { v0[e] = v0[e] * sigmoidf_(v0[e]); v1[e] = v1[e] * sigmoidf_(v1[e]); }
                        } else if (seg == 6) {
#pragma unroll
                            for (int e = 0; e < 4; ++e) { v0[e] = sigmoidf_(v0[e]); v1[e] = sigmoidf_(v1[e]); }
                        }
                        u32x4 w; w.x = pk2(v0[0], v0[1]); w.y = pk2(v0[2], v0[3]); w.z = pk2(v1[0], v1[1]); w.w = pk2(v1[2], v1[3]);
                        bf16_t* dst = prompt ? PROJ + (size_t)seg * SEGSZ + rpart + cpart[bj] : PROJ + PS_OFF + (size_t)(row - MP) * NPROJ + col0 + bj * 128;
                        *(u32x4*)dst = w;
                    }
                }
            }
    }
};
struct EpiOut {
    static constexpr bool PERM = true, AFTER_DRAIN = false;
    float* Y; const float* xp; const float* xs; const float* MOD;
    __device__ __forceinline__ void operator()(const f32x4 (&acc)[2][2][4][2], const pg8::Unit& u, int wr, int wc, int fr, int fq) const {
        const int row0 = u.pm * 256 + wr * 64 + fr, col0 = u.pn * 256 + wc * 32 + 8 * fq;
#pragma unroll
        for (int ai = 0; ai < 2; ++ai)
#pragma unroll
            for (int m = 0; m < 4; ++m) {
                const int row = row0 + ai * 128 + m * 16;
                const float* xr = row < MP ? xp + (size_t)row * DM : xs + (size_t)(row - MP) * DM;
                const int mb = row < MP ? (row >> 11) : BP + ((row - MP) >> 2);
                const float* gate = MOD + (size_t)mb * 3072 + 2048;
#pragma unroll
                for (int bj = 0; bj < 2; ++bj)
#pragma unroll
                    for (int n = 0; n < 2; ++n) {
                        const int col = col0 + bj * 128 + 4 * n;
                        const f32x4 xv = *(const f32x4*)(xr + col), gv = *(const f32x4*)(gate + col);
                        *(f32x4*)(Y + (size_t)row * DM + col) = xv + gv * acc[ai][bj][m][n];
                    }
            }
    }
};

struct EpiOutFused {
    static constexpr bool PERM = true, AFTER_DRAIN = true;
    float* Y; const float* xp; const float* MOD; const float* fg; float* STATS; unsigned* cnt;
    __device__ __forceinline__ void operator()(const f32x4 (&)[2][2][4][2], const pg8::Unit&, int, int, int, int) const {}
    __device__ __forceinline__ void fused(f32x4 (&acc)[2][2][4][2], const pg8::Unit& u, int wr, int wc, int fr, int fq, LAS unsigned char* lds, int wid, int lane) const {
        LAS float* P = (LAS float*)lds;
        LAS float* S = (LAS float*)(lds + 4096);
        const int tid = wid * 64 + lane;
        const int row0 = u.pm * 256 + wr * 64 + fr, col0 = u.pn * 256 + wc * 32 + 8 * fq;
        const float* gate = MOD + (size_t)(u.pm >> 3) * 3072 + 2048;
        f32x4 gv[2][2];
#pragma unroll
        for (int bj = 0; bj < 2; ++bj)
#pragma unroll
            for (int n = 0; n < 2; ++n) gv[bj][n] = *(const f32x4*)(gate + col0 + bj * 128 + 4 * n);
#pragma unroll
        for (int ai = 0; ai < 2; ++ai)
#pragma unroll
            for (int m = 0; m < 4; ++m) {
                const int row = row0 + ai * 128 + m * 16; float sq = 0.f;
#pragma unroll
                for (int bj = 0; bj < 2; ++bj)
#pragma unroll
                    for (int n = 0; n < 2; ++n) { const f32x4 xv = *(const f32x4*)(xp + (size_t)row * DM + col0 + bj * 128 + 4 * n);
                        const f32x4 v = xv + gv[bj][n] * acc[ai][bj][m][n]; acc[ai][bj][m][n] = v; sq += (v.x * v.x + v.y * v.y) + (v.z * v.z + v.w * v.w); }
                sq += __shfl_xor(sq, 16); sq += __shfl_xor(sq, 32);
                if (fq == 0) P[(ai * 128 + wr * 64 + m * 16 + fr) * 4 + wc] = sq;
            }
        __syncthreads();
        if (tid < 256) { const f32x4 p4 = *(const LAS f32x4*)(P + tid * 4);
            __hip_atomic_store(STATS + ((size_t)u.pm * 256 + tid) * 4 + u.pn, (p4.x + p4.y) + (p4.z + p4.w), __ATOMIC_RELAXED, __HIP_MEMORY_SCOPE_AGENT); }
        asm volatile("s_waitcnt vmcnt(0)" ::: "memory");
        __syncthreads();
        if (tid == 0) { (void)xb_add(cnt + 64 * u.pm, 1u);
            unsigned sp = 0; while (xb_ld(cnt + 64 * u.pm) < 4u) { __builtin_amdgcn_s_sleep(1); if (++sp > (1u << 20)) break; } }
        __syncthreads();
        if (tid < 256) { const float* st = STATS + ((size_t)u.pm * 256 + tid) * 4; float t = 0.f;
#pragma unroll
            for (int j = 0; j < 4; ++j) t += __hip_atomic_load(st + j, __ATOMIC_RELAXED, __HIP_MEMORY_SCOPE_AGENT);
            S[tid] = 1.0f / sqrtf(t * (1.f / DM) + EPS); }
        __syncthreads();
        f32x4 fgv[2][2];
#pragma unroll
        for (int bj = 0; bj < 2; ++bj)
#pragma unroll
            for (int n = 0; n < 2; ++n) fgv[bj][n] = *(const f32x4*)(fg + col0 + bj * 128 + 4 * n);
#pragma unroll
        for (int ai = 0; ai < 2; ++ai)
#pragma unroll
            for (int m = 0; m < 4; ++m) {
                const int rl = ai * 128 + wr * 64 + m * 16 + fr; const float ri = S[rl];
#pragma unroll
                for (int bj = 0; bj < 2; ++bj)
#pragma unroll
                    for (int n = 0; n < 2; ++n) *(f32x4*)(Y + (size_t)(u.pm * 256 + rl) * DM + col0 + bj * 128 + 4 * n) = acc[ai][bj][m][n] * ri * fgv[bj][n];
            }
    }
};
#define LDSP(type, off) ((LAS type*)(lds + (off)))
__device__ __forceinline__ unsigned lp_row(int lane, unsigned RS) { return (unsigned)(lane & 31) * RS + 16u * (unsigned)(lane >> 5); }
__device__ __forceinline__ unsigned lp_perm(int lane, unsigned RS) { return (unsigned)(lane & 31) * RS + 8u * (unsigned)(lane >> 5); }
__device__ __forceinline__ unsigned lp_tr(int lane, unsigned RS) { return ((unsigned)(lane >> 5) * 8u + (unsigned)((lane & 15) >> 2)) * RS + (((unsigned)(lane >> 4) & 1u) * 16u + (unsigned)(lane & 3) * 4u) * 2u; }
__device__ __forceinline__ bf16x8 frag_row(LAS unsigned char* lds, unsigned off) { return *LDSP(const bf16x8, off); }
__device__ __forceinline__ bf16x8 frag_perm(LAS unsigned char* lds, unsigned off) {
    const s16x4 lo = *LDSP(const s16x4, off), hi = *LDSP(const s16x4, off + 16);
    bf16x8 r; r[0] = lo[0]; r[1] = lo[1]; r[2] = lo[2]; r[3] = lo[3]; r[4] = hi[0]; r[5] = hi[1]; r[6] = hi[2]; r[7] = hi[3]; return r;
}
template <unsigned RS> __device__ __forceinline__ bf16x8 frag_tr(LAS unsigned char* lds, unsigned off) {
    const s16x4 lo = __builtin_amdgcn_ds_read_tr16_b64_v4i16(LDSP(s16x4, off));
    const s16x4 hi = __builtin_amdgcn_ds_read_tr16_b64_v4i16(LDSP(s16x4, off + 4 * RS));
    bf16x8 r; r[0] = lo[0]; r[1] = lo[1]; r[2] = lo[2]; r[3] = lo[3]; r[4] = hi[0]; r[5] = hi[1]; r[6] = hi[2]; r[7] = hi[3]; return r;
}
template <int S> __device__ __forceinline__ bf16x8 acc_frag(const f32x16& x) {
    u32x4 w; w.x = pk2(x[8 * S + 0], x[8 * S + 1]); w.y = pk2(x[8 * S + 2], x[8 * S + 3]); w.z = pk2(x[8 * S + 4], x[8 * S + 5]); w.w = pk2(x[8 * S + 6], x[8 * S + 7]);
    return __builtin_bit_cast(bf16x8, w);
}
#define MFMA32(a, b, c) __builtin_amdgcn_mfma_f32_32x32x16_bf16(a, b, c, 0, 0, 0)
__device__ __forceinline__ int accrow(int i, int h) { return (i & 3) + 8 * (i >> 2) + 4 * h; }
#define ACCROW0(i) (((i) & 3) + 8 * ((i) >> 2))

__device__ __forceinline__ void p0_transpose_tile(const float* W, int ldw, int K, bf16_t* WT, LAS unsigned char* lds, int kb, int nb, int tid, int wave, int lane) {
    constexpr unsigned RS = 528;
    const int k0 = 64 * kb, n0 = 256 * nb;
    f32x4 v[8];
#pragma unroll
    for (int i = 0; i < 8; ++i) { const int idx = tid + NTHR * i, k = idx >> 6, nq = idx & 63; v[i] = *(const f32x4*)(W + (size_t)(k0 + k) * ldw + n0 + 4 * nq); }
#pragma unroll
    for (int i = 0; i < 8; ++i) { const int idx = tid + NTHR * i, k = idx >> 6, nq = idx & 63; u32x2 o; o.x = pk2(v[i].x, v[i].y); o.y = pk2(v[i].z, v[i].w); *LDSP(u32x2, k * RS + 8 * nq) = o; }
    __syncthreads();
    const unsigned ot = lp_tr(lane, RS) + 64u * wave;
#pragma unroll
    for (int rb = 0; rb < 4; ++rb) { const bf16x8 f = frag_tr<RS>(lds, ot + 16 * rb * RS);
        *(bf16x8*)(WT + (size_t)(n0 + 32 * wave + (lane & 31)) * K + k0 + 16 * rb + 8 * (lane >> 5)) = f; }
    __syncthreads();
}
__device__ __forceinline__ void transposes(const Args& a, LAS unsigned char* lds, int vcu, int G, int tid, int wave, int lane);
__device__ __forceinline__ void phase0(const Args& a, LAS unsigned char* lds, int vcu, int G, int tid, int wave, int lane) {
    float* MOD = (float*)(a.ws + WS_MOD);
    for (int cb = vcu; cb < 96; cb += G) {
        const int c0 = 32 * cb;
#pragma unroll
        for (int hb = 0; hb < 2; ++hb) { f32x4 v[8];
#pragma unroll
            for (int i = 0; i < 8; ++i) { const int k = (tid >> 3) + 64 * (8 * hb + i); v[i] = *(const f32x4*)(a.w_ada + (size_t)k * 3072 + c0 + 4 * (tid & 7)); }
#pragma unroll
            for (int i = 0; i < 8; ++i) { const int k = (tid >> 3) + 64 * (8 * hb + i); u32x2 o; o.x = pk2(v[i].x, v[i].y); o.y = pk2(v[i].z, v[i].w); *LDSP(u32x2, k * 80 + 8 * (tid & 7)) = o; } }
        __syncthreads();
        if (wave < 5) {
            const int hl = lane >> 5, rr = 32 * wave + (lane & 31), rc = rr < NMOD ? rr : NMOD - 1;
            const float* cr = (rc < BP ? a.c_p + (size_t)rc * DM : a.c_s + (size_t)(rc - BP) * DM) + 8 * hl;
            const unsigned ot = lp_tr(lane, 80);
            f32x16 acc;
#pragma unroll
            for (int i = 0; i < 16; ++i) acc[i] = 0.f;
            f32x4 cv[8][2], cnx[8][2];
#pragma unroll
            for (int j = 0; j < 8; ++j) { cnx[j][0] = *(const f32x4*)(cr + 16 * j); cnx[j][1] = *(const f32x4*)(cr + 16 * j + 4); }
#pragma unroll 1
            for (int k0 = 0; k0 < DM; k0 += 128) {
#pragma unroll
                for (int j = 0; j < 8; ++j) { cv[j][0] = cnx[j][0]; cv[j][1] = cnx[j][1]; }
                { const int kn = (k0 + 128 < DM) ? k0 + 128 : k0;
#pragma unroll
                  for (int j = 0; j < 8; ++j) { cnx[j][0] = *(const f32x4*)(cr + kn + 16 * j); cnx[j][1] = *(const f32x4*)(cr + kn + 16 * j + 4); } }
#pragma unroll
                for (int j = 0; j < 8; ++j) {
                    float sv[8];
#pragma unroll
                    for (int e = 0; e < 4; ++e) { sv[e] = cv[j][0][e] * sigmoidf_(cv[j][0][e]); sv[4 + e] = cv[j][1][e] * sigmoidf_(cv[j][1][e]); }
                    u32x4 w; w.x = pk2(sv[0], sv[1]); w.y = pk2(sv[2], sv[3]); w.z = pk2(sv[4], sv[5]); w.w = pk2(sv[6], sv[7]);
                    acc = MFMA32(__builtin_bit_cast(bf16x8, w), frag_tr<80>(lds, ot + (unsigned)(k0 + 16 * j) * 80u), acc);
                }
            }
#pragma unroll
            for (int i = 0; i < 16; ++i) { const int r = 32 * wave + accrow(i, hl);
                if (r < NMOD) MOD[(size_t)r * 3072 + c0 + (lane & 31)] = acc[i] + a.b_ada[c0 + (lane & 31)]; }
        }
        __syncthreads();
    }
    if (vcu >= 96) transposes(a, lds, vcu - 96, G - 96, tid, wave, lane);
    if (vcu == G - 1) {
        float* GW = (float*)(a.ws + WS_GW);
        float tv[16];
#pragma unroll
        for (int i = 0; i < 16; ++i) { const int idx = tid + NTHR * i; tv[i] = a.w_in[(size_t)(idx >> 3) * WIN_LD + NPROJ + (idx & 7)]; }
#pragma unroll
        for (int i = 0; i < 16; ++i) { const int idx = tid + NTHR * i; GW[(idx & 7) * 1024 + (idx >> 3)] = tv[i]; }
    }
}
__device__ __forceinline__ void transposes(const Args& a, LAS unsigned char* lds, int vcu, int G, int tid, int wave, int lane) {
    bf16_t* WinT = (bf16_t*)(a.ws + WS_WIN); bf16_t* WoutT = (bf16_t*)(a.ws + WS_WOUT);
    constexpr int I_IN = (DM / 64) * (NPROJ / 256), I_OUT = (DMIX / 64) * (DM / 256);
    for (int it = vcu; it < I_IN + I_OUT; it += G) {
        if (it < I_IN) p0_transpose_tile(a.w_in, WIN_LD, DM, WinT, lds, it / (NPROJ / 256), it % (NPROJ / 256), tid, wave, lane);
        else { const int u = it - I_IN; p0_transpose_tile(a.w_out, DM, DMIX, WoutT, lds, u / (DM / 256), u % (DM / 256), tid, wave, lane); }
    }
}

__device__ __forceinline__ unsigned p3a_touch(const Args& a, int t, int tid) {
    const bf16_t* PROJ = (const bf16_t*)(a.ws + WS_PROJ);
    const unsigned* p;
    if (t < 1024) { const int b = t >> 7, c = (t >> 2) & 31, h = t & 3;
        p = (const unsigned*)(PROJ + ml_tile(4, b, c, h) + (tid & 255) * 64); }
    else { const int u = t - 1024, b = u >> 8, c = (u >> 3) & 31, h = u & 7;
        if (tid < 256) p = (const unsigned*)((const float*)(a.ws + WS_LOGF) + ((size_t)((b * NCH + c) * 8 + h) << 13) + tid * 32);
        else p = (const unsigned*)(PROJ + hg_tile(0, b, c, h) + (tid & 127) * 64); }
    return *p;
}
__device__ __forceinline__ void p3a_hgrn(const Args& a, LAS unsigned char* lds, int b, int c, int h, int tid, int wave, int lane, int tnext) {
    constexpr unsigned RS = 272, OQT = 8192, OKT = 8192 + 17408;
    bf16_t* PROJ = (bf16_t*)(a.ws + WS_PROJ);
    const float* LOGF = (const float*)(a.ws + WS_LOGF);
    const size_t r0 = (size_t)b * TP + (size_t)c * 64;
    const size_t task = ((size_t)b * NCH + c) * 8 + h;
    const int cq = tid & 31, tseg = tid >> 5;
    f32x4 lf[4]; u32x2 qw[4];
#pragma unroll
    for (int i = 0; i < 4; ++i) { const int t = 4 * tseg + i; lf[i] = *(const f32x4*)(LOGF + (task << 13) + t * 128 + 4 * cq); qw[i] = *(const u32x2*)(PROJ + hg_tile(0, b, c, h) + t * 128 + 4 * cq); }
    const unsigned pf = (tnext >= 0) ? p3a_touch(a, tnext, tid) : 0u;
    f32x4 gl[4]; gl[0] = lf[0]; gl[1] = gl[0] + lf[1]; gl[2] = gl[1] + lf[2]; gl[3] = gl[2] + lf[3];
    *LDSP(f32x4, (tseg * 128 + 4 * cq) * 4) = gl[3];
    __syncthreads();
    f32x4 off = {0.f, 0.f, 0.f, 0.f}, Gm = off, GL = off;
#pragma unroll
    for (int sg = 0; sg < 16; ++sg) { const f32x4 v = *LDSP(const f32x4, (sg * 128 + 4 * cq) * 4); GL += v; if (sg < 8) Gm += v; if (sg < tseg) off += v; }
#pragma unroll
    for (int i = 0; i < 4; ++i) { const int t = 4 * tseg + i;
        const f32x4 G = off + gl[i];
        const float q[4] = {bflo(qw[i].x), bfhi(qw[i].x), bflo(qw[i].y), bfhi(qw[i].y)};
        float qe[4], ke[4], qt[4], kt[4];
#pragma unroll
        for (int e = 0; e < 4; ++e) { const float kk = 1.f - __expf(lf[i][e]);
            qe[e] = q[e] * __expf(G[e]); ke[e] = kk * __expf(GL[e] - G[e]); qt[e] = q[e] * __expf(G[e] - Gm[e]); kt[e] = kk * __expf(Gm[e] - G[e]); }
        bf16_t* qp = PROJ + hg_tile(0, b, c, h) + t * 128 + 4 * cq;
        u32x2 o; o.x = pk2(qe[0], qe[1]); o.y = pk2(qe[2], qe[3]); *(u32x2*)qp = o;
        o.x = pk2(ke[0], ke[1]); o.y = pk2(ke[2], ke[3]); *(u32x2*)(qp + SEGSZ) = o;
        o.x = pk2(qt[0], qt[1]); o.y = pk2(qt[2], qt[3]); *LDSP(u32x2, OQT + t * RS + 8 * cq) = o;
        o.x = pk2(kt[0], kt[1]); o.y = pk2(kt[2], kt[3]); *LDSP(u32x2, OKT + t * RS + 8 * cq) = o;
    }
    if (tseg == 15) { f32x4 d; d.x = __expf(GL.x); d.y = __expf(GL.y); d.z = __expf(GL.z); d.w = __expf(GL.w); *(f32x4*)((float*)(a.ws + WS_DEC) + task * 128 + 4 * cq) = d; }
    __syncthreads();
    bf16_t* AH = (bf16_t*)(a.ws + WS_AH) + task * 4096;
    if (wave < 4) {
        const int ti = (wave == 0 || wave == 3) ? 0 : 1, tj = (wave == 2 || wave == 3) ? 1 : 0;
        const int hh = lane >> 5, c31 = lane & 31;
        f32x16 acc = {0.f, 0.f, 0.f, 0.f, 0.f, 0.f, 0.f, 0.f, 0.f, 0.f, 0.f, 0.f, 0.f, 0.f, 0.f, 0.f};
        if (wave < 3) {
            unsigned oa = OQT + lp_row(lane, RS) + 32u * ti * RS, ob = OKT + lp_row(lane, RS) + 32u * tj * RS;
#pragma unroll 4
            for (int ks = 0; ks < 8; ++ks) { acc = MFMA32(frag_row(lds, oa), frag_row(lds, ob), acc); oa += 32; ob += 32; }
        }
#pragma unroll
        for (int i = 0; i < 16; ++i) { const int t = 32 * ti + accrow(i, hh), j = 32 * tj + c31;
            AH[t * 64 + j] = f2bf((wave < 3 && j <= t) ? acc[i] : 0.f); }
    }
    asm volatile("" :: "v"(pf));
    __syncthreads();
}
__device__ __forceinline__ void p3a_mlstm(const Args& a, LAS unsigned char* lds, int b, int c, int h, int tid, int wave, int lane, int tnext) {
    constexpr unsigned RS = 528, OK_ = 33792, ORS_ = 67584, OCS_ = 67584 + 256;
    const bf16_t* PROJ = (const bf16_t*)(a.ws + WS_PROJ);
    const float* GATE = (const float*)(a.ws + WS_GATE);
    const size_t r0 = (size_t)b * TP + (size_t)c * 64;
    const size_t task = ((size_t)b * NCH + c) * 4 + h;
    if (tid < 64) *LDSP(float, ORS_ + tid * 4) = 0.f;
    const int tg = tid & 7, g = tid >> 3, ch = h * 256 + 4 * g, gg = h * 64 + g;
    const float ig = GATE[(r0 + lane) * 8 + h], lfg = GATE[(r0 + lane) * 8 + 4 + h];
    u32x2 muw[11];
#pragma unroll
    for (int rr = 0; rr < 11; ++rr) { const int t = 8 * tg - 3 + rr; const bool pad = (c == 0 && t < 0);
        const int tt_ = pad ? 0 : t;
        const u32x2 w = *(const u32x2*)(PROJ + ml_tile(4, b, tt_ < 0 ? c - 1 : c, h) + (tt_ & 63) * 256 + 4 * g);
        muw[rr].x = pad ? 0u : w.x; muw[rr].y = pad ? 0u : w.y; }
    float cw[4][4], cb[4], wq[4][4], wk[4][4], wv[4][4];
#pragma unroll
    for (int w = 0; w < 4; ++w) { const f32x4 t = *(const f32x4*)(a.conv_w + w * 1024 + ch); cw[w][0] = t.x; cw[w][1] = t.y; cw[w][2] = t.z; cw[w][3] = t.w; }
    { const f32x4 t = *(const f32x4*)(a.conv_b + ch); cb[0] = t.x; cb[1] = t.y; cb[2] = t.z; cb[3] = t.w; }
#pragma unroll
    for (int i = 0; i < 4; ++i) { const f32x4 t0 = *(const f32x4*)(a.wq + gg * 16 + 4 * i), t1 = *(const f32x4*)(a.wk + gg * 16 + 4 * i), t2 = *(const f32x4*)(a.wv + gg * 16 + 4 * i);
#pragma unroll
        for (int j = 0; j < 4; ++j) { wq[i][j] = t0[j]; wk[i][j] = t1[j] * 0.0625f; wv[i][j] = t2[j]; } }
    const unsigned pf = (tnext >= 0) ? p3a_touch(a, tnext, tid) : 0u;
    float bt = lfg;
#pragma unroll
    for (int o = 1; o < 64; o <<= 1) { const float n = __shfl_up(bt, o); if (lane >= o) bt += n; }
    const float av = ig - bt; float R = av;
#pragma unroll
    for (int o = 1; o < 64; o <<= 1) R = fmaxf(R, __shfl_xor(R, o));
    const float wtok = __expf(av - R);
    if (wave == 0) { ((float*)(a.ws + WS_BT))[task * 64 + lane] = bt; if (lane == 0) ((float*)(a.ws + WS_RL))[task] = R; }
    {
        bf16_t* XC = (bf16_t*)(a.ws + WS_XC); bf16_t* QM = (bf16_t*)(a.ws + WS_QM); bf16_t* KM = (bf16_t*)(a.ws + WS_KM); bf16_t* VM = (bf16_t*)(a.ws + WS_VM);
        float cs[4] = {0.f, 0.f, 0.f, 0.f};
        u32x4 kT[4], vT[4];
#pragma unroll
        for (int tp = 0; tp < 4; ++tp) { float k2[2][4], v2[2][4];
#pragma unroll
          for (int u = 0; u < 2; ++u) { const int tt = 2 * tp + u; const int t = 8 * tg + tt; const float wt = __shfl(wtok, t);
            float m0[4], m1[4], m2[4], m3[4];
            m0[0] = bflo(muw[tt].x); m0[1] = bfhi(muw[tt].x); m0[2] = bflo(muw[tt].y); m0[3] = bfhi(muw[tt].y);
            m1[0] = bflo(muw[tt + 1].x); m1[1] = bfhi(muw[tt + 1].x); m1[2] = bflo(muw[tt + 1].y); m1[3] = bfhi(muw[tt + 1].y);
            m2[0] = bflo(muw[tt + 2].x); m2[1] = bfhi(muw[tt + 2].x); m2[2] = bflo(muw[tt + 2].y); m2[3] = bfhi(muw[tt + 2].y);
            m3[0] = bflo(muw[tt + 3].x); m3[1] = bfhi(muw[tt + 3].x); m3[2] = bflo(muw[tt + 3].y); m3[3] = bfhi(muw[tt + 3].y);
            float xc[4], q[4], k[4];
#pragma unroll
            for (int i = 0; i < 4; ++i) { const float cv = cb[i] + cw[0][i] * m0[i] + cw[1][i] * m1[i] + cw[2][i] * m2[i] + cw[3][i] * m3[i]; xc[i] = cv * sigmoidf_(cv); }
#pragma unroll
            for (int j = 0; j < 4; ++j) { q[j] = xc[0] * wq[0][j] + xc[1] * wq[1][j] + xc[2] * wq[2][j] + xc[3] * wq[3][j];
                k[j] = (xc[0] * wk[0][j] + xc[1] * wk[1][j] + xc[2] * wk[2][j] + xc[3] * wk[3][j]) * wt;
                v2[u][j] = m3[0] * wv[0][j] + m3[1] * wv[1][j] + m3[2] * wv[2][j] + m3[3] * wv[3][j]; cs[j] += k[j]; k2[u][j] = k[j]; }
            const size_t go = (task << 14) + t * 256 + 4 * g;
            u32x2 o; o.x = pk2(xc[0], xc[1]); o.y = pk2(xc[2], xc[3]); *(u32x2*)(XC + go) = o;
            o.x = pk2(q[0], q[1]); o.y = pk2(q[2], q[3]); *(u32x2*)(QM + go) = o; *LDSP(u32x2, t * RS + 8 * g) = o;
            o.x = pk2(k[0], k[1]); o.y = pk2(k[2], k[3]); *LDSP(u32x2, OK_ + t * RS + 8 * g) = o;
          }
#pragma unroll
          for (int j = 0; j < 4; ++j) { kT[j][tp] = pk2(k2[0][j], k2[1][j]); vT[j][tp] = pk2(v2[0][j], v2[1][j]); }
        }
#pragma unroll
        for (int j = 0; j < 4; ++j) { const size_t go = (task << 14) + (size_t)(4 * g + j) * 64 + 8 * tg;
            *(u32x4*)(KM + go) = kT[j]; *(u32x4*)(VM + go) = vT[j]; }
#pragma unroll
        for (int j = 0; j < 4; ++j) { cs[j] += __shfl_xor(cs[j], 1); cs[j] += __shfl_xor(cs[j], 2); cs[j] += __shfl_xor(cs[j], 4); }
        if (tg == 0) *LDSP(f32x4, OCS_ + 16 * g) = (f32x4){cs[0], cs[1], cs[2], cs[3]};
        if (c == NCH - 1 && tg == 7) {
#pragma unroll
            for (int j = 0; j < 3; ++j) *(f32x4*)(a.out + O_VP + ((size_t)b * 3 + j) * 1024 + ch) = (f32x4){bflo(muw[8 + j].x), bfhi(muw[8 + j].x), bflo(muw[8 + j].y), bfhi(muw[8 + j].y)};
        }
    }
    __syncthreads();
    bf16_t* AM = (bf16_t*)(a.ws + WS_AM) + task * 4096;
    if (wave < 4) {
        const int ti = (wave == 0 || wave == 3) ? 0 : 1, tj = (wave == 2 || wave == 3) ? 1 : 0;
        const int hh = lane >> 5, c31 = lane & 31;
        f32x16 acc = {0.f, 0.f, 0.f, 0.f, 0.f, 0.f, 0.f, 0.f, 0.f, 0.f, 0.f, 0.f, 0.f, 0.f, 0.f, 0.f};
        if (wave < 3) {
            unsigned oa = lp_row(lane, RS) + 32u * ti * RS, ob = OK_ + lp_row(lane, RS) + 32u * tj * RS;
#pragma unroll 4
            for (int ks = 0; ks < 16; ++ks) { acc = MFMA32(frag_row(lds, oa), frag_row(lds, ob), acc); oa += 32; ob += 32; }
        }
        float pv[16];
#pragma unroll
        for (int i = 0; i < 16; ++i) { const int t = 32 * ti + accrow(i, hh), j = 32 * tj + c31;
            pv[i] = (wave < 3 && j <= t) ? acc[i] : 0.f;
            AM[t * 64 + j] = f2bf(pv[i]); }
        if (wave < 3) {
#pragma unroll
            for (int bit = 8; bit >= 1; bit >>= 1) {
#pragma unroll
                for (int m = 0; m < bit; ++m) { const bool up = (lane & bit) != 0; const float send = up ? pv[m] : pv[m + bit], keep = up ? pv[m + bit] : pv[m];
                    pv[m] = keep + __shfl_xor(send, bit); }
            }
            const float tot = pv[0] + __shfl_xor(pv[0], 16);
            if ((lane & 16) == 0) { const int i = lane & 15; atomicAdd((float*)LDSP(float, ORS_ + (32 * ti + accrow(i, hh)) * 4), tot); }
        }
    }
    asm volatile("" :: "v"(pf));
    __syncthreads();
    if (tid < 64) ((float*)(a.ws + WS_RS))[task * 64 + tid] = *LDSP(const float, ORS_ + tid * 4);
    if (tid < 256) ((float*)(a.ws + WS_CSK))[task * 256 + tid] = *LDSP(const float, OCS_ + tid * 4);
    __syncthreads();
}

constexpr int NPART = 4, CPP = NCH / NPART;
constexpr size_t WS_SUMH = 2 * MiB;
constexpr size_t WS_DTOT = 14 * MiB;
constexpr size_t WS_SUMM = 484 * MiB;
constexpr size_t WS_SUMN = 508 * MiB;
constexpr size_t WS_SUMS = 508 * MiB + 512 * 1024;
constexpr size_t WS_STATS = 509 * MiB;
constexpr size_t WS_END2 = 510 * MiB;

template <int MODE>
__device__ __forceinline__ void p3b_hgrn(const Args& a, LAS unsigned char* lds, int b, int hp, int part, int tid, int wave, int lane) {
    constexpr unsigned RS = 272, RSA = 144, HB = 62464;
    constexpr unsigned OKE = 17408, OV = 34816, OA = 52224, ODEC = 61440;
    const int hhd = wave >> 2, vb = wave & 3, hl = lane >> 5, c31 = lane & 31;
    const bf16_t* PROJ = (const bf16_t*)(a.ws + WS_PROJ);
    const bf16_t* AH = (const bf16_t*)(a.ws + WS_AH);
    const float* DEC = (const float*)(a.ws + WS_DEC);
    bf16_t* MIX = (bf16_t*)(a.ws + WS_MIX);
    float* SUMH = (float*)(a.ws + WS_SUMH); float* DTOT = (float*)(a.ws + WS_DTOT);
    f32x16 acc[4];
#pragma unroll
    for (int kt = 0; kt < 4; ++kt)
#pragma unroll
        for (int i = 0; i < 16; ++i) acc[kt][i] = 0.f;
    unsigned hb = (unsigned)hhd * HB;
    unsigned o_perm = hb + lp_perm(lane, RS), o_rowA = hb + OA + lp_row(lane, RSA), o_trV = hb + OV + lp_tr(lane, RS) + 64u * vb, o_trK = hb + OKE + lp_tr(lane, RS);
    unsigned o_dec = hb + ODEC + 16u * hl, o_st = hb + 4u * hl * RS + (32u * vb + c31) * 2u;
    const size_t sbase = ((size_t)b * 4 + hp) * 3;
    if (MODE == 1) {
        for (int q = 0; q < part; ++q) {
            __syncthreads();
            if (tid < 256) *LDSP(float, (tid >> 7) * HB + ODEC + (tid & 127) * 4) = DTOT[(sbase + q) * 256 + tid];
            __syncthreads();
            const float* su = SUMH + ((sbase + q) * 2 + hhd) * 16384 + (size_t)(vb * 4) * 1024 + lane;
#pragma unroll
            for (int kt = 0; kt < 4; ++kt)
#pragma unroll
                for (int g4 = 0; g4 < 4; ++g4) { const f32x4 d = *LDSP(const f32x4, o_dec + (32 * kt + 8 * g4) * 4);
#pragma unroll
                    for (int e = 0; e < 4; ++e) acc[kt][4 * g4 + e] = acc[kt][4 * g4 + e] * d[e] + su[kt * 1024 + (4 * g4 + e) * 64]; }
        }
    }
    float dprod = 1.f;
    constexpr int NT = (MODE == 0) ? 8 : 12;
    u32x4 pre[NT], preA[2]; float preD = 0.f;
#define HG_TILE(idx, tile, head, which) const int tile = (MODE == 0) ? ((idx) >> 10) : ((idx) >> 10), head = (MODE == 0) ? (tile >> 1) : (tile / 3), which = (MODE == 0) ? (1 + (tile & 1)) : (tile % 3)
#define HG_ISSUE(cc) do { \
        _Pragma("unroll") for (int i = 0; i < NT; ++i) { const int idx = tl + NTHR * i; HG_TILE(idx, tile, head, which); const int rem = idx & 1023; \
            pre[i] = *(const u32x4*)(PROJ + hg_tile(which, b, (cc), 2 * hp + head) + rem * 8); } \
        if (MODE == 1) { _Pragma("unroll") for (int i = 0; i < 2; ++i) { const int idx = tl + NTHR * i, head = idx >> 9, rem = idx & 511; \
            preA[i] = *(const u32x4*)(AH + (((size_t)b * NCH + (cc)) * 8 + 2 * hp + head) * 4096 + rem * 8); } } \
        if (tl < 256) preD = DEC[(((size_t)b * NCH + (cc)) * 8 + 2 * hp + (tl >> 7)) * 128 + (tl & 127)]; } while (0)
    { int tl = tid; HG_ISSUE(part * CPP); }
    for (int c = part * CPP; c < (part + 1) * CPP; ++c) {
        int tl = tid; asm volatile("" : "+v"(tl));
        asm volatile("" : "+v"(o_perm), "+v"(o_rowA), "+v"(o_trV), "+v"(o_trK), "+v"(o_dec), "+v"(o_st));
        __syncthreads();
#pragma unroll
        for (int i = 0; i < NT; ++i) { const int idx = tl + NTHR * i; HG_TILE(idx, tile, head, which); const int rem = idx & 1023, row = rem >> 4, ch = rem & 15;
            *LDSP(u32x4, head * HB + which * 17408 + row * RS + 16 * ch) = pre[i]; }
        if (MODE == 1) {
#pragma unroll
            for (int i = 0; i < 2; ++i) { const int idx = tl + NTHR * i, head = idx >> 9, rem = idx & 511, row = rem >> 3, ch = rem & 7;
                *LDSP(u32x4, head * HB + OA + row * RSA + 16 * ch) = preA[i]; } }
        if (tl < 256) { *LDSP(float, (tl >> 7) * HB + ODEC + (tl & 127) * 4) = preD; dprod *= preD; }
        __syncthreads();
        if (c + 1 < (part + 1) * CPP) HG_ISSUE(c + 1);
        f32x16 o0, o1; bf16x8 vf[4];
        if (MODE == 1) {
#pragma unroll
            for (int i = 0; i < 16; ++i) { o0[i] = 0.f; o1[i] = 0.f; }
#pragma unroll
            for (int kt = 0; kt < 4; ++kt) {
                { const bf16x8 bf = acc_frag<0>(acc[kt]);
                  o0 = MFMA32(frag_perm(lds, o_perm + 64 * kt), bf, o0); o1 = MFMA32(frag_perm(lds, o_perm + 32 * RS + 64 * kt), bf, o1); }
                { const bf16x8 bf = acc_frag<1>(acc[kt]);
                  o0 = MFMA32(frag_perm(lds, o_perm + 64 * kt + 32), bf, o0); o1 = MFMA32(frag_perm(lds, o_perm + 32 * RS + 64 * kt + 32), bf, o1); }
                asm volatile("" : "+v"(o0), "+v"(o1) :: "memory");
            }
        }
#pragma unroll
        for (int js = 0; js < 4; ++js) vf[js] = frag_tr<RS>(lds, o_trV + 16 * js * RS);
        if (MODE == 1) {
#pragma unroll
            for (int js = 0; js < 4; ++js) { o0 = MFMA32(frag_row(lds, o_rowA + 32 * js), vf[js], o0); o1 = MFMA32(frag_row(lds, o_rowA + 32 * RSA + 32 * js), vf[js], o1); }
            asm volatile("" : "+v"(o0), "+v"(o1) :: "memory");
        }
#pragma unroll
        for (int kt = 0; kt < 4; ++kt) {
#pragma unroll
            for (int g4 = 0; g4 < 4; ++g4) { const f32x4 d = *LDSP(const f32x4, o_dec + (32 * kt + 8 * g4) * 4);
                acc[kt][4 * g4 + 0] *= d.x; acc[kt][4 * g4 + 1] *= d.y; acc[kt][4 * g4 + 2] *= d.z; acc[kt][4 * g4 + 3] *= d.w; }
            asm volatile("" : "+v"(acc[kt]) :: "memory"); }
#pragma unroll
        for (int kt = 0; kt < 4; ++kt) {
#pragma unroll
            for (int js = 0; js < 4; ++js) acc[kt] = MFMA32(frag_tr<RS>(lds, o_trK + 16 * js * RS + 64 * kt), vf[js], acc[kt]);
            asm volatile("" : "+v"(acc[kt]) :: "memory"); }
        if (MODE == 1) {
            __builtin_amdgcn_sched_barrier(0);
            __syncthreads();
#pragma unroll
            for (int i = 0; i < 16; ++i) {
                *LDSP(bf16_t, o_st + ACCROW0(i) * RS) = f2bf(o0[i]);
                *LDSP(bf16_t, o_st + (32 + ACCROW0(i)) * RS) = f2bf(o1[i]);
            }
            __syncthreads();
            const size_t r0 = (size_t)b * TP + (size_t)c * 64;
#pragma unroll
            for (int i = 0; i < 4; ++i) { const int idx = tl + NTHR * i, head = idx >> 10, rem = idx & 1023, row = rem >> 4, ch = rem & 15;
                const u32x4 w = *LDSP(const u32x4, head * HB + row * RS + 16 * ch);
                float v[8] = {bflo(w.x), bfhi(w.x), bflo(w.y), bfhi(w.y), bflo(w.z), bfhi(w.z), bflo(w.w), bfhi(w.w)};
                float ss = 0.f;
#pragma unroll
                for (int e = 0; e < 8; ++e) ss += v[e] * v[e];
                ss += __shfl_xor(ss, 1); ss += __shfl_xor(ss, 2); ss += __shfl_xor(ss, 4); ss += __shfl_xor(ss, 8);
                const float rn = 1.0f / sqrtf(ss * (1.f / 128.f) + EPS);
                const int col = (2 * hp + head) * 128 + 8 * ch;
                const u32x4 z = *(const u32x4*)(PROJ + hg_tile(3, b, c, 2 * hp + head) + rem * 8);
                const f32x4 g0 = *(const f32x4*)(a.hnorm_g + col), g1 = *(const f32x4*)(a.hnorm_g + col + 4);
                u32x4 o; o.x = pk2(v[0] * rn * g0.x * bflo(z.x), v[1] * rn * g0.y * bfhi(z.x)); o.y = pk2(v[2] * rn * g0.z * bflo(z.y), v[3] * rn * g0.w * bfhi(z.y));
                o.z = pk2(v[4] * rn * g1.x * bflo(z.z), v[5] * rn * g1.y * bfhi(z.z)); o.w = pk2(v[6] * rn * g1.z * bflo(z.w), v[7] * rn * g1.w * bfhi(z.w));
                *(u32x4*)(MIX + (r0 + row) * DMIX + col) = o;
            }
        }
    }
    if (MODE == 0) {
        float* su = SUMH + ((sbase + part) * 2 + hhd) * 16384 + (size_t)(vb * 4) * 1024 + lane;
#pragma unroll
        for (int kt = 0; kt < 4; ++kt)
#pragma unroll
            for (int i = 0; i < 16; ++i) su[kt * 1024 + i * 64] = acc[kt][i];
        if (tid < 256) DTOT[(sbase + part) * 256 + tid] = dprod;
    } else if (part == NPART - 1) {
        float* SP = a.out + O_HP + ((size_t)b * 8 + 2 * hp + hhd) * 128 * 128 + (size_t)(4 * hl) * 128 + 32 * vb + c31;
#pragma unroll
        for (int kt = 0; kt < 4; ++kt)
#pragma unroll
            for (int i = 0; i < 16; ++i) SP[(size_t)(32 * kt + ACCROW0(i)) * 128] = acc[kt][i];
    }
    __syncthreads();
#undef HG_TILE
#undef HG_ISSUE
}

template <int MODE>
__device__ __forceinline__ void p3b_mlstm(const Args& a, LAS unsigned char* lds, int b, int h, int part, int tid, int wave, int lane) {
    constexpr unsigned RS = 528;
    constexpr unsigned OKE = (MODE == 1) ? 33792u : 0u, OV = OKE + 32768u, OA = OV + 32768u;
    constexpr unsigned ON = (MODE == 1) ? OA + 8192u : 131072u, OD = ON + 1024, OBT = OD + 256, ORS = OBT + 256, OCS = ORS + 256, OSTG = OCS + 1024 + 256;
    static_assert(MODE == 0 || OSTG + 64 * RS <= (unsigned)MISC_OFF, "LDS layout");
    const int hl = lane >> 5, c31 = lane & 31;
    const bf16_t* PROJ = (const bf16_t*)(a.ws + WS_PROJ);
    const bf16_t* QM = (const bf16_t*)(a.ws + WS_QM); const bf16_t* KM = (const bf16_t*)(a.ws + WS_KM); const bf16_t* VM = (const bf16_t*)(a.ws + WS_VM); const bf16_t* XC = (const bf16_t*)(a.ws + WS_XC);
    const bf16_t* AM = (const bf16_t*)(a.ws + WS_AM);
    bf16_t* MIX = (bf16_t*)(a.ws + WS_MIX);
    float* SUMM = (float*)(a.ws + WS_SUMM); float* SUMN = (float*)(a.ws + WS_SUMN); float* SUMS = (float*)(a.ws + WS_SUMS);
    f32x16 acc[8];
#pragma unroll
    for (int kt = 0; kt < 8; ++kt)
#pragma unroll
        for (int i = 0; i < 16; ++i) acc[kt][i] = 0.f;
    if (tid < 256) *LDSP(float, ON + tid * 4) = 0.f;
    float mu = 0.f, mrun = (MODE == 0) ? -1e30f : 0.f, bsum = 0.f;
    const size_t sbase = ((size_t)b * 4 + h) * 3;
    if (MODE == 1 && part > 0) {
        float muU[3], Bq[3], Mq[3], cq[3];
#pragma unroll
        for (int q = 0; q < 3; ++q) { const float* s3 = SUMS + (sbase + (q < part ? q : 0)) * 4; muU[q] = s3[0]; Bq[q] = s3[1]; Mq[q] = s3[2]; }
        float sb = 0.f, mus = -1e30f, e[3];
#pragma unroll
        for (int q = 2; q >= 0; --q) { if (q < part) { e[q] = muU[q] + sb; mus = fmaxf(mus, e[q]); sb += Bq[q]; } else e[q] = -1e30f; }
#pragma unroll
        for (int q = 0; q < 3; ++q) { cq[q] = (q < part) ? __expf(e[q] - mus) : 0.f; if (q < part) mrun = fmaxf(mrun + Bq[q], Mq[q]); }
        mu = mus;
        const float* su0 = SUMM + (sbase + 0) * 65536 + (size_t)(wave * 8) * 1024 + lane * 16;
#pragma unroll
        for (int kp = 0; kp < 4; ++kp) {
            f32x4 t[3][2][4];
#pragma unroll
            for (int q = 0; q < 3; ++q) { const float* su = su0 + (size_t)(q < part ? q : 0) * 65536;
#pragma unroll
                for (int k2 = 0; k2 < 2; ++k2)
#pragma unroll
                    for (int g = 0; g < 4; ++g) t[q][k2][g] = *(const f32x4*)(su + (2 * kp + k2) * 1024 + 4 * g); }
#pragma unroll
            for (int k2 = 0; k2 < 2; ++k2)
#pragma unroll
                for (int g = 0; g < 4; ++g)
#pragma unroll
                    for (int e4 = 0; e4 < 4; ++e4) acc[2 * kp + k2][4 * g + e4] = cq[0] * t[0][k2][g][e4] + cq[1] * t[1][k2][g][e4] + cq[2] * t[2][k2][g][e4];
            asm volatile("" : "+v"(acc[2 * kp]), "+v"(acc[2 * kp + 1]) :: "memory");
        }
        if (tid < 256) { float n = 0.f;
#pragma unroll
            for (int q = 0; q < 3; ++q) n += cq[q] * SUMN[(sbase + (q < part ? q : 0)) * 256 + tid];
            *LDSP(float, ON + tid * 4) = n; }
    }
    const unsigned xs_ = (unsigned)((c31 >> 1) & 7);
    const unsigned fb_ = (unsigned)c31 * 128u + (((unsigned)hl ^ (xs_ & 1u)) << 4) + ((xs_ >> 1) << 5);
    unsigned o_perm = lp_perm(lane, RS), o_rowA = OA + fb_, o_trV = OV + 4096u * (unsigned)wave + fb_, o_trK = OKE + fb_;
    unsigned o_st = OSTG + 4u * hl * RS + (32u * wave + c31) * 2u, o_h = 16u * hl;
    const int c_end = (part + 1) * CPP;
    float preRL = 0.f, preC = 0.f, preBL = 0.f;
#define ML_DMA_TILE(gsrc, ldsoff, n) do { const char* g_ = (const char*)(gsrc) + vK; \
        _Pragma("unroll") for (int i_ = 0; i_ < (n); ++i_) __builtin_amdgcn_global_load_lds((const unsigned*)(g_ + i_ * 8192), (LAS unsigned*)(lds + (ldsoff) + i_ * 8192u + 1024u * (unsigned)wave), 16, 0, 0); } while (0)
#define ML_ISSUE(cc, bufo) do { const size_t task_ = ((size_t)b * NCH + (cc)) * 4 + h; \
        const unsigned vK = (unsigned)(tl >> 3) * 128u + ((((unsigned)tl & 7u) ^ (((unsigned)tl >> 4) & 7u)) << 4); \
        ML_DMA_TILE(KM + (task_ << 14), (bufo) + OKE, 4); ML_DMA_TILE(VM + (task_ << 14), (bufo) + OV, 4); \
        if (MODE == 1) { ML_DMA_TILE(AM + task_ * 4096, OA, 1); \
            if (wave < 4) __builtin_amdgcn_global_load_lds((const unsigned*)((const float*)(a.ws + WS_CSK) + task_ * 256 + (tl & 255)), (LAS unsigned*)(lds + OCS + 256u * (unsigned)wave), 4, 0, 0); \
            else if (wave == 4) __builtin_amdgcn_global_load_lds((const unsigned*)((const float*)(a.ws + WS_BT) + task_ * 64 + (tl & 63)), (LAS unsigned*)(lds + OBT), 4, 0, 0); \
            else if (wave == 5) __builtin_amdgcn_global_load_lds((const unsigned*)((const float*)(a.ws + WS_RS) + task_ * 64 + (tl & 63)), (LAS unsigned*)(lds + ORS), 4, 0, 0); \
            _Pragma("unroll") for (int i_ = 0; i_ < 5; ++i_) { if (i_ < 4 || wave == 0) { const unsigned q_ = 512u * i_ + (unsigned)tl, row_ = (q_ * 1986u) >> 16; unsigned cp_ = q_ - 33u * row_; cp_ = cp_ > 31u ? 31u : cp_;   \
                __builtin_amdgcn_global_load_lds((const unsigned*)((const char*)(QM + (task_ << 14)) + (row_ * 32u + cp_) * 16u), (LAS unsigned*)(lds + i_ * 8192u + 1024u * (unsigned)wave), 16, 0, 0); } } } \
        else { preC = ((const float*)(a.ws + WS_CSK))[task_ * 256 + (tl & 255)]; preBL = ((const float*)(a.ws + WS_BT))[task_ * 64 + 63]; } \
        preRL = ((const float*)(a.ws + WS_RL))[task_]; } while (0)
    __syncthreads();
    { int tl = tid; asm volatile("" : "+v"(tl)); ML_ISSUE(part * CPP, 0u); }
    for (int c = part * CPP; c < c_end; ++c) {
        int tl = tid; asm volatile("" : "+v"(tl));
        asm volatile("" : "+v"(o_perm), "+v"(o_rowA), "+v"(o_trV), "+v"(o_trK), "+v"(o_st), "+v"(o_h));
        const size_t r0 = (size_t)b * TP + (size_t)c * 64;
        const size_t task = ((size_t)b * NCH + c) * 4 + h;
        const float R = preRL, cskv = preC, bL0 = preBL;
        if (MODE == 1) {
            if (c == part * CPP) asm volatile("s_waitcnt vmcnt(0)" ::: "memory"); else asm volatile("s_waitcnt vmcnt(4)" ::: "memory");
        } else asm volatile("s_waitcnt vmcnt(0)" ::: "memory");
        __syncthreads();
        const unsigned bo = (MODE == 0) ? (unsigned)((c - part * CPP) & 1) * 65536u : 0u;
        if (MODE == 0) { if (c + 1 < c_end) ML_ISSUE(c + 1, 65536u - bo); }
        const float sc = __expf(mu - R);
        f32x16 o0, o1; bf16x8 vf[4];
        if (MODE == 1) {
            { const int t = tl >> 3, sub = tl & 7; float p = 0.f;
#pragma unroll
              for (int j = 0; j < 4; ++j) { const u32x4 w = *LDSP(const u32x4, t * RS + (sub * 32 + 8 * j) * 2);
                  const f32x4 n0 = *LDSP(const f32x4, ON + (sub * 32 + 8 * j) * 4), n1 = *LDSP(const f32x4, ON + (sub * 32 + 8 * j + 4) * 4);
                  p += bflo(w.x) * n0.x + bfhi(w.x) * n0.y + bflo(w.y) * n0.z + bfhi(w.y) * n0.w + bflo(w.z) * n1.x + bfhi(w.z) * n1.y + bflo(w.w) * n1.z + bfhi(w.w) * n1.w; }
              p += __shfl_xor(p, 1); p += __shfl_xor(p, 2); p += __shfl_xor(p, 4);
              if (sub == 0) { const float den = fmaxf(fabsf(sc * p + *LDSP(const float, ORS + t * 4)), __expf(-(*LDSP(const float, OBT + t * 4) + R)));
                  *LDSP(float, OD + t * 4) = __builtin_amdgcn_rcpf(den); } }
        }
#pragma unroll
        for (int kt = 0; kt < 8; ++kt)
#pragma unroll
            for (int i = 0; i < 16; ++i) acc[kt][i] *= sc;
        if (MODE == 1) {
#pragma unroll
            for (int i = 0; i < 16; ++i) { o0[i] = 0.f; o1[i] = 0.f; }
#pragma unroll
            for (int kt = 0; kt < 8; ++kt) {
                { const bf16x8 bf = acc_frag<0>(acc[kt]);
                  o0 = MFMA32(frag_perm(lds, o_perm + 64 * kt), bf, o0); o1 = MFMA32(frag_perm(lds, o_perm + 32 * RS + 64 * kt), bf, o1); }
                { const bf16x8 bf = acc_frag<1>(acc[kt]);
                  o0 = MFMA32(frag_perm(lds, o_perm + 64 * kt + 32), bf, o0); o1 = MFMA32(frag_perm(lds, o_perm + 32 * RS + 64 * kt + 32), bf, o1); }
                asm volatile("" : "+v"(o0), "+v"(o1) :: "memory");
            }
        }
#pragma unroll
        for (int js = 0; js < 4; ++js) vf[js] = frag_row(lds, ((o_trV + bo) ^ (32u * js)));
        if (MODE == 1) {
#pragma unroll
            for (int js = 0; js < 4; ++js) { const unsigned oa = o_rowA ^ (32u * js); o0 = MFMA32(frag_row(lds, oa), vf[js], o0); o1 = MFMA32(frag_row(lds, oa + 4096u), vf[js], o1); }
            asm volatile("" : "+v"(o0), "+v"(o1) :: "memory");
        }
        { unsigned okj[4];
#pragma unroll
          for (int js = 0; js < 4; ++js) okj[js] = (o_trK + bo) ^ (32u * js);
#pragma unroll
          for (int kt = 0; kt < 8; ++kt) {
#pragma unroll
            for (int js = 0; js < 4; ++js) acc[kt] = MFMA32(frag_row(lds, okj[js] + 4096u * kt), vf[js], acc[kt]);
            asm volatile("" : "+v"(acc[kt]) :: "memory"); } }
        const float bL = (MODE == 1) ? *LDSP(const float, OBT + 63 * 4) : bL0;
#ifndef RPN
#define RPN 2
#endif
        u32x4 rpm[4], rpz[4], rpx[4];
        if (MODE == 1) {
#pragma unroll
            for (int i = 0; i < RPN; ++i) { const int idx = tl + NTHR * i;
                rpm[i] = *(const u32x4*)(PROJ + ml_tile(6, b, c, h) + idx * 8);
                rpz[i] = *(const u32x4*)(PROJ + ml_tile(5, b, c, h) + idx * 8);
                rpx[i] = *(const u32x4*)(XC + (task << 14) + idx * 8); }
        }
        if (MODE == 0) { if (tl < 256) *LDSP(float, ON + tl * 4) = sc * *LDSP(const float, ON + tl * 4) + cskv; }
        if (MODE == 1) {
            __builtin_amdgcn_sched_barrier(0);
            __syncthreads();
            if (tl < 256) *LDSP(float, ON + tl * 4) = sc * *LDSP(const float, ON + tl * 4) + *LDSP(const float, OCS + tl * 4);
            if (c + 1 < c_end) ML_ISSUE(c + 1, 0u);
#pragma unroll
            for (int g4 = 0; g4 < 4; ++g4) {
                const f32x4 d0 = *LDSP(const f32x4, OD + o_h + 32 * g4), d1 = *LDSP(const f32x4, OD + o_h + 128 + 32 * g4);
#pragma unroll
                for (int e = 0; e < 4; ++e) {
                    *LDSP(bf16_t, o_st + (8 * g4 + e) * RS) = f2bf(o0[4 * g4 + e] * d0[e]);
                    *LDSP(bf16_t, o_st + (32 + 8 * g4 + e) * RS) = f2bf(o1[4 * g4 + e] * d1[e]);
                }
            }
            __syncthreads();
#pragma unroll
            for (int i = 0; i < 4; ++i) { const int idx = tl + NTHR * i, row = idx >> 5, ch = idx & 31, col = h * 256 + 8 * ch;
                const u32x4 w = *LDSP(const u32x4, OSTG + row * RS + 16 * ch);
                const u32x4 mo = (i < RPN) ? rpm[i] : *(const u32x4*)(PROJ + ml_tile(6, b, c, h) + idx * 8);
                float v[8] = {bflo(w.x) * bflo(mo.x), bfhi(w.x) * bfhi(mo.x), bflo(w.y) * bflo(mo.y), bfhi(w.y) * bfhi(mo.y), bflo(w.z) * bflo(mo.z), bfhi(w.z) * bfhi(mo.z), bflo(w.w) * bflo(mo.w), bfhi(w.w) * bfhi(mo.w)};
                float ss = 0.f;
#pragma unroll
                for (int e = 0; e < 8; ++e) ss += v[e] * v[e];
                ss += __shfl_xor(ss, 1); ss += __shfl_xor(ss, 2); ss += __shfl_xor(ss, 4); ss += __shfl_xor(ss, 8); ss += __shfl_xor(ss, 16);
                const float rn = 1.0f / sqrtf(ss * (1.f / 256.f) + EPS);
                const u32x4 z = (i < RPN) ? rpz[i] : *(const u32x4*)(PROJ + ml_tile(5, b, c, h) + idx * 8);
                const u32x4 xc = (i < RPN) ? rpx[i] : *(const u32x4*)(XC + (task << 14) + idx * 8);
                const f32x4 g0 = *(const f32x4*)(a.mnorm_g + col), g1 = *(const f32x4*)(a.mnorm_g + col + 4), k0 = *(const f32x4*)(a.skip + col), k1 = *(const f32x4*)(a.skip + col + 4);
                u32x4 o;
                o.x = pk2((v[0] * rn * g0.x + k0.x * bflo(xc.x)) * bflo(z.x), (v[1] * rn * g0.y + k0.y * bfhi(xc.x)) * bfhi(z.x));
                o.y = pk2((v[2] * rn * g0.z + k0.z * bflo(xc.y)) * bflo(z.y), (v[3] * rn * g0.w + k0.w * bfhi(xc.y)) * bfhi(z.y));
                o.z = pk2((v[4] * rn * g1.x + k1.x * bflo(xc.z)) * bflo(z.z), (v[5] * rn * g1.y + k1.y * bfhi(xc.z)) * bfhi(z.z));
                o.w = pk2((v[6] * rn * g1.z + k1.z * bflo(xc.w)) * bflo(z.w), (v[7] * rn * g1.w + k1.w * bfhi(xc.w)) * bfhi(z.w));
                *(u32x4*)(MIX + (r0 + row) * DMIX + 1024 + col) = o;
            }
        }
        mu = bL + R; mrun = bL + fmaxf(mrun, R); bsum += bL;
    }
    __syncthreads();
    if (MODE == 0) {
        float* su = SUMM + (sbase + part) * 65536 + (size_t)(wave * 8) * 1024 + lane * 16;
#pragma unroll
        for (int kt = 0; kt < 8; ++kt)
#pragma unroll
            for (int g = 0; g < 4; ++g) *(f32x4*)(su + kt * 1024 + 4 * g) = (f32x4){acc[kt][4 * g], acc[kt][4 * g + 1], acc[kt][4 * g + 2], acc[kt][4 * g + 3]};
        if (tid < 256) SUMN[(sbase + part) * 256 + tid] = *LDSP(const float, ON + tid * 4);
        if (tid == 0) { float* s3 = SUMS + (sbase + part) * 4; s3[0] = mu; s3[1] = bsum; s3[2] = mrun; }
    } else if (part == NPART - 1) {
        const float fs = __expf(mu - mrun);
        float* CP = a.out + O_CP + ((size_t)b * 4 + h) * 65536 + (size_t)(4 * hl) * 256 + 32 * wave + c31;
#pragma unroll
        for (int kt = 0; kt < 8; ++kt)
#pragma unroll
            for (int i = 0; i < 16; ++i) CP[(size_t)(32 * kt + ACCROW0(i)) * 256] = acc[kt][i] * fs;
        if (tid < 256) a.out[O_NP + ((size_t)b * 4 + h) * 256 + tid] = *LDSP(const float, ON + tid * 4) * fs;
        if (tid == 0) a.out[O_MP + b * 4 + h] = mrun;
    }
    __syncthreads();
#undef ML_ISSUE
#undef ML_DMA_TILE
}

__device__ __forceinline__ void p3b_sample_hgrn(const Args& a, LAS unsigned char* lds, int b, int h, int tid, int wave, int lane) {
    LAS float* sq = (LAS float*)lds; LAS float* sf = sq + 512; LAS float* sk = sf + 512; LAS float* sv = sk + 512;
    LAS float* sPO = sv + 512;
    const bf16_t* PROJ = (const bf16_t*)(a.ws + WS_PROJ) + PS_OFF - (size_t)MP * NPROJ;   const float* LOGFS = (const float*)(a.ws + WS_LOGFS);
    const size_t rb = (size_t)MP + (size_t)b * 4;
    const int vq = tid & 31, kr = tid >> 5;
    const float* S0 = a.st_h + ((size_t)b * 8 + h) * 16384; float* S1 = a.out + O_HS + ((size_t)b * 8 + h) * 16384;
    f32x4 S[8];
#pragma unroll
    for (int i = 0; i < 8; ++i) S[i] = __builtin_nontemporal_load((const f32x4*)(S0 + (size_t)(kr + 16 * i) * 128 + 4 * vq));
    __syncthreads();
    { const int t = tid >> 7, k = tid & 127; const float f = __expf(LOGFS[((size_t)b * 4 + t) * 1024 + h * 128 + k]);
      sf[tid] = f; sk[tid] = 1.f - f; sq[tid] = bf2f(PROJ[(rb + t) * NPROJ + h * 128 + k]); sv[tid] = bf2f(PROJ[(rb + t) * NPROJ + 2048 + h * 128 + k]); }
    __syncthreads();
    f32x4 vv[4], po[4];
#pragma unroll
    for (int t = 0; t < 4; ++t) { vv[t] = *(const LAS f32x4*)(sv + t * 128 + 4 * vq); po[t] = (f32x4){0.f, 0.f, 0.f, 0.f}; }
#pragma unroll
    for (int i = 0; i < 8; ++i) { const int k = kr + 16 * i;
#pragma unroll
        for (int t = 0; t < 4; ++t) { S[i] = S[i] * sf[t * 128 + k] + vv[t] * sk[t * 128 + k]; po[t] += S[i] * sq[t * 128 + k]; }
        __builtin_nontemporal_store(S[i], (f32x4*)(S1 + (size_t)k * 128 + 4 * vq)); }
#pragma unroll
    for (int t = 0; t < 4; ++t) *(LAS f32x4*)(sPO + (kr * 4 + t) * 128 + 4 * vq) = po[t];
    __syncthreads();
    if (wave < 4) { const int t = wave; float o[2]; float ss = 0.f;
#pragma unroll
        for (int j = 0; j < 2; ++j) { const int v = lane + 64 * j; float s = 0.f;
#pragma unroll
            for (int r = 0; r < 16; ++r) s += sPO[(r * 4 + t) * 128 + v];
            o[j] = s; ss += s * s; }
        ss = wave_sum(ss); const float rn = 1.0f / sqrtf(ss * (1.f / 128.f) + EPS);
#pragma unroll
        for (int j = 0; j < 2; ++j) { const int col = h * 128 + lane + 64 * j;
            const float z = bf2f(PROJ[(rb + t) * NPROJ + 3072 + col]);
            ((bf16_t*)(a.ws + WS_MIX))[(rb + t) * DMIX + col] = f2bf(o[j] * rn * a.hnorm_g[col] * z); }
    }
}
__device__ __forceinline__ void p3b_sample_hgrn4(const Args& a, LAS unsigned char* lds, int b, int hq, int tid, int wave, int lane) {
    LAS float* sT = (LAS float*)lds;
    LAS float* sPO = sT + 8192;
    const bf16_t* PROJ = (const bf16_t*)(a.ws + WS_PROJ) + PS_OFF - (size_t)MP * NPROJ; const float* LOGFS = (const float*)(a.ws + WS_LOGFS);
    const size_t rb = (size_t)MP + (size_t)b * 4;
    const int vq = tid & 31, kr = tid >> 5, h0 = 4 * hq;
    const float* S0 = a.st_h + ((size_t)b * 8 + h0) * 16384; float* S1 = a.out + O_HS + ((size_t)b * 8 + h0) * 16384;
    f32x4 S[8], Sn[8];
#pragma unroll
    for (int i = 0; i < 8; ++i) S[i] = __builtin_nontemporal_load((const f32x4*)(S0 + (size_t)(kr + 16 * i) * 128 + 4 * vq));
    float lf[4], qv[4], vvv[4], zr[4][2], gr[4][2];
    { const int t = tid >> 7, k = tid & 127;
#pragma unroll
      for (int hh = 0; hh < 4; ++hh) { const int col = (h0 + hh) * 128 + k;
          lf[hh] = LOGFS[((size_t)b * 4 + t) * 1024 + col]; qv[hh] = bf2f(PROJ[(rb + t) * NPROJ + col]); vvv[hh] = bf2f(PROJ[(rb + t) * NPROJ + 2048 + col]); } }
    { const int t = wave & 3;
#pragma unroll
      for (int hh = 0; hh < 4; ++hh)
#pragma unroll
          for (int j = 0; j < 2; ++j) { const int col = (h0 + hh) * 128 + lane + 64 * j; zr[hh][j] = bf2f(PROJ[(rb + t) * NPROJ + 3072 + col]); gr[hh][j] = a.hnorm_g[col]; } }
    __syncthreads();
#pragma unroll
    for (int hh = 0; hh < 4; ++hh) { const float f = __expf(lf[hh]); LAS float* p = sT + hh * 2048 + tid;
        p[0] = qv[hh]; p[512] = f; p[1024] = 1.f - f; p[1536] = vvv[hh]; }
    __syncthreads();
#pragma unroll
    for (int hh = 0; hh < 4; ++hh) {
        const LAS float* sq = sT + hh * 2048; const LAS float* sf = sq + 512; const LAS float* sk = sf + 512; const LAS float* sv = sk + 512;
        LAS float* po_ = sPO + (hh & 1) * 8192;
        if (hh < 3) {
#pragma unroll
            for (int i = 0; i < 8; ++i) Sn[i] = __builtin_nontemporal_load((const f32x4*)(S0 + (size_t)(hh + 1) * 16384 + (size_t)(kr + 16 * i) * 128 + 4 * vq));
        }
        f32x4 vv[4], po[4];
#pragma unroll
        for (int t = 0; t < 4; ++t) { vv[t] = *(const LAS f32x4*)(sv + t * 128 + 4 * vq); po[t] = (f32x4){0.f, 0.f, 0.f, 0.f}; }
#pragma unroll
        for (int i = 0; i < 8; ++i) { const int k = kr + 16 * i;
#pragma unroll
            for (int t = 0; t < 4; ++t) { S[i] = S[i] * sf[t * 128 + k] + vv[t] * sk[t * 128 + k]; po[t] += S[i] * sq[t * 128 + k]; }
            __builtin_nontemporal_store(S[i], (f32x4*)(S1 + (size_t)hh * 16384 + (size_t)k * 128 + 4 * vq)); }
#pragma unroll
        for (int t = 0; t < 4; ++t) *(LAS f32x4*)(po_ + (kr * 4 + t) * 128 + 4 * vq) = po[t];
        __syncthreads();
        if (wave < 4) { const int t = wave; float o[2]; float ss = 0.f;
#pragma unroll
            for (int j = 0; j < 2; ++j) { const int v = lane + 64 * j; float s_ = 0.f;
#pragma unroll
                for (int r = 0; r < 16; ++r) s_ += po_[(r * 4 + t) * 128 + v];
                o[j] = s_; ss += s_ * s_; }
            ss = wave_sum(ss); const float rn = 1.0f / sqrtf(ss * (1.f / 128.f) + EPS);
#pragma unroll
            for (int j = 0; j < 2; ++j) { const int col = (h0 + hh) * 128 + lane + 64 * j;
                ((bf16_t*)(a.ws + WS_MIX))[(rb + t) * DMIX + col] = f2bf(o[j] * rn * gr[hh][j] * zr[hh][j]); }
        }
        if (hh < 3) {
#pragma unroll
            for (int i = 0; i < 8; ++i) S[i] = Sn[i];
        }
    }
}
__device__ __forceinline__ void p3b_sample_mlstm(const Args& a, LAS unsigned char* lds, int b, int h, int tid, int wave, int lane) {
    LAS float* sxc = (LAS float*)lds; LAS float* sq = sxc + 1024; LAS float* sk = sq + 1024; LAS float* sv = sk + 1024;
    LAS float* sDen = sv + 1024;
    LAS float* sPN = sDen + 16;
    const bf16_t* PROJ = (const bf16_t*)(a.ws + WS_PROJ) + PS_OFF - (size_t)MP * NPROJ;   const float* GATE = (const float*)(a.ws + WS_GATE);
    const size_t rb = (size_t)MP + (size_t)b * 4;
    const int vq = tid & 63, kr = tid >> 6;
    const float* C0 = a.st_C + ((size_t)b * 4 + h) * 65536; float* C1 = a.out + O_CS + ((size_t)b * 4 + h) * 65536;
    f32x4 Ca[8], Cb[8];
#pragma unroll
    for (int i = 0; i < 8; ++i) { Ca[i] = __builtin_nontemporal_load((const f32x4*)(C0 + (size_t)(kr + 8 * i) * 256 + 4 * vq)); Cb[i] = __builtin_nontemporal_load((const f32x4*)(C0 + (size_t)(kr + 8 * (8 + i)) * 256 + 4 * vq)); }
    __syncthreads();
    if (tid < 256) {
        const int t = tid >> 6, g = tid & 63, ch = h * 256 + 4 * g, gg = h * 64 + g;
        float e[4][4];
#pragma unroll
        for (int w = 0; w < 4; ++w) { const int idx = t + w;
            if (idx < 3) { const f32x4 x = *(const f32x4*)(a.st_conv + ((size_t)b * 3 + idx) * 1024 + ch); e[w][0] = x.x; e[w][1] = x.y; e[w][2] = x.z; e[w][3] = x.w; }
            else { const u32x2 x = *(const u32x2*)(PROJ + (rb + idx - 3) * NPROJ + 4096 + ch); e[w][0] = bflo(x.x); e[w][1] = bfhi(x.x); e[w][2] = bflo(x.y); e[w][3] = bfhi(x.y); } }
        float xc[4];
#pragma unroll
        for (int i = 0; i < 4; ++i) { float cv = a.conv_b[ch + i];
#pragma unroll
            for (int w = 0; w < 4; ++w) cv += a.conv_w[w * 1024 + ch + i] * e[w][i];
            xc[i] = cv * sigmoidf_(cv); }
#pragma unroll
        for (int j = 0; j < 4; ++j) { float q = 0.f, k = 0.f, v = 0.f;
#pragma unroll
            for (int i = 0; i < 4; ++i) { q += xc[i] * a.wq[gg * 16 + 4 * i + j]; k += xc[i] * a.wk[gg * 16 + 4 * i + j]; v += e[3][i] * a.wv[gg * 16 + 4 * i + j]; }
            sxc[t * 256 + 4 * g + j] = xc[j]; sq[t * 256 + 4 * g + j] = q; sk[t * 256 + 4 * g + j] = k * 0.0625f; sv[t * 256 + 4 * g + j] = v; }
        if (t == 3) {
#pragma unroll
            for (int j = 0; j < 3; ++j) *(f32x4*)(a.out + O_VS + ((size_t)b * 3 + j) * 1024 + ch) = (f32x4){e[1 + j][0], e[1 + j][1], e[1 + j][2], e[1 + j][3]};
        }
    }
    float fd[4], iw[4], mt[4];
    { float m = a.st_m[b * 4 + h];
#pragma unroll
      for (int t = 0; t < 4; ++t) { const float ig = GATE[(rb + t) * 8 + h], lf = GATE[(rb + t) * 8 + 4 + h]; const float mn = fmaxf(lf + m, ig);
          fd[t] = __expf(lf + m - mn); iw[t] = __expf(ig - mn); mt[t] = mn; m = mn; } }
    __syncthreads();
    if (tid < 256) { float n = a.st_n[((size_t)b * 4 + h) * 256 + tid]; float pd[4];
#pragma unroll
        for (int t = 0; t < 4; ++t) { n = fd[t] * n + iw[t] * sk[t * 256 + tid]; pd[t] = sq[t * 256 + tid] * n; }
        a.out[O_NS + ((size_t)b * 4 + h) * 256 + tid] = n;
#pragma unroll
        for (int t = 0; t < 4; ++t) { const float s = wave_sum(pd[t]); if (lane == 0) sDen[wave * 4 + t] = s; } }
    f32x4 vv[4], pn[4];
#pragma unroll
    for (int t = 0; t < 4; ++t) { vv[t] = *(const LAS f32x4*)(sv + t * 256 + 4 * vq) * iw[t]; pn[t] = (f32x4){0.f, 0.f, 0.f, 0.f}; }
#define SM_BATCH(C, bi, reload) do { \
        _Pragma("unroll") for (int i = 0; i < 8; ++i) { const int k = kr + 8 * (8 * (bi) + i); \
            _Pragma("unroll") for (int t = 0; t < 4; ++t) { C[i] = C[i] * fd[t] + vv[t] * sk[t * 256 + k]; pn[t] += C[i] * sq[t * 256 + k]; } \
            __builtin_nontemporal_store(C[i], (f32x4*)(C1 + (size_t)k * 256 + 4 * vq)); \
            if (reload) C[i] = __builtin_nontemporal_load((const f32x4*)(C0 + (size_t)(kr + 8 * (8 * ((bi) + 2) + i)) * 256 + 4 * vq)); } } while (0)
    SM_BATCH(Ca, 0, true); SM_BATCH(Cb, 1, true); SM_BATCH(Ca, 2, false); SM_BATCH(Cb, 3, false);
#undef SM_BATCH
#pragma unroll
    for (int t = 0; t < 4; ++t) *(LAS f32x4*)(sPN + (kr * 4 + t) * 256 + 4 * vq) = pn[t];
    __syncthreads();
    if (wave < 4) { const int t = wave;
        const float den = sDen[t] + sDen[4 + t] + sDen[8 + t] + sDen[12 + t];
        const float hden = fmaxf(fabsf(den), __expf(-mt[t]));
        float hm[4]; float ss = 0.f;
#pragma unroll
        for (int j = 0; j < 4; ++j) { const int v = lane + 64 * j; float s = 0.f;
#pragma unroll
            for (int r = 0; r < 8; ++r) s += sPN[(r * 4 + t) * 256 + v];
            hm[j] = s / hden * bf2f(PROJ[(rb + t) * NPROJ + 6144 + h * 256 + v]); ss += hm[j] * hm[j]; }
        ss = wave_sum(ss); const float rn = 1.0f / sqrtf(ss * (1.f / 256.f) + EPS);
#pragma unroll
        for (int j = 0; j < 4; ++j) { const int v = lane + 64 * j, col = h * 256 + v;
            const float z = bf2f(PROJ[(rb + t) * NPROJ + 5120 + col]);
            ((bf16_t*)(a.ws + WS_MIX))[(rb + t) * DMIX + 1024 + col] = f2bf((hm[j] * rn * a.mnorm_g[col] + a.skip[col] * sxc[t * 256 + v]) * z); }
        if (t == 3 && lane == 0) a.out[O_MS + b * 4 + h] = mt[3];
    }
}

typedef float f32x4v __attribute__((ext_vector_type(4)));
__device__ __forceinline__ void small_gemm_out(const Args& a, int vcu, int G, int wave, int lane, unsigned* cnt_s) {
    const bf16_t* MIX = (const bf16_t*)(a.ws + WS_MIX); const bf16_t* WoutT = (const bf16_t*)(a.ws + WS_WOUT); const float* MOD = (const float*)(a.ws + WS_MOD);
    const int r = lane & 15, kq = lane >> 4;
    for (int t = vcu * NWAVES + wave; t < 32 * 64; t += G * NWAVES) {
        const int mt = t >> 6, nt = t & 63;
        const bf16_t* ap = MIX + (size_t)(MP + 16 * mt + r) * DMIX + 8 * kq;
        const bf16_t* bp = WoutT + (size_t)(16 * nt + r) * DMIX + 8 * kq;
        f32x4v acc = {0.f, 0.f, 0.f, 0.f};
        bf16x8 af[8], bfr[8], an[8], bn[8];
#pragma unroll
        for (int j = 0; j < 8; ++j) { af[j] = *(const bf16x8*)(ap + 32 * j); bfr[j] = *(const bf16x8*)(bp + 32 * j); }
#pragma unroll 1
        for (int k0 = 0; k0 < DMIX; k0 += 512) {
#pragma unroll
            for (int j = 0; j < 8; ++j) { an[j] = *(const bf16x8*)(ap + k0 + 256 + 32 * j); bn[j] = *(const bf16x8*)(bp + k0 + 256 + 32 * j); }
#pragma unroll
            for (int j = 0; j < 8; ++j) acc = __builtin_amdgcn_mfma_f32_16x16x32_bf16(af[j], bfr[j], acc, 0, 0, 0);
            const int kn = (k0 + 512 < DMIX) ? k0 + 512 : k0;
#pragma unroll
            for (int j = 0; j < 8; ++j) { af[j] = *(const bf16x8*)(ap + kn + 32 * j); bfr[j] = *(const bf16x8*)(bp + kn + 32 * j); }
#pragma unroll
            for (int j = 0; j < 8; ++j) acc = __builtin_amdgcn_mfma_f32_16x16x32_bf16(an[j], bn[j], acc, 0, 0, 0);
        }
        const int col = 16 * nt + r;
#pragma unroll
        for (int i = 0; i < 4; ++i) { const int row = 16 * mt + 4 * kq + i;
            const float g = MOD[(size_t)(BP + (row >> 2)) * 3072 + 2048 + col];
            const float v = a.x_s[(size_t)row * DM + col] + g * acc[i];
            if (cnt_s) store_wt_f32(a.out + O_Y + (size_t)(MP + row) * DM + col, v); else a.out[O_Y + (size_t)(MP + row) * DM + col] = v; }
        if (cnt_s) { asm volatile("s_waitcnt vmcnt(0)" ::: "memory"); if (lane == 0) (void)xb_add(cnt_s + 64 * mt, 1u); }
    }
}
__device__ __forceinline__ void rms_row_inplace(const Args& a, size_t r, int lane) {
    float* yr = a.out + O_Y + r * DM;
    f32x4 v[4]; float s = 0.f;
#pragma unroll
    for (int j = 0; j < 4; ++j) { v[j] = *(const f32x4*)(yr + 4 * lane + 256 * j); s += (v[j].x * v[j].x + v[j].y * v[j].y) + (v[j].z * v[j].z + v[j].w * v[j].w); }
    const float rinv = 1.0f / sqrtf(wave_sum(s) * (1.f / DM) + EPS);
#pragma unroll
    for (int j = 0; j < 4; ++j) { const f32x4 g = *(const f32x4*)(a.final_g + 4 * lane + 256 * j); *(f32x4*)(yr + 4 * lane + 256 * j) = v[j] * rinv * g; }
}

__device__ __forceinline__ void phase5(const Args& a, int vcu, int G, int wave, int lane) {
    const int gw = vcu * NWAVES + wave, NGW = G * NWAVES;
    f32x4 nx[4];
    if (gw < MT) {
#pragma unroll
        for (int j = 0; j < 4; ++j) nx[j] = *(const f32x4*)(a.out + O_Y + (size_t)gw * DM + 4 * lane + 256 * j);
    }
    f32x4 g[4];
#pragma unroll
    for (int j = 0; j < 4; ++j) g[j] = *(const f32x4*)(a.final_g + 4 * lane + 256 * j);
    for (int r = gw; r < MT; r += NGW) {
        float* yr = a.out + O_Y + (size_t)r * DM;
        f32x4 v[4]; float s = 0.f;
#pragma unroll
        for (int j = 0; j < 4; ++j) { v[j] = nx[j]; s += (v[j].x * v[j].x + v[j].y * v[j].y) + (v[j].z * v[j].z + v[j].w * v[j].w); }
        if (r + NGW < MT) {
#pragma unroll
            for (int j = 0; j < 4; ++j) nx[j] = *(const f32x4*)(yr + (size_t)NGW * DM + 4 * lane + 256 * j);
        }
        const float rinv = 1.0f / sqrtf(wave_sum(s) * (1.f / DM) + EPS);
#pragma unroll
        for (int j = 0; j < 4; ++j) *(f32x4*)(yr + 4 * lane + 256 * j) = v[j] * rinv * g[j];
    }
}

__global__ void __launch_bounds__(NTHR, 2) mk_fwd(Args a) {
    extern __shared__ __attribute__((aligned(16))) unsigned char lds_raw[];
    LAS unsigned char* lds = (LAS unsigned char*)lds_raw;
    volatile LAS unsigned* MISC = (volatile LAS unsigned*)(lds + MISC_OFF);
    int tid = threadIdx.x, lane = tid & 63, wave = __builtin_amdgcn_readfirstlane(tid >> 6);
#define RELAUNDER() do { asm volatile("" : "+v"(tid)); lane = tid & 63; wave = __builtin_amdgcn_readfirstlane(tid >> 6); } while (0)
    const int G = gridDim.x; const int bx = blockIdx.x; const int vcu = (G % 8 == 0) ? (bx % 8) * (G / 8) + bx / 8 : bx;
    for (int u = tid; u < (LDS_BYTES - MISC_OFF) / 4; u += NTHR) ((LAS unsigned*)(lds + MISC_OFF))[u] = 0u;
    __syncthreads();
    XcdBarrier bar = xcd_barrier_post((unsigned*)(a.ws + WS_CTL) + CW_BAR, MISC + 8);

    phase0(a, lds, vcu, G, tid, wave, lane);
    xcd_barrier(bar); RELAUNDER();
    phase1(a, lds, vcu, G, tid, wave, lane);
    xcd_barrier(bar); RELAUNDER();
    {
        pg8::Gemm g{(const bf16_t*)(a.ws + WS_XN), (const bf16_t*)(a.ws + WS_WIN), MT, NPROJ, DM};
        pg8::StaticOrder S; S.init(MT, NPROJ, G, bx);
        EpiProj E{(bf16_t*)(a.ws + WS_PROJ), (float*)(a.ws + WS_LOGF), (float*)(a.ws + WS_LOGFS), a.b_in, a.lb_logits};
        pg8::gemm_phase<EpiProj, pg8::StaticOrder, true, true>(lds, g, S, E);
    }
    xcd_barrier(bar); RELAUNDER();
    for (int t = vcu; t < 3072; t += G) {
        RELAUNDER();
        const int tn = -1;
        if (t < 1024) p3a_mlstm(a, lds, t >> 7, (t >> 2) & 31, t & 3, tid, wave, lane, tn);
        else { const int u = t - 1024; p3a_hgrn(a, lds, u >> 8, (u >> 3) & 31, u & 7, tid, wave, lane, tn); }
    }
    xcd_barrier(bar); RELAUNDER();
    const int rid = bx;
    if (rid < 96) p3b_mlstm<0>(a, lds, rid / 12, (rid / 3) & 3, rid % 3, tid, wave, lane);
    else if (rid < 192) { const int u = rid - 96; p3b_hgrn<0>(a, lds, u / 12, (u / 3) & 3, u % 3, tid, wave, lane);
        RELAUNDER(); { const int t = 128 + u; p3b_sample_mlstm(a, lds, t >> 2, t & 3, tid, wave, lane); } }
    else {
        for (int k = 0; k < 2; ++k) { RELAUNDER(); const int t = (rid - 192) * 2 + k; p3b_sample_mlstm(a, lds, t >> 2, t & 3, tid, wave, lane); }
    }
    xcd_barrier(bar); RELAUNDER();
    if (rid < 128) p3b_mlstm<1>(a, lds, rid >> 4, (rid >> 2) & 3, rid & 3, tid, wave, lane);
    else { const int u = rid - 128; p3b_hgrn<1>(a, lds, u >> 4, (u >> 2) & 3, u & 3, tid, wave, lane); }
    for (;;) {
        RELAUNDER();
        __syncthreads();
        if (tid == 0) MISC[16] = 224u + __hip_atomic_fetch_add((unsigned*)(a.ws + WS_CTL) + CW_QUEUE, 1u, __ATOMIC_RELAXED, __HIP_MEMORY_SCOPE_AGENT);
        __syncthreads();
        const int t = (int)MISC[16];
        if (t >= 768) break;
        if (t < 512) p3b_sample_mlstm(a, lds, t >> 2, t & 3, tid, wave, lane);
        else { const int u = t - 512; p3b_sample_hgrn4(a, lds, u >> 1, u & 1, tid, wave, lane); }
    }
    xcd_barrier(bar); RELAUNDER();
    {
        pg8::Gemm g{(const bf16_t*)(a.ws + WS_MIX), (const bf16_t*)(a.ws + WS_WOUT), MP, DM, DMIX};
        pg8::StaticOrder S; S.init(MP, DM, G, bx);
        unsigned* ctl = (unsigned*)(a.ws + WS_CTL);
        if (G == 256) {
            EpiOutFused E{a.out + O_Y, a.x_p, (const float*)(a.ws + WS_MOD), a.final_g, (float*)(a.ws + WS_STATS), ctl + CW_PANEL};
            pg8::gemm_phase<EpiOutFused, pg8::StaticOrder, true, true>(lds, g, S, E);
            small_gemm_out(a, vcu, G, wave, lane, ctl + CW_SROW);
            { const int t = vcu * NWAVES + wave;
              if ((t & 3) == 0) { unsigned* cs = ctl + CW_SROW + 64 * (t >> 6); unsigned sp = 0;
                  while (xb_ld(cs) < 64u) { __builtin_amdgcn_s_sleep(1); if (++sp > (1u << 20)) break; }
                  __builtin_amdgcn_fence(__ATOMIC_ACQUIRE, "agent"); asm volatile("s_waitcnt vmcnt(0)" ::: "memory");
                  rms_row_inplace(a, (size_t)MP + (t >> 2), lane); } }
        } else {
            EpiOut E{a.out + O_Y, a.x_p, a.x_s, (const float*)(a.ws + WS_MOD)};
            pg8::gemm_phase<EpiOut, pg8::StaticOrder, true, true>(lds, g, S, E);
            small_gemm_out(a, vcu, G, wave, lane, nullptr);
            xcd_barrier(bar); RELAUNDER();
            phase5(a, vcu, G, wave, lane);
        }
    }
}

extern "C" void kernel_launch(void* const* d_in, const int* in_sizes, int n_in, void* d_out, int out_size, void* d_ws, size_t ws_size, hipStream_t stream) {
    static int grid = 0;
    if (grid == 0) {
        if (n_in != 25 || (size_t)out_size != O_END || ws_size < WS_END2) { fprintf(stderr, "kernel_launch: unexpected shapes: n_in %d out %d (want %zu) ws %zu (want %zu)\n", n_in, out_size, (size_t)O_END, ws_size, (size_t)WS_END); grid = -1; return; }
        int dev = 0, cus = 0, per_cu = 0;
        if (hipGetDevice(&dev) != hipSuccess || hipDeviceGetAttribute(&cus, hipDeviceAttributeMultiprocessorCount, dev) != hipSuccess) { grid = -1; return; }
        if (hipFuncSetAttribute((const void*)mk_fwd, hipFuncAttributeMaxDynamicSharedMemorySize, LDS_BYTES) != hipSuccess) { fprintf(stderr, "hipFuncSetAttribute failed\n"); grid = -1; return; }
        if (hipOccupancyMaxActiveBlocksPerMultiprocessor(&per_cu, (const void*)mk_fwd, NTHR, LDS_BYTES) != hipSuccess || per_cu < 1) { fprintf(stderr, "occupancy query: %d\n", per_cu); grid = -1; return; }
        (void)hipGetLastError();
        grid = cus;
    }
    if (grid < 0) return;
    (void)hipMemsetAsync((char*)d_ws + WS_CTL, 0, CTL_ZERO_BYTES, stream);
    Args a{};
    const float** ap = (const float**)&a;
    for (int i = 0; i < 25; ++i) ap[i] = (const float*)d_in[i];
    a.out = (float*)d_out; a.ws = (unsigned char*)d_ws;
    void* args[] = {&a};
    hipError_t e = hipLaunchCooperativeKernel((const void*)mk_fwd, dim3(grid), dim3(NTHR), args, LDS_BYTES, stream);
    if (e != hipSuccess) fprintf(stderr, "cooperative launch failed: %s (grid %d)\n", hipGetErrorString(e), grid);
}
```

```cpp
#include <hip/hip_runtime.h>
#include <cstdio>
#include <cstdint>

#define LAS __attribute__((address_space(3)))
typedef unsigned short bf16_t;
typedef short bf16x8 __attribute__((ext_vector_type(8)));
typedef short s16x4 __attribute__((ext_vector_type(4)));
typedef float f32x4 __attribute__((ext_vector_type(4)));
typedef float f32x16 __attribute__((ext_vector_type(16)));
typedef unsigned u32x4 __attribute__((ext_vector_type(4)));
typedef unsigned u32x2 __attribute__((ext_vector_type(2)));

namespace pg8 {
constexpr int BM = 256, BK = 64, HALF = 128, HTB = HALF * BK * 2, STAGE_BYTES = 8 * HTB, NXCD = 8, WGM = 8;
__host__ __device__ __forceinline__ int lds_byte(int r, int c) { const int st = (r >> 4) * 2 + (c >> 5), rr = r & 15, cc = c & 31, ob = rr * 64 + cc * 2; return st * 1024 + (ob ^ (((ob >> 9) & 1) << 5)); }
__host__ __device__ __forceinline__ void stage_rc(int b, int& R, int& C) { const int st = b / 1024, sb = b % 1024, swz = sb ^ (((sb >> 9) & 1) << 5); R = (st >> 1) * 16 + swz / 64; C = (st & 1) * 32 + (swz % 64) / 2; }
__host__ __device__ __forceinline__ int perm32(int rho) { const int n = rho >> 4, i = rho & 15; return 8 * (i >> 2) + 4 * n + (i & 3); }
struct Unit { int pm, pn; };
struct Gemm { const bf16_t* A; const bf16_t* Bt; int M, N, K; };
struct StaticOrder {
    int nM, nN, nwg, G, c;
    __host__ __device__ void init(int M, int N, int G_, int c_) { nM = M / BM; nN = N / BM; nwg = nM * nN; G = G_; c = c_; }
    __host__ __device__ bool next(int i, Unit& u) const {
        const long L = (long)i * G + c; if (L >= nwg) return false;
        int wgid = (int)L; { const int q = nwg / NXCD, r = nwg % NXCD, xcd = wgid % NXCD, off = wgid / NXCD; wgid = (xcd < r ? xcd * (q + 1) : r * (q + 1) + (xcd - r) * q) + off; }
        const int nig = WGM * nN, gid = wgid / nig, fm = gid * WGM, gsz = (nM - fm) < WGM ? (nM - fm) : WGM;
        u.pm = fm + ((wgid % nig) % gsz); u.pn = (wgid % nig) / gsz; return true;
    }
};
template <class Epi, class Sched, bool ALIGN_EPI = false, bool SP2 = false>
__device__ __forceinline__ void gemm_phase(LAS unsigned char* lds, const Gemm g, const Sched& S, const Epi& E) {
    const int tid = threadIdx.x, wid = __builtin_amdgcn_readfirstlane(tid >> 6), lane = tid & 63, wr = wid >> 2, wc = wid & 3, fr = lane & 15, fq = lane >> 4;
    const int K = g.K, nt = K / BK;
    unsigned voffA[2], voffB[2];
#pragma unroll
    for (int i = 0; i < 2; ++i) { int R, C; stage_rc(tid * 16 + i * 8192, R, C); const int Rb = Epi::PERM ? ((R & ~31) + perm32(R & 31)) : R;
        voffA[i] = (unsigned)(R * K + C) * 2u; voffB[i] = (unsigned)(Rb * K + C) * 2u; }
    const size_t kstep = (size_t)(BK * 2);
    const size_t hstep = (size_t)HALF * K * 2;
    const size_t tstep = 2 * hstep;
    const unsigned ldsw = (unsigned)wid * 1024u;
    const int aoff = lds_byte(wr * 64 + fr, fq * 8), boff = lds_byte(wc * 32 + fr, fq * 8);
#define PG8_SA(b, h) (((b) * 2 + (h)) * HTB)
#define PG8_SB(b, h) ((4 + (b) * 2 + (h)) * HTB)
#define PG8_STAGE(bufoff, gbase, voff) do { _Pragma("unroll") for (int _i = 0; _i < 2; ++_i) \
        __builtin_amdgcn_global_load_lds((const unsigned*)((const char*)(gbase) + (voff)[_i]), (LAS unsigned*)(lds + (bufoff) + ldsw + _i * 8192), 16, 0, 0); } while (0)
#define PG8_LDA(dst, b, h) do { _Pragma("unroll") for (int m = 0; m < 4; ++m) _Pragma("unroll") for (int k = 0; k < 2; ++k) dst[m][k] = *(const LAS bf16x8*)(lds + PG8_SA(b, h) + aoff + m * 2048 + k * 1024); } while (0)
#define PG8_LDB(dst, b, h) do { _Pragma("unroll") for (int n = 0; n < 2; ++n) _Pragma("unroll") for (int k = 0; k < 2; ++k) dst[n][k] = *(const LAS bf16x8*)(lds + PG8_SB(b, h) + boff + n * 2048 + k * 1024); } while (0)
#define PG8_MMA(ai, bj, At, Bt) do { __builtin_amdgcn_s_setprio(1); _Pragma("unroll") for (int m = 0; m < 4; ++m) _Pragma("unroll") for (int n = 0; n < 2; ++n) _Pragma("unroll") for (int k = 0; k < 2; ++k) \
        acc[ai][bj][m][n] = __builtin_amdgcn_mfma_f32_16x16x32_bf16(Bt[n][k], At[m][k], acc[ai][bj][m][n], 0, 0, 0); __builtin_amdgcn_s_setprio(0); } while (0)
#define PG8_WAIT_V(n) asm volatile("s_waitcnt vmcnt(" #n ")" ::: "memory")
#define PG8_WAIT_L(n) asm volatile("s_waitcnt lgkmcnt(" #n ")" ::: "memory")
#define PG8_BAR __builtin_amdgcn_s_barrier()
#define PG8_SCHED __builtin_amdgcn_sched_barrier(0)
    Unit cur, nxt; int ui = 0;
    if (!S.next(0, cur)) return;
    f32x4 acc[2][2][4][2];
#pragma unroll
    for (int a = 0; a < 2; ++a)
#pragma unroll
        for (int b = 0; b < 2; ++b)
#pragma unroll
            for (int m = 0; m < 4; ++m)
#pragma unroll
                for (int n = 0; n < 2; ++n) acc[a][b][m][n] = (f32x4){0.f, 0.f, 0.f, 0.f};
    bf16x8 At[4][2], B0[2][2], B1[2][2];
    const char* cA = (const char*)g.A + (size_t)cur.pm * tstep; const char* cB = (const char*)g.Bt + (size_t)cur.pn * tstep;
    if constexpr (SP2) {
        PG8_STAGE(PG8_SB(0, 0), cB, voffB); PG8_STAGE(PG8_SB(0, 1), cB + hstep, voffB); PG8_STAGE(PG8_SA(0, 0), cA, voffA); PG8_STAGE(PG8_SA(0, 1), cA + hstep, voffA);
        if (wr == 1) PG8_BAR;
        PG8_WAIT_V(2); PG8_BAR;
        PG8_STAGE(PG8_SB(1, 0), cB + kstep, voffB); PG8_STAGE(PG8_SA(1, 0), cA + kstep, voffA); PG8_STAGE(PG8_SB(1, 1), cB + hstep + kstep, voffB);
        PG8_WAIT_V(6); PG8_BAR;
    } else {
        PG8_STAGE(PG8_SB(0, 0), cB, voffB); PG8_STAGE(PG8_SA(0, 0), cA, voffA); PG8_STAGE(PG8_SB(0, 1), cB + hstep, voffB); PG8_STAGE(PG8_SA(0, 1), cA + hstep, voffA);
        if (wr == 1) PG8_BAR;
        PG8_WAIT_V(4); PG8_BAR;
        PG8_STAGE(PG8_SB(1, 0), cB + kstep, voffB); PG8_STAGE(PG8_SA(1, 0), cA + kstep, voffA); PG8_STAGE(PG8_SB(1, 1), cB + hstep + kstep, voffB);
        PG8_WAIT_V(6); PG8_BAR;
    }
    for (;;) {
        const bool has_next = S.next(ui + 1, nxt);
        const char* nA = has_next ? (const char*)g.A + (size_t)nxt.pm * tstep : cA; const char* nB = has_next ? (const char*)g.Bt + (size_t)nxt.pn * tstep : cB;
        for (int t = 0; t < nt; t += 2) {
            const bool last = (t == nt - 2);
            const char* a1 = cA + (size_t)(t + 1) * kstep;
            const char* a2 = last ? nA : cA + (size_t)(t + 2) * kstep; const char* b2 = last ? nB : cB + (size_t)(t + 2) * kstep;
            const char* a3 = a2 + kstep; const char* b3 = b2 + kstep;
            if constexpr (SP2) {
            PG8_LDB(B0, 0, 0); PG8_LDB(B1, 0, 1); PG8_SCHED; PG8_LDA(At, 0, 0); PG8_STAGE(PG8_SA(1, 1), a1 + hstep, voffA);
            PG8_WAIT_V(8); PG8_WAIT_L(0); PG8_BAR; PG8_MMA(0, 0, At, B0); PG8_MMA(0, 1, At, B1); PG8_BAR; PG8_SCHED;
            PG8_LDA(At, 0, 1); PG8_STAGE(PG8_SB(0, 0), b2, voffB); PG8_STAGE(PG8_SB(0, 1), b2 + hstep, voffB); PG8_STAGE(PG8_SA(0, 0), a2, voffA);
            PG8_WAIT_V(8); PG8_WAIT_L(0); PG8_BAR; PG8_MMA(1, 0, At, B0); PG8_MMA(1, 1, At, B1); PG8_BAR; PG8_SCHED;
            PG8_LDB(B0, 1, 0); PG8_LDB(B1, 1, 1); PG8_SCHED; PG8_LDA(At, 1, 0); PG8_STAGE(PG8_SA(0, 1), a2 + hstep, voffA);
            PG8_WAIT_V(8); PG8_WAIT_L(0); PG8_BAR; PG8_MMA(0, 0, At, B0); PG8_MMA(0, 1, At, B1); PG8_BAR; PG8_SCHED;
            PG8_LDA(At, 1, 1); PG8_STAGE(PG8_SB(1, 0), b3, voffB); PG8_STAGE(PG8_SB(1, 1), b3 + hstep, voffB); PG8_STAGE(PG8_SA(1, 0), a3, voffA);
            PG8_WAIT_V(8); PG8_WAIT_L(0); PG8_BAR; PG8_MMA(1, 0, At, B0); PG8_MMA(1, 1, At, B1); PG8_BAR; PG8_SCHED;
            } else {
            PG8_LDB(B0, 0, 0); PG8_SCHED; PG8_LDA(At, 0, 0); PG8_STAGE(PG8_SA(1, 1), a1 + hstep, voffA);
            PG8_WAIT_L(8); PG8_BAR; PG8_WAIT_L(0); PG8_MMA(0, 0, At, B0); PG8_BAR; PG8_SCHED;
            PG8_LDB(B1, 0, 1); PG8_STAGE(PG8_SB(0, 0), b2, voffB);
            PG8_BAR; PG8_WAIT_L(0); PG8_MMA(0, 1, At, B1); PG8_BAR;
            PG8_LDA(At, 0, 1); PG8_STAGE(PG8_SA(0, 0), a2, voffA);
            PG8_BAR; PG8_WAIT_L(0); PG8_MMA(1, 0, At, B0); PG8_BAR; PG8_SCHED;
            PG8_STAGE(PG8_SB(0, 1), b2 + hstep, voffB);
            PG8_WAIT_V(6); PG8_BAR; PG8_MMA(1, 1, At, B1); PG8_BAR;
            PG8_LDB(B0, 1, 0); PG8_SCHED; PG8_LDA(At, 1, 0); PG8_STAGE(PG8_SA(0, 1), a2 + hstep, voffA);
            PG8_WAIT_L(8); PG8_BAR; PG8_WAIT_L(0); PG8_MMA(0, 0, At, B0); PG8_BAR; PG8_SCHED;
            PG8_LDB(B1, 1, 1); PG8_STAGE(PG8_SB(1, 0), b3, voffB);
            PG8_BAR; PG8_WAIT_L(0); PG8_MMA(0, 1, At, B1); PG8_BAR;
            PG8_LDA(At, 1, 1); PG8_STAGE(PG8_SA(1, 0), a3, voffA);
            PG8_BAR; PG8_WAIT_L(0); PG8_MMA(1, 0, At, B0); PG8_BAR; PG8_SCHED;
            PG8_STAGE(PG8_SB(1, 1), b3 + hstep, voffB);
            PG8_WAIT_V(6); PG8_BAR; PG8_MMA(1, 1, At, B1); PG8_BAR;
            }
        }
        if constexpr (ALIGN_EPI) { if (wr == 0) PG8_BAR; }
        if constexpr (!Epi::AFTER_DRAIN) E(acc, cur, wr, wc, fr, fq);
        if (!has_next) break;
#pragma unroll
        for (int a = 0; a < 2; ++a)
#pragma unroll
            for (int b = 0; b < 2; ++b)
#pragma unroll
                for (int m = 0; m < 4; ++m)
#pragma unroll
                    for (int n = 0; n < 2; ++n) acc[a][b][m][n] = (f32x4){0.f, 0.f, 0.f, 0.f};
        cur = nxt; cA = nA; cB = nB; ++ui;
        if constexpr (ALIGN_EPI) { if (wr == 1) PG8_BAR; }
    }
    PG8_WAIT_V(0);
    if constexpr (!ALIGN_EPI) { if (wr == 0) PG8_BAR; }
    PG8_BAR;
    if constexpr (Epi::AFTER_DRAIN) E.fused(acc, cur, wr, wc, fr, fq, lds, wid, lane);
#undef PG8_SA
#undef PG8_SB
#undef PG8_STAGE
#undef PG8_LDA
#undef PG8_LDB
#undef PG8_MMA
#undef PG8_WAIT_V
#undef PG8_WAIT_L
#undef PG8_BAR
#undef PG8_SCHED
}
}

constexpr int NWAVES = 8, NTHR = 512;
constexpr int DM = 1024;
constexpr int BP = 8, TP = 2048, MP = BP * TP;
constexpr int BS = 128, TS = 4, MS = BS * TS;
constexpr int MT = MP + MS;
constexpr int NMOD = BP + BS;
constexpr int WIN_LD = 7176, NPROJ = 7168, DMIX = 2048;
constexpr int NCH = TP / 64;
constexpr float EPS = 1e-6f;

constexpr size_t SEGSZ = (size_t)MP * 1024;
constexpr size_t PS_OFF = 7 * SEGSZ;
__device__ __forceinline__ size_t hg_tile(int seg, int b, int c, int head) { return (size_t)seg * SEGSZ + ((size_t)((b * NCH + c) * 8 + head) << 13); }
__device__ __forceinline__ size_t ml_tile(int seg, int b, int c, int h) { return (size_t)seg * SEGSZ + ((size_t)((b * NCH + c) * 4 + h) << 14); }
constexpr size_t MiB = 1u << 20;
constexpr size_t WS_CTL = 0, CTL_ZERO_BYTES = 64 * 1024;
constexpr size_t WS_WIN = 2 * MiB;
constexpr size_t WS_WOUT = 16 * MiB;
constexpr size_t WS_MOD = 20 * MiB;
constexpr size_t WS_GATE = 22 * MiB;
constexpr size_t WS_DEC = 23 * MiB;
constexpr size_t WS_BT = 24 * MiB;
constexpr size_t WS_RS = 24 * MiB + 512 * 1024;
constexpr size_t WS_CSK = 25 * MiB;
constexpr size_t WS_RL = 26 * MiB;
constexpr size_t WS_GW = 26 * MiB + 64 * 1024;
constexpr size_t WS_LOGFS = 26 * MiB + 512 * 1024;
constexpr size_t WS_AH = 30 * MiB;
constexpr size_t WS_AM = 46 * MiB;
constexpr size_t WS_XN = 54 * MiB;
constexpr size_t WS_QM = WS_XN;
constexpr size_t WS_PROJ = 88 * MiB;
constexpr size_t WS_LOGF = 320 * MiB;
constexpr size_t WS_MIX = WS_LOGF;
constexpr size_t WS_KM = 388 * MiB, WS_VM = 420 * MiB, WS_XC = 452 * MiB;
constexpr size_t WS_END = 484 * MiB;
constexpr size_t O_Y = 0;
constexpr size_t O_HP = (size_t)MT * DM;
constexpr size_t O_CP = O_HP + (size_t)BP * 8 * 128 * 128;
constexpr size_t O_NP = O_CP + (size_t)BP * 4 * 256 * 256;
constexpr size_t O_MP = O_NP + (size_t)BP * 4 * 256;
constexpr size_t O_VP = O_MP + (size_t)BP * 4;
constexpr size_t O_HS = O_VP + (size_t)BP * 3 * 1024;
constexpr size_t O_CS = O_HS + (size_t)BS * 8 * 128 * 128;
constexpr size_t O_NS = O_CS + (size_t)BS * 4 * 256 * 256;
constexpr size_t O_MS = O_NS + (size_t)BS * 4 * 256;
constexpr size_t O_VS = O_MS + (size_t)BS * 4;
constexpr size_t O_END = O_VS + (size_t)BS * 3 * 1024;

constexpr int RING_BYTES = 131072, LDS_BYTES = 147456, MISC_OFF = LDS_BYTES - 1024;
constexpr int CW_BAR = 4096, CW_QUEUE = 2048, CW_PANEL = 8192, CW_SROW = 12288;

#define LDS_WAIT() asm volatile("s_waitcnt lgkmcnt(0)" ::: "memory")
__device__ __forceinline__ float bf2f(unsigned u16) { return __uint_as_float(u16 << 16); }
__device__ __forceinline__ float bflo(unsigned w) { return __uint_as_float(w << 16); }
__device__ __forceinline__ float bfhi(unsigned w) { return __uint_as_float(w & 0xffff0000u); }
typedef __bf16 bf16v2_t __attribute__((ext_vector_type(2)));
__device__ __forceinline__ unsigned pk2(float lo, float hi) { bf16v2_t v; v[0] = (__bf16)lo; v[1] = (__bf16)hi; return __builtin_bit_cast(unsigned, v); }
__device__ __forceinline__ bf16_t f2bf(float f) { return __builtin_bit_cast(bf16_t, (__bf16)f); }
__device__ __forceinline__ float wave_sum(float v) {
#pragma unroll
    for (int o = 1; o < 64; o <<= 1) v += __shfl_xor(v, o);
    return v;
}
__device__ __forceinline__ float sigmoidf_(float x) { return __builtin_amdgcn_rcpf(1.f + __expf(-x)); }

#define XB_TMO      128
#define XB_XCNT(j)  (256  + 64 * (j))
#define XB_XSUB(j)  (1280 + 64 * (j))
#define XB_XGEN(j)  (2304 + 64 * (j))
#define XB_TOP      3328
#define XB_TOPGEN   3392
#define XCD_BAR_WORDS 3456
#define XB_SPIN_CAP (1u << 18)
__device__ __forceinline__ unsigned xb_ld(unsigned* p)              { return __hip_atomic_load(p, __ATOMIC_RELAXED, __HIP_MEMORY_SCOPE_AGENT); }
__device__ __forceinline__ unsigned xb_add(unsigned* p, unsigned v) { return __hip_atomic_fetch_add(p, v, __ATOMIC_RELAXED, __HIP_MEMORY_SCOPE_AGENT); }
__device__ __forceinline__ unsigned xb_xcc_id() { return (unsigned)__builtin_amdgcn_s_getreg((3 << 11) | 20) & 0xFu; }
#define XB_SPIN(cond, bar) do { unsigned _sp = 0; while (cond) { __builtin_amdgcn_s_sleep(1); \
    if ((++_sp & 255u) == 0u) { if (xb_ld(&(bar)[XB_TMO])) break; if (_sp > XB_SPIN_CAP) { atomicAdd(&(bar)[XB_TMO], 1u); break; } } } } while (0)
struct XcdBarrier { unsigned* bar; unsigned x; volatile LAS unsigned* st; };
__device__ __forceinline__ XcdBarrier xcd_barrier_post(unsigned* bar, volatile LAS unsigned* st) {
    XcdBarrier b; b.bar = bar; b.x = xb_xcc_id(); b.st = st;
    if (threadIdx.x == 0) (void)xb_add(&bar[XB_XCNT(b.x)], 1u);
    return b;
}
__device__ __forceinline__ void xcd_barrier_complete(unsigned* bar, unsigned x, unsigned& nloc, unsigned& nx) {
    const unsigned G = gridDim.x * gridDim.y * gridDim.z;
    unsigned sum, cnt, mine, sp = 0u;
    for (;;) {
        sum = 0u; cnt = 0u; mine = 0u;
#pragma unroll
        for (unsigned j = 0; j < 16; ++j) { const unsigned c = xb_ld(&bar[XB_XCNT(j)]); sum += c; cnt += (c > 0u) ? 1u : 0u; mine = (j == x) ? c : mine; }
        if (sum == G) break;
        __builtin_amdgcn_s_sleep(1);
        if ((++sp & 255u) == 0u) { if (xb_ld(&bar[XB_TMO])) break; if (sp > XB_SPIN_CAP) { atomicAdd(&bar[XB_TMO], 1u); break; } }
    }
    nloc = mine > 0u ? mine : 1u; nx = cnt > 0u ? cnt : 1u;
}
__device__ __forceinline__ void xcd_barrier(const XcdBarrier& b) {
    asm volatile("s_waitcnt vmcnt(0)" ::: "memory");
    __syncthreads();
    if (threadIdx.x == 0) {
        unsigned* bar = b.bar;
        __builtin_amdgcn_s_waitcnt(0);
        unsigned nloc = b.st[0], nx = b.st[1];
        if (nloc == 0u) { xcd_barrier_complete(bar, b.x, nloc, nx); b.st[0] = nloc; b.st[1] = nx; }
        const unsigned old = xb_add(&bar[XB_XSUB(b.x)], 1u);
        const unsigned gen = old / nloc;
        if (old + 1u == (gen + 1u) * nloc) {
            __builtin_amdgcn_fence(__ATOMIC_RELEASE, "agent");
            asm volatile("s_waitcnt vmcnt(0)" ::: "memory");
            const unsigned og = xb_add(&bar[XB_TOP], 1u);
            const unsigned tg = og / nx;
            if (og + 1u == (tg + 1u) * nx) xb_add(&bar[XB_TOPGEN], 1u);
            else XB_SPIN(xb_ld(&bar[XB_TOPGEN]) == tg, bar);
            __builtin_amdgcn_fence(__ATOMIC_ACQUIRE, "agent");
            xb_add(&bar[XB_XGEN(b.x)], 1u);
            asm volatile("s_waitcnt vmcnt(0)" ::: "memory");
        } else {
            XB_SPIN(xb_ld(&bar[XB_XGEN(b.x)]) == gen, bar);
            __builtin_amdgcn_fence(__ATOMIC_ACQUIRE, "agent");
            asm volatile("s_waitcnt vmcnt(0)" ::: "memory");
        }
    }
    __syncthreads();
}

struct Args {
    const float *x_p, *x_s, *c_p, *c_s, *st_h, *st_C, *st_n, *st_m, *st_conv, *w_ada, *b_ada, *norm_g, *w_in, *b_in, *lb_logits, *hnorm_g,
                *conv_w, *conv_b, *wq, *wk, *wv, *mnorm_g, *skip, *w_out, *final_g;
    float* out; unsigned char* ws;
};

__device__ __forceinline__ void transposes(const Args& a, LAS unsigned char* lds, int vcu, int G, int tid, int wave, int lane);
__device__ __forceinline__ void phase1(const Args& a, LAS unsigned char* lds, int vcu, int G, int tid, int wave, int lane) {
    LAS float* sg = (LAS float*)lds;
    { const float* GW = (const float*)(a.ws + WS_GW); f32x4 tv[4];
#pragma unroll
      for (int i = 0; i < 4; ++i) tv[i] = *(const f32x4*)(GW + 4 * (tid + NTHR * i));
#pragma unroll
      for (int i = 0; i < 4; ++i) *(LAS f32x4*)(sg + 4 * (tid + NTHR * i)) = tv[i]; }
    __syncthreads();
    const float* MOD = (const float*)(a.ws + WS_MOD);
    bf16_t* XN = (bf16_t*)(a.ws + WS_XN); float* GATE = (float*)(a.ws + WS_GATE);
    const int gw = vcu * NWAVES + wave, NGW = G * NWAVES;
    f32x4 nx[4];
    if (gw < MT) { const float* xr = gw < MP ? a.x_p + (size_t)gw * DM : a.x_s + (size_t)(gw - MP) * DM;
#pragma unroll
        for (int j = 0; j < 4; ++j) nx[j] = *(const f32x4*)(xr + 4 * lane + 256 * j); }
    for (int r = gw; r < MT; r += NGW) {
        const int mb = r < MP ? (r >> 11) : BP + ((r - MP) >> 2);
        const float* shift = MOD + (size_t)mb * 3072; const float* scale = shift + 1024;
        f32x4 v[4]; float s = 0.f;
#pragma unroll
        for (int j = 0; j < 4; ++j) { v[j] = nx[j]; s += (v[j].x * v[j].x + v[j].y * v[j].y) + (v[j].z * v[j].z + v[j].w * v[j].w); }
        if (r + NGW < MT) { const int rn = r + NGW; const float* xr = rn < MP ? a.x_p + (size_t)rn * DM : a.x_s + (size_t)(rn - MP) * DM;
#pragma unroll
            for (int j = 0; j < 4; ++j) nx[j] = *(const f32x4*)(xr + 4 * lane + 256 * j); }
        const float rinv = 1.0f / sqrtf(wave_sum(s) * (1.f / DM) + EPS);
        float gd[8];
#pragma unroll
        for (int gi = 0; gi < 8; ++gi) gd[gi] = 0.f;
#pragma unroll
        for (int j = 0; j < 4; ++j) {
            const int col = 4 * lane + 256 * j;
            const f32x4 g = *(const f32x4*)(a.norm_g + col), sc = *(const f32x4*)(scale + col), sh = *(const f32x4*)(shift + col);
            f32x4 h = v[j] * rinv * g * (sc + 1.0f) + sh;
            u32x2 o; o.x = pk2(h.x, h.y); o.y = pk2(h.z, h.w);
            *(u32x2*)(XN + (size_t)r * DM + col) = o;
#pragma unroll
            for (int gi = 0; gi < 8; ++gi) { const f32x4 w = *(const LAS f32x4*)(sg + gi * 1024 + col); gd[gi] += (h.x * w.x + h.y * w.y) + (h.z * w.z + h.w * w.w); }
        }
#pragma unroll
        for (int gi = 0; gi < 8; ++gi) gd[gi] = wave_sum(gd[gi]);
        if (lane < 8) {
            float val = 0.f;
#pragma unroll
            for (int gi = 0; gi < 8; ++gi) val = (lane == gi) ? gd[gi] : val;
            val += a.b_in[NPROJ + lane];
            if (lane >= 4) val = fminf(val, 0.f) - log1pf(__expf(-fabsf(val)));
            GATE[(size_t)r * 8 + lane] = val;
        }
    }
}

__device__ __forceinline__ void store_wt_f32(float* p, float v) { asm volatile("global_store_dword %0, %1, off sc1\n\ts_nop 1" :: "v"(p), "v"(v) : "memory"); }
struct EpiProj {
    static constexpr bool PERM = true, AFTER_DRAIN = false;
    bf16_t* PROJ; float* LOGF; float* LOGFS; const float* bias; const float* lbl;
    __device__ __forceinline__ void operator()(const f32x4 (&acc)[2][2][4][2], const pg8::Unit& u, int wr, int wc, int fr, int fq) const {
        const int seg = u.pn >> 2;
        const int row0 = u.pm * 256 + wr * 64 + fr, col0 = u.pn * 256 + wc * 32 + 8 * fq, cs0 = col0 & 1023;
        const bool prompt = u.pm < MP / 256;
        unsigned cpart[2];
#pragma unroll
        for (int bj = 0; bj < 2; ++bj) { const int cs = cs0 + bj * 128; cpart[bj] = seg < 4 ? (unsigned)(((cs >> 7) << 13) + (cs & 127)) : (unsigned)(((cs >> 8) << 14) + (cs & 255)); }
        const int tsh = seg < 4 ? 7 : 8;
        f32x4 bv[2][2], lb[2][2];
#pragma unroll
        for (int bj = 0; bj < 2; ++bj)
#pragma unroll
            for (int n = 0; n < 2; ++n) {
                bv[bj][n] = *(const f32x4*)(bias + col0 + bj * 128 + 4 * n);
                if (seg == 1) { const int c = col0 - 1024 + bj * 128 + 4 * n; const f32x4 l0 = *(const f32x4*)(lbl + c), l1 = *(const f32x4*)(lbl + 1024 + c);
                    f32x4 t; t.x = 1.f / (1.f + __expf(l1.x - l0.x)); t.y = 1.f / (1.f + __expf(l1.y - l0.y)); t.z = 1.f / (1.f + __expf(l1.z - l0.z)); t.w = 1.f / (1.f + __expf(l1.w - l0.w)); lb[bj][n] = t; }
                else lb[bj][n] = (f32x4){0.f, 0.f, 0.f, 0.f};
            }
#pragma unroll
        for (int ai = 0; ai < 2; ++ai)
#pragma unroll
            for (int m = 0; m < 4; ++m) {
                const int row = row0 + ai * 128 + m * 16;
                const size_t rpart = prompt ? ((size_t)(row >> 6) << 16) + (size_t)((row & 63) << tsh) : 0;
#pragma unroll
                for (int bj = 0; bj < 2; ++bj) {
                    f32x4 v0 = acc[ai][bj][m][0] + bv[bj][0], v1 = acc[ai][bj][m][1] + bv[bj][1];
                    if (seg == 1) {
                        float* dst = prompt ? LOGF + rpart + cpart[bj] : LOGFS + (size_t)(row - MP) * 1024 + cs0 + bj * 128;
                        f32x4 o0, o1;
#pragma unroll
                        for (int e = 0; e < 4; ++e) { const float l0 = lb[bj][0][e], l1 = lb[bj][1][e];
                            o0[e] = __logf(l0 + (1.f - l0) * sigmoidf_(v0[e])); o1[e] = __logf(l1 + (1.f - l1) * sigmoidf_(v1[e])); }
                        *(f32x4*)dst = o0; *(f32x4*)(dst + 4) = o1;
                    } else {
                        if (seg == 3 || seg == 5) {
#pragma unroll
                            for (int e = 0; e < 4; ++e) { v0[e] = v0[e] * sigmoidf_(v0[e]); v1[e] = v1[e] * sigmoidf_(v1[e]); }
                        } else if (seg == 6) {
#pragma unroll
                            for (int e = 0; e < 4; ++e) { v0[e] = sigmoidf_(v0[e]); v1[e] = sigmoidf_(v1[e]); }
                        }
                        u32x4 w; w.x = pk2(v0[0], v0[1]); w.y = pk2(v0[2], v0[3]); w.z = pk2(v1[0], v1[1]); w.w = pk2(v1[2], v1[3]);
                        bf16_t* dst = prompt ? PROJ + (size_t)seg * SEGSZ + rpart + cpart[bj] : PROJ + PS_OFF + (size_t)(row - MP) * NPROJ + col0 + bj * 128;
                        *(u32x4*)dst = w;
                    }
                }
            }
    }
};
struct EpiOut {
    static constexpr bool PERM = true, AFTER_DRAIN = false;
    float* Y; const float* xp; const float* xs; const float* MOD;
    __device__ __forceinline__ void operator()(const f32x4 (&acc)[2][2][4][2], const pg8::Unit& u, int wr, int wc, int fr, int fq) const {
        const int row0 = u.pm * 256 + wr * 64 + fr, col0 = u.pn * 256 + wc * 32 + 8 * fq;
#pragma unroll
        for (int ai = 0; ai < 2; ++ai)
#pragma unroll
            for (int m = 0; m < 4; ++m) {
                const int row = row0 + ai * 128 + m * 16;
                const float* xr = row < MP ? xp + (size_t)row * DM : xs + (size_t)(row - MP) * DM;
                const int mb = row < MP ? (row >> 11) : BP + ((row - MP) >> 2);
                const float* gate = MOD + (size_t)mb * 3072 + 2048;
#pragma unroll
                for (int bj = 0; bj < 2; ++bj)
#pragma unroll
                    for (int n = 0; n < 2; ++n) {
                        const int col = col0 + bj * 128 + 4 * n;
                        const f32x4 xv = *(const f32x4*)(xr + col), gv = *(const f32x4*)(gate + col);
                        *(f32x4*)(Y + (size_t)row * DM + col) = xv + gv * acc[ai][bj][m][n];
                    }
            }
    }
};

struct EpiOutFused {
    static constexpr bool PERM = true, AFTER_DRAIN = true;
    float* Y; const float* xp; const float* MOD; const float* fg; float* STATS; unsigned* cnt;
    __device__ __forceinline__ void operator()(const f32x4 (&)[2][2][4][2], const pg8::Unit&, int, int, int, int) const {}
    __device__ __forceinline__ void fused(f32x4 (&acc)[2][2][4][2], const pg8::Unit& u, int wr, int wc, int fr, int fq, LAS unsigned char* lds, int wid, int lane) const {
        LAS float* P = (LAS float*)lds;
        LAS float* S = (LAS float*)(lds + 4096);
        const int tid = wid * 64 + lane;
        const int row0 = u.pm * 256 + wr * 64 + fr, col0 = u.pn * 256 + wc * 32 + 8 * fq;
        const float* gate = MOD + (size_t)(u.pm >> 3) * 3072 + 2048;
        f32x4 gv[2][2];
#pragma unroll
        for (int bj = 0; bj < 2; ++bj)
#pragma unroll
            for (int n = 0; n < 2; ++n) gv[bj][n] = *(const f32x4*)(gate + col0 + bj * 128 + 4 * n);
#pragma unroll
        for (int ai = 0; ai < 2; ++ai)
#pragma unroll
            for (int m = 0; m < 4; ++m) {
                const int row = row0 + ai * 128 + m * 16; float sq = 0.f;
#pragma unroll
                for (int bj = 0; bj < 2; ++bj)
#pragma unroll
                    for (int n = 0; n < 2; ++n) { const f32x4 xv = *(const f32x4*)(xp + (size_t)row * DM + col0 + bj * 128 + 4 * n);
                        const f32x4 v = xv + gv[bj][n] * acc[ai][bj][m][n]; acc[ai][bj][m][n] = v; sq += (v.x * v.x + v.y * v.y) + (v.z * v.z + v.w * v.w); }
                sq += __shfl_xor(sq, 16); sq += __shfl_xor(sq, 32);
                if (fq == 0) P[(ai * 128 + wr * 64 + m * 16 + fr) * 4 + wc] = sq;
            }
        __syncthreads();
        if (tid < 256) { const f32x4 p4 = *(const LAS f32x4*)(P + tid * 4);
            __hip_atomic_store(STATS + ((size_t)u.pm * 256 + tid) * 4 + u.pn, (p4.x + p4.y) + (p4.z + p4.w), __ATOMIC_RELAXED, __HIP_MEMORY_SCOPE_AGENT); }
        asm volatile("s_waitcnt vmcnt(0)" ::: "memory");
        __syncthreads();
        if (tid == 0) { (void)xb_add(cnt + 64 * u.pm, 1u);
            unsigned sp = 0; while (xb_ld(cnt + 64 * u.pm) < 4u) { __builtin_amdgcn_s_sleep(1); if (++sp > (1u << 20)) break; } }
        __syncthreads();
        if (tid < 256) { const float* st = STATS + ((size_t)u.pm * 256 + tid) * 4; float t = 0.f;
#pragma unroll
            for (int j = 0; j < 4; ++j) t += __hip_atomic_load(st + j, __ATOMIC_RELAXED, __HIP_MEMORY_SCOPE_AGENT);
            S[tid] = 1.0f / sqrtf(t * (1.f / DM) + EPS); }
        __syncthreads();
        f32x4 fgv[2][2];
#pragma unroll
        for (int bj = 0; bj < 2; ++bj)
#pragma unroll
            for (int n = 0; n < 2; ++n) fgv[bj][n] = *(const f32x4*)(fg + col0 + bj * 128 + 4 * n);
#pragma unroll
        for (int ai = 0; ai < 2; ++ai)
#pragma unroll
            for (int m = 0; m < 4; ++m) {
                const int rl = ai * 128 + wr * 64 + m * 16 + fr; const float ri = S[rl];
#pragma unroll
                for (int bj = 0; bj < 2; ++bj)
#pragma unroll
                    for (int n = 0; n < 2; ++n) *(f32x4*)(Y + (size_t)(u.pm * 256 + rl) * DM + col0 + bj * 128 + 4 * n) = acc[ai][bj][m][n] * ri * fgv[bj][n];
            }
    }
};
#define LDSP(type, off) ((LAS type*)(lds + (off)))
__device__ __forceinline__ unsigned lp_row(int lane, unsigned RS) { return (unsigned)(lane & 31) * RS + 16u * (unsigned)(lane >> 5); }
__device__ __forceinline__ unsigned lp_perm(int lane, unsigned RS) { return (unsigned)(lane & 31) * RS + 8u * (unsigned)(lane >> 5); }
__device__ __forceinline__ unsigned lp_tr(int lane, unsigned RS) { return ((unsigned)(lane >> 5) * 8u + (unsigned)((lane & 15) >> 2)) * RS + (((unsigned)(lane >> 4) & 1u) * 16u + (unsigned)(lane & 3) * 4u) * 2u; }
__device__ __forceinline__ bf16x8 frag_row(LAS unsigned char* lds, unsigned off) { return *LDSP(const bf16x8, off); }
__device__ __forceinline__ bf16x8 frag_perm(LAS unsigned char* lds, unsigned off) {
    const s16x4 lo = *LDSP(const s16x4, off), hi = *LDSP(const s16x4, off + 16);
    bf16x8 r; r[0] = lo[0]; r[1] = lo[1]; r[2] = lo[2]; r[3] = lo[3]; r[4] = hi[0]; r[5] = hi[1]; r[6] = hi[2]; r[7] = hi[3]; return r;
}
template <unsigned RS> __device__ __forceinline__ bf16x8 frag_tr(LAS unsigned char* lds, unsigned off) {
    const s16x4 lo = __builtin_amdgcn_ds_read_tr16_b64_v4i16(LDSP(s16x4, off));
    const s16x4 hi = __builtin_amdgcn_ds_read_tr16_b64_v4i16(LDSP(s16x4, off + 4 * RS));
    bf16x8 r; r[0] = lo[0]; r[1] = lo[1]; r[2] = lo[2]; r[3] = lo[3]; r[4] = hi[0]; r[5] = hi[1]; r[6] = hi[2]; r[7] = hi[3]; return r;
}
template <int S> __device__ __forceinline__ bf16x8 acc_frag(const f32x16& x) {
    u32x4 w; w.x = pk2(x[8 * S + 0], x[8 * S + 1]); w.y = pk2(x[8 * S + 2], x[8 * S + 3]); w.z = pk2(x[8 * S + 4], x[8 * S + 5]); w.w = pk2(x[8 * S + 6], x[8 * S + 7]);
    return __builtin_bit_cast(bf16x8, w);
}
#define MFMA32(a, b, c) __builtin_amdgcn_mfma_f32_32x32x16_bf16(a, b, c, 0, 0, 0)
__device__ __forceinline__ int accrow(int i, int h) { return (i & 3) + 8 * (i >> 2) + 4 * h; }
#define ACCROW0(i) (((i) & 3) + 8 * ((i) >> 2))

__device__ __forceinline__ void p0_transpose_tile(const float* W, int ldw, int K, bf16_t* WT, LAS unsigned char* lds, int kb, int nb, int tid, int wave, int lane) {
    constexpr unsigned RS = 528;
    const int k0 = 64 * kb, n0 = 256 * nb;
    f32x4 v[8];
#pragma unroll
    for (int i = 0; i < 8; ++i) { const int idx = tid + NTHR * i, k = idx >> 6, nq = idx & 63; v[i] = *(const f32x4*)(W + (size_t)(k0 + k) * ldw + n0 + 4 * nq); }
#pragma unroll
    for (int i = 0; i < 8; ++i) { const int idx = tid + NTHR * i, k = idx >> 6, nq = idx & 63; u32x2 o; o.x = pk2(v[i].x, v[i].y); o.y = pk2(v[i].z, v[i].w); *LDSP(u32x2, k * RS + 8 * nq) = o; }
    __syncthreads();
    const unsigned ot = lp_tr(lane, RS) + 64u * wave;
#pragma unroll
    for (int rb = 0; rb < 4; ++rb) { const bf16x8 f = frag_tr<RS>(lds, ot + 16 * rb * RS);
        *(bf16x8*)(WT + (size_t)(n0 + 32 * wave + (lane & 31)) * K + k0 + 16 * rb + 8 * (lane >> 5)) = f; }
    __syncthreads();
}
__device__ __forceinline__ void transposes(const Args& a, LAS unsigned char* lds, int vcu, int G, int tid, int wave, int lane);
__device__ __forceinline__ void phase0(const Args& a, LAS unsigned char* lds, int vcu, int G, int tid, int wave, int lane) {
    float* MOD = (float*)(a.ws + WS_MOD);
    for (int cb = vcu; cb < 96; cb += G) {
        const int c0 = 32 * cb;
#pragma unroll
        for (int hb = 0; hb < 2; ++hb) { f32x4 v[8];
#pragma unroll
            for (int i = 0; i < 8; ++i) { const int k = (tid >> 3) + 64 * (8 * hb + i); v[i] = *(const f32x4*)(a.w_ada + (size_t)k * 3072 + c0 + 4 * (tid & 7)); }
#pragma unroll
            for (int i = 0; i < 8; ++i) { const int k = (tid >> 3) + 64 * (8 * hb + i); u32x2 o; o.x = pk2(v[i].x, v[i].y); o.y = pk2(v[i].z, v[i].w); *LDSP(u32x2, k * 80 + 8 * (tid & 7)) = o; } }
        __syncthreads();
        if (wave < 5) {
            const int hl = lane >> 5, rr = 32 * wave + (lane & 31), rc = rr < NMOD ? rr : NMOD - 1;
            const float* cr = (rc < BP ? a.c_p + (size_t)rc * DM : a.c_s + (size_t)(rc - BP) * DM) + 8 * hl;
            const unsigned ot = lp_tr(lane, 80);
            f32x16 acc;
#pragma unroll
            for (int i = 0; i < 16; ++i) acc[i] = 0.f;
            f32x4 cv[8][2], cnx[8][2];
#pragma unroll
            for (int j = 0; j < 8; ++j) { cnx[j][0] = *(const f32x4*)(cr + 16 * j); cnx[j][1] = *(const f32x4*)(cr + 16 * j + 4); }
#pragma unroll 1
            for (int k0 = 0; k0 < DM; k0 += 128) {
#pragma unroll
                for (int j = 0; j < 8; ++j) { cv[j][0] = cnx[j][0]; cv[j][1] = cnx[j][1]; }
                { const int kn = (k0 + 128 < DM) ? k0 + 128 : k0;
#pragma unroll
                  for (int j = 0; j < 8; ++j) { cnx[j][0] = *(const f32x4*)(cr + kn + 16 * j); cnx[j][1] = *(const f32x4*)(cr + kn + 16 * j + 4); } }
#pragma unroll
                for (int j = 0; j < 8; ++j) {
                    float sv[8];
#pragma unroll
                    for (int e = 0; e < 4; ++e) { sv[e] = cv[j][0][e] * sigmoidf_(cv[j][0][e]); sv[4 + e] = cv[j][1][e] * sigmoidf_(cv[j][1][e]); }
                    u32x4 w; w.x = pk2(sv[0], sv[1]); w.y = pk2(sv[2], sv[3]); w.z = pk2(sv[4], sv[5]); w.w = pk2(sv[6], sv[7]);
                    acc = MFMA32(__builtin_bit_cast(bf16x8, w), frag_tr<80>(lds, ot + (unsigned)(k0 + 16 * j) * 80u), acc);
                }
            }
#pragma unroll
            for (int i = 0; i < 16; ++i) { const int r = 32 * wave + accrow(i, hl);
                if (r < NMOD) MOD[(size_t)r * 3072 + c0 + (lane & 31)] = acc[i] + a.b_ada[c0 + (lane & 31)]; }
        }
        __syncthreads();
    }
    if (vcu >= 96) transposes(a, lds, vcu - 96, G - 96, tid, wave, lane);
    if (vcu == G - 1) {
        float* GW = (float*)(a.ws + WS_GW);
        float tv[16];
#pragma unroll
        for (int i = 0; i < 16; ++i) { const int idx = tid + NTHR * i; tv[i] = a.w_in[(size_t)(idx >> 3) * WIN_LD + NPROJ + (idx & 7)]; }
#pragma unroll
        for (int i = 0; i < 16; ++i) { const int idx = tid + NTHR * i; GW[(idx & 7) * 1024 + (idx >> 3)] = tv[i]; }
    }
}
__device__ __forceinline__ void transposes(const Args& a, LAS unsigned char* lds, int vcu, int G, int tid, int wave, int lane) {
    bf16_t* WinT = (bf16_t*)(a.ws + WS_WIN); bf16_t* WoutT = (bf16_t*)(a.ws + WS_WOUT);
    constexpr int I_IN = (DM / 64) * (NPROJ / 256), I_OUT = (DMIX / 64) * (DM / 256);
    for (int it = vcu; it < I_IN + I_OUT; it += G) {
        if (it < I_IN) p0_transpose_tile(a.w_in, WIN_LD, DM, WinT, lds, it / (NPROJ / 256), it % (NPROJ / 256), tid, wave, lane);
        else { const int u = it - I_IN; p0_transpose_tile(a.w_out, DM, DMIX, WoutT, lds, u / (DM / 256), u % (DM / 256), tid, wave, lane); }
    }
}

__device__ __forceinline__ unsigned p3a_touch(const Args& a, int t, int tid) {
    const bf16_t* PROJ = (const bf16_t*)(a.ws + WS_PROJ);
    const unsigned* p;
    if (t < 1024) { const int b = t >> 7, c = (t >> 2) & 31, h = t & 3;
        p = (const unsigned*)(PROJ + ml_tile(4, b, c, h) + (tid & 255) * 64); }
    else { const int u = t - 1024, b = u >> 8, c = (u >> 3) & 31, h = u & 7;
        if (tid < 256) p = (const unsigned*)((const float*)(a.ws + WS_LOGF) + ((size_t)((b * NCH + c) * 8 + h) << 13) + tid * 32);
        else p = (const unsigned*)(PROJ + hg_tile(0, b, c, h) + (tid & 127) * 64); }
    return *p;
}
__device__ __forceinline__ void p3a_hgrn(const Args& a, LAS unsigned char* lds, int b, int c, int h, int tid, int wave, int lane, int tnext) {
    constexpr unsigned RS = 272, OQT = 8192, OKT = 8192 + 17408;
    bf16_t* PROJ = (bf16_t*)(a.ws + WS_PROJ);
    const float* LOGF = (const float*)(a.ws + WS_LOGF);
    const size_t r0 = (size_t)b * TP + (size_t)c * 64;
    const size_t task = ((size_t)b * NCH + c) * 8 + h;
    const int cq = tid & 31, tseg = tid >> 5;
    f32x4 lf[4]; u32x2 qw[4];
#pragma unroll
    for (int i = 0; i < 4; ++i) { const int t = 4 * tseg + i; lf[i] = *(const f32x4*)(LOGF + (task << 13) + t * 128 + 4 * cq); qw[i] = *(const u32x2*)(PROJ + hg_tile(0, b, c, h) + t * 128 + 4 * cq); }
    const unsigned pf = (tnext >= 0) ? p3a_touch(a, tnext, tid) : 0u;
    f32x4 gl[4]; gl[0] = lf[0]; gl[1] = gl[0] + lf[1]; gl[2] = gl[1] + lf[2]; gl[3] = gl[2] + lf[3];
    *LDSP(f32x4, (tseg * 128 + 4 * cq) * 4) = gl[3];
    __syncthreads();
    f32x4 off = {0.f, 0.f, 0.f, 0.f}, Gm = off, GL = off;
#pragma unroll
    for (int sg = 0; sg < 16; ++sg) { const f32x4 v = *LDSP(const f32x4, (sg * 128 + 4 * cq) * 4); GL += v; if (sg < 8) Gm += v; if (sg < tseg) off += v; }
#pragma unroll
    for (int i = 0; i < 4; ++i) { const int t = 4 * tseg + i;
        const f32x4 G = off + gl[i];
        const float q[4] = {bflo(qw[i].x), bfhi(qw[i].x), bflo(qw[i].y), bfhi(qw[i].y)};
        float qe[4], ke[4], qt[4], kt[4];
#pragma unroll
        for (int e = 0; e < 4; ++e) { const float kk = 1.f - __expf(lf[i][e]);
            qe[e] = q[e] * __expf(G[e]); ke[e] = kk * __expf(GL[e] - G[e]); qt[e] = q[e] * __expf(G[e] - Gm[e]); kt[e] = kk * __expf(Gm[e] - G[e]); }
        bf16_t* qp = PROJ + hg_tile(0, b, c, h) + t * 128 + 4 * cq;
        u32x2 o; o.x = pk2(qe[0], qe[1]); o.y = pk2(qe[2], qe[3]); *(u32x2*)qp = o;
        o.x = pk2(ke[0], ke[1]); o.y = pk2(ke[2], ke[3]); *(u32x2*)(qp + SEGSZ) = o;
        o.x = pk2(qt[0], qt[1]); o.y = pk2(qt[2], qt[3]); *LDSP(u32x2, OQT + t * RS + 8 * cq) = o;
        o.x = pk2(kt[0], kt[1]); o.y = pk2(kt[2], kt[3]); *LDSP(u32x2, OKT + t * RS + 8 * cq) = o;
    }
    if (tseg == 15) { f32x4 d; d.x = __expf(GL.x); d.y = __expf(GL.y); d.z = __expf(GL.z); d.w = __expf(GL.w); *(f32x4*)((float*)(a.ws + WS_DEC) + task * 128 + 4 * cq) = d; }
    __syncthreads();
    bf16_t* AH = (bf16_t*)(a.ws + WS_AH) + task * 4096;
    if (wave < 4) {
        const int ti = (wave == 0 || wave == 3) ? 0 : 1, tj = (wave == 2 || wave == 3) ? 1 : 0;
        const int hh = lane >> 5, c31 = lane & 31;
        f32x16 acc = {0.f, 0.f, 0.f, 0.f, 0.f, 0.f, 0.f, 0.f, 0.f, 0.f, 0.f, 0.f, 0.f, 0.f, 0.f, 0.f};
        if (wave < 3) {
            unsigned oa = OQT + lp_row(lane, RS) + 32u * ti * RS, ob = OKT + lp_row(lane, RS) + 32u * tj * RS;
#pragma unroll 4
            for (int ks = 0; ks < 8; ++ks) { acc = MFMA32(frag_row(lds, oa), frag_row(lds, ob), acc); oa += 32; ob += 32; }
        }
#pragma unroll
        for (int i = 0; i < 16; ++i) { const int t = 32 * ti + accrow(i, hh), j = 32 * tj + c31;
            AH[t * 64 + j] = f2bf((wave < 3 && j <= t) ? acc[i] : 0.f); }
    }
    asm volatile("" :: "v"(pf));
    __syncthreads();
}
__device__ __forceinline__ void p3a_mlstm(const Args& a, LAS unsigned char* lds, int b, int c, int h, int tid, int wave, int lane, int tnext) {
    constexpr unsigned RS = 528, OK_ = 33792, ORS_ = 67584, OCS_ = 67584 + 256;
    const bf16_t* PROJ = (const bf16_t*)(a.ws + WS_PROJ);
    const float* GATE = (const float*)(a.ws + WS_GATE);
    const size_t r0 = (size_t)b * TP + (size_t)c * 64;
    const size_t task = ((size_t)b * NCH + c) * 4 + h;
    if (tid < 64) *LDSP(float, ORS_ + tid * 4) = 0.f;
    const int tg = tid & 7, g = tid >> 3, ch = h * 256 + 4 * g, gg = h * 64 + g;
    const float ig = GATE[(r0 + lane) * 8 + h], lfg = GATE[(r0 + lane) * 8 + 4 + h];
    u32x2 muw[11];
#pragma unroll
    for (int rr = 0; rr < 11; ++rr) { const int t = 8 * tg - 3 + rr; const bool pad = (c == 0 && t < 0);
        const int tt_ = pad ? 0 : t;
        const u32x2 w = *(const u32x2*)(PROJ + ml_tile(4, b, tt_ < 0 ? c - 1 : c, h) + (tt_ & 63) * 256 + 4 * g);
        muw[rr].x = pad ? 0u : w.x; muw[rr].y = pad ? 0u : w.y; }
    float cw[4][4], cb[4], wq[4][4], wk[4][4], wv[4][4];
#pragma unroll
    for (int w = 0; w < 4; ++w) { const f32x4 t = *(const f32x4*)(a.conv_w + w * 1024 + ch); cw[w][0] = t.x; cw[w][1] = t.y; cw[w][2] = t.z; cw[w][3] = t.w; }
    { const f32x4 t = *(const f32x4*)(a.conv_b + ch); cb[0] = t.x; cb[1] = t.y; cb[2] = t.z; cb[3] = t.w; }
#pragma unroll
    for (int i = 0; i < 4; ++i) { const f32x4 t0 = *(const f32x4*)(a.wq + gg * 16 + 4 * i), t1 = *(const f32x4*)(a.wk + gg * 16 + 4 * i), t2 = *(const f32x4*)(a.wv + gg * 16 + 4 * i);
#pragma unroll
        for (int j = 0; j < 4; ++j) { wq[i][j] = t0[j]; wk[i][j] = t1[j] * 0.0625f; wv[i][j] = t2[j]; } }
    const unsigned pf = (tnext >= 0) ? p3a_touch(a, tnext, tid) : 0u;
    float bt = lfg;
#pragma unroll
    for (int o = 1; o < 64; o <<= 1) { const float n = __shfl_up(bt, o); if (lane >= o) bt += n; }
    const float av = ig - bt; float R = av;
#pragma unroll
    for (int o = 1; o < 64; o <<= 1) R = fmaxf(R, __shfl_xor(R, o));
    const float wtok = __expf(av - R);
    if (wave == 0) { ((float*)(a.ws + WS_BT))[task * 64 + lane] = bt; if (lane == 0) ((float*)(a.ws + WS_RL))[task] = R; }
    {
        bf16_t* XC = (bf16_t*)(a.ws + WS_XC); bf16_t* QM = (bf16_t*)(a.ws + WS_QM); bf16_t* KM = (bf16_t*)(a.ws + WS_KM); bf16_t* VM = (bf16_t*)(a.ws + WS_VM);
        float cs[4] = {0.f, 0.f, 0.f, 0.f};
        u32x4 kT[4], vT[4];
#pragma unroll
        for (int tp = 0; tp < 4; ++tp) { float k2[2][4], v2[2][4];
#pragma unroll
          for (int u = 0; u < 2; ++u) { const int tt = 2 * tp + u; const int t = 8 * tg + tt; const float wt = __shfl(wtok, t);
            float m0[4], m1[4], m2[4], m3[4];
            m0[0] = bflo(muw[tt].x); m0[1] = bfhi(muw[tt].x); m0[2] = bflo(muw[tt].y); m0[3] = bfhi(muw[tt].y);
            m1[0] = bflo(muw[tt + 1].x); m1[1] = bfhi(muw[tt + 1].x); m1[2] = bflo(muw[tt + 1].y); m1[3] = bfhi(muw[tt + 1].y);
            m2[0] = bflo(muw[tt + 2].x); m2[1] = bfhi(muw[tt + 2].x); m2[2] = bflo(muw[tt + 2].y); m2[3] = bfhi(muw[tt + 2].y);
            m3[0] = bflo(muw[tt + 3].x); m3[1] = bfhi(muw[tt + 3].x); m3[2] = bflo(muw[tt + 3].y); m3[3] = bfhi(muw[tt + 3].y);
            float xc[4], q[4], k[4];
#pragma unroll
            for (int i = 0; i < 4; ++i) { const float cv = cb[i] + cw[0][i] * m0[i] + cw[1][i] * m1[i] + cw[2][i] * m2[i] + cw[3][i] * m3[i]; xc[i] = cv * sigmoidf_(cv); }
#pragma unroll
            for (int j = 0; j < 4; ++j) { q[j] = xc[0] * wq[0][j] + xc[1] * wq[1][j] + xc[2] * wq[2][j] + xc[3] * wq[3][j];
                k[j] = (xc[0] * wk[0][j] + xc[1] * wk[1][j] + xc[2] * wk[2][j] + xc[3] * wk[3][j]) * wt;
                v2[u][j] = m3[0] * wv[0][j] + m3[1] * wv[1][j] + m3[2] * wv[2][j] + m3[3] * wv[3][j]; cs[j] += k[j]; k2[u][j] = k[j]; }
            const size_t go = (task << 14) + t * 256 + 4 * g;
            u32x2 o; o.x = pk2(xc[0], xc[1]); o.y = pk2(xc[2], xc[3]); *(u32x2*)(XC + go) = o;
            o.x = pk2(q[0], q[1]); o.y = pk2(q[2], q[3]); *(u32x2*)(QM + go) = o; *LDSP(u32x2, t * RS + 8 * g) = o;
            o.x = pk2(k[0], k[1]); o.y = pk2(k[2], k[3]); *LDSP(u32x2, OK_ + t * RS + 8 * g) = o;
          }
#pragma unroll
          for (int j = 0; j < 4; ++j) { kT[j][tp] = pk2(k2[0][j], k2[1][j]); vT[j][tp] = pk2(v2[0][j], v2[1][j]); }
        }
#pragma unroll
        for (int j = 0; j < 4; ++j) { const size_t go = (task << 14) + (size_t)(4 * g + j) * 64 + 8 * tg;
            *(u32x4*)(KM + go) = kT[j]; *(u32x4*)(VM + go) = vT[j]; }
#pragma unroll
        for (int j = 0; j < 4; ++j) { cs[j] += __shfl_xor(cs[j], 1); cs[j] += __shfl_xor(cs[j], 2); cs[j] += __shfl_xor(cs[j], 4); }
        if (tg == 0) *LDSP(f32x4, OCS_ + 16 * g) = (f32x4){cs[0], cs[1], cs[2], cs[3]};
        if (c == NCH - 1 && tg == 7) {
#pragma unroll
            for (int j = 0; j < 3; ++j) *(f32x4*)(a.out + O_VP + ((size_t)b * 3 + j) * 1024 + ch) = (f32x4){bflo(muw[8 + j].x), bfhi(muw[8 + j].x), bflo(muw[8 + j].y), bfhi(muw[8 + j].y)};
        }
    }
    __syncthreads();
    bf16_t* AM = (bf16_t*)(a.ws + WS_AM) + task * 4096;
    if (wave < 4) {
        const int ti = (wave == 0 || wave == 3) ? 0 : 1, tj = (wave == 2 || wave == 3) ? 1 : 0;
        const int hh = lane >> 5, c31 = lane & 31;
        f32x16 acc = {0.f, 0.f, 0.f, 0.f, 0.f, 0.f, 0.f, 0.f, 0.f, 0.f, 0.f, 0.f, 0.f, 0.f, 0.f, 0.f};
        if (wave < 3) {
            unsigned oa = lp_row(lane, RS) + 32u * ti * RS, ob = OK_ + lp_row(lane, RS) + 32u * tj * RS;
#pragma unroll 4
            for (int ks = 0; ks < 16; ++ks) { acc = MFMA32(frag_row(lds, oa), frag_row(lds, ob), acc); oa += 32; ob += 32; }
        }
        float pv[16];
#pragma unroll
        for (int i = 0; i < 16; ++i) { const int t = 32 * ti + accrow(i, hh), j = 32 * tj + c31;
            pv[i] = (wave < 3 && j <= t) ? acc[i] : 0.f;
            AM[t * 64 + j] = f2bf(pv[i]); }
        if (wave < 3) {
#pragma unroll
            for (int bit = 8; bit >= 1; bit >>= 1) {
#pragma unroll
                for (int m = 0; m < bit; ++m) { const bool up = (lane & bit) != 0; const float send = up ? pv[m] : pv[m + bit], keep = up ? pv[m + bit] : pv[m];
                    pv[m] = keep + __shfl_xor(send, bit); }
            }
            const float tot = pv[0] + __shfl_xor(pv[0], 16);
            if ((lane & 16) == 0) { const int i = lane & 15; atomicAdd((float*)LDSP(float, ORS_ + (32 * ti + accrow(i, hh)) * 4), tot); }
        }
    }
    asm volatile("" :: "v"(pf));
    __syncthreads();
    if (tid < 64) ((float*)(a.ws + WS_RS))[task * 64 + tid] = *LDSP(const float, ORS_ + tid * 4);
    if (tid < 256) ((float*)(a.ws + WS_CSK))[task * 256 + tid] = *LDSP(const float, OCS_ + tid * 4);
    __syncthreads();
}

constexpr int NPART = 4, CPP = NCH / NPART;
constexpr size_t WS_SUMH = 2 * MiB;
constexpr size_t WS_DTOT = 14 * MiB;
constexpr size_t WS_SUMM = 484 * MiB;
constexpr size_t WS_SUMN = 508 * MiB;
constexpr size_t WS_SUMS = 508 * MiB + 512 * 1024;
constexpr size_t WS_STATS = 509 * MiB;
constexpr size_t WS_END2 = 510 * MiB;

template <int MODE>
__device__ __forceinline__ void p3b_hgrn(const Args& a, LAS unsigned char* lds, int b, int hp, int part, int tid, int wave, int lane) {
    constexpr unsigned RS = 272, RSA = 144, HB = 62464;
    constexpr unsigned OKE = 17408, OV = 34816, OA = 52224, ODEC = 61440;
    const int hhd = wave >> 2, vb = wave & 3, hl = lane >> 5, c31 = lane & 31;
    const bf16_t* PROJ = (const bf16_t*)(a.ws + WS_PROJ);
    const bf16_t* AH = (const bf16_t*)(a.ws + WS_AH);
    const float* DEC = (const float*)(a.ws + WS_DEC);
    bf16_t* MIX = (bf16_t*)(a.ws + WS_MIX);
    float* SUMH = (float*)(a.ws + WS_SUMH); float* DTOT = (float*)(a.ws + WS_DTOT);
    f32x16 acc[4];
#pragma unroll
    for (int kt = 0; kt < 4; ++kt)
#pragma unroll
        for (int i = 0; i < 16; ++i) acc[kt][i] = 0.f;
    unsigned hb = (unsigned)hhd * HB;
    unsigned o_perm = hb + lp_perm(lane, RS), o_rowA = hb + OA + lp_row(lane, RSA), o_trV = hb + OV + lp_tr(lane, RS) + 64u * vb, o_trK = hb + OKE + lp_tr(lane, RS);
    unsigned o_dec = hb + ODEC + 16u * hl, o_st = hb + 4u * hl * RS + (32u * vb + c31) * 2u;
    const size_t sbase = ((size_t)b * 4 + hp) * 3;
    if (MODE == 1) {
        for (int q = 0; q < part; ++q) {
            __syncthreads();
            if (tid < 256) *LDSP(float, (tid >> 7) * HB + ODEC + (tid & 127) * 4) = DTOT[(sbase + q) * 256 + tid];
            __syncthreads();
            const float* su = SUMH + ((sbase + q) * 2 + hhd) * 16384 + (size_t)(vb * 4) * 1024 + lane;
#pragma unroll
            for (int kt = 0; kt < 4; ++kt)
#pragma unroll
                for (int g4 = 0; g4 < 4; ++g4) { const f32x4 d = *LDSP(const f32x4, o_dec + (32 * kt + 8 * g4) * 4);
#pragma unroll
                    for (int e = 0; e < 4; ++e) acc[kt][4 * g4 + e] = acc[kt][4 * g4 + e] * d[e] + su[kt * 1024 + (4 * g4 + e) * 64]; }
        }
    }
    float dprod = 1.f;
    constexpr int NT = (MODE == 0) ? 8 : 12;
    u32x4 pre[NT], preA[2]; float preD = 0.f;
#define HG_TILE(idx, tile, head, which) const int tile = (MODE == 0) ? ((idx) >> 10) : ((idx) >> 10), head = (MODE == 0) ? (tile >> 1) : (tile / 3), which = (MODE == 0) ? (1 + (tile & 1)) : (tile % 3)
#define HG_ISSUE(cc) do { \
        _Pragma("unroll") for (int i = 0; i < NT; ++i) { const int idx = tl + NTHR * i; HG_TILE(idx, tile, head, which); const int rem = idx & 1023; \
            pre[i] = *(const u32x4*)(PROJ + hg_tile(which, b, (cc), 2 * hp + head) + rem * 8); } \
        if (MODE == 1) { _Pragma("unroll") for (int i = 0; i < 2; ++i) { const int idx = tl + NTHR * i, head = idx >> 9, rem = idx & 511; \
            preA[i] = *(const u32x4*)(AH + (((size_t)b * NCH + (cc)) * 8 + 2 * hp + head) * 4096 + rem * 8); } } \
        if (tl < 256) preD = DEC[(((size_t)b * NCH + (cc)) * 8 + 2 * hp + (tl >> 7)) * 128 + (tl & 127)]; } while (0)
    { int tl = tid; HG_ISSUE(part * CPP); }
    for (int c = part * CPP; c < (part + 1) * CPP; ++c) {
        int tl = tid; asm volatile("" : "+v"(tl));
        asm volatile("" : "+v"(o_perm), "+v"(o_rowA), "+v"(o_trV), "+v"(o_trK), "+v"(o_dec), "+v"(o_st));
        __syncthreads();
#pragma unroll
        for (int i = 0; i < NT; ++i) { const int idx = tl + NTHR * i; HG_TILE(idx, tile, head, which); const int rem = idx & 1023, row = rem >> 4, ch = rem & 15;
            *LDSP(u32x4, head * HB + which * 17408 + row * RS + 16 * ch) = pre[i]; }
        if (MODE == 1) {
#pragma unroll
            for (int i = 0; i < 2; ++i) { const int idx = tl + NTHR * i, head = idx >> 9, rem = idx & 511, row = rem >> 3, ch = rem & 7;
                *LDSP(u32x4, head * HB + OA + row * RSA + 16 * ch) = preA[i]; } }
        if (tl < 256) { *LDSP(float, (tl >> 7) * HB + ODEC + (tl & 127) * 4) = preD; dprod *= preD; }
        __syncthreads();
        if (c + 1 < (part + 1) * CPP) HG_ISSUE(c + 1);
        f32x16 o0, o1; bf16x8 vf[4];
        if (MODE == 1) {
#pragma unroll
            for (int i = 0; i < 16; ++i) { o0[i] = 0.f; o1[i] = 0.f; }
#pragma unroll
            for (int kt = 0; kt < 4; ++kt) {
                { const bf16x8 bf = acc_frag<0>(acc[kt]);
                  o0 = MFMA32(frag_perm(lds, o_perm + 64 * kt), bf, o0); o1 = MFMA32(frag_perm(lds, o_perm + 32 * RS + 64 * kt), bf, o1); }
                { const bf16x8 bf = acc_frag<1>(acc[kt]);
                  o0 = MFMA32(frag_perm(lds, o_perm + 64 * kt + 32), bf, o0); o1 = MFMA32(frag_perm(lds, o_perm + 32 * RS + 64 * kt + 32), bf, o1); }
                asm volatile("" : "+v"(o0), "+v"(o1) :: "memory");
            }
        }
#pragma unroll
        for (int js = 0; js < 4; ++js) vf[js] = frag_tr<RS>(lds, o_trV + 16 * js * RS);
        if (MODE == 1) {
#pragma unroll
            for (int js = 0; js < 4; ++js) { o0 = MFMA32(frag_row(lds, o_rowA + 32 * js), vf[js], o0); o1 = MFMA32(frag_row(lds, o_rowA + 32 * RSA + 32 * js), vf[js], o1); }
            asm volatile("" : "+v"(o0), "+v"(o1) :: "memory");
        }
#pragma unroll
        for (int kt = 0; kt < 4; ++kt) {
#pragma unroll
            for (int g4 = 0; g4 < 4; ++g4) { const f32x4 d = *LDSP(const f32x4, o_dec + (32 * kt + 8 * g4) * 4);
                acc[kt][4 * g4 + 0] *= d.x; acc[kt][4 * g4 + 1] *= d.y; acc[kt][4 * g4 + 2] *= d.z; acc[kt][4 * g4 + 3] *= d.w; }
            asm volatile("" : "+v"(acc[kt]) :: "memory"); }
#pragma unroll
        for (int kt = 0; kt < 4; ++kt) {
#pragma unroll
            for (int js = 0; js < 4; ++js) acc[kt] = MFMA32(frag_tr<RS>(lds, o_trK + 16 * js * RS + 64 * kt), vf[js], acc[kt]);
            asm volatile("" : "+v"(acc[kt]) :: "memory"); }
        if (MODE == 1) {
            __builtin_amdgcn_sched_barrier(0);
            __syncthreads();
#pragma unroll
            for (int i = 0; i < 16; ++i) {
                *LDSP(bf16_t, o_st + ACCROW0(i) * RS) = f2bf(o0[i]);
                *LDSP(bf16_t, o_st + (32 + ACCROW0(i)) * RS) = f2bf(o1[i]);
            }
            __syncthreads();
            const size_t r0 = (size_t)b * TP + (size_t)c * 64;
#pragma unroll
            for (int i = 0; i < 4; ++i) { const int idx = tl + NTHR * i, head = idx >> 10, rem = idx & 1023, row = rem >> 4, ch = rem & 15;
                const u32x4 w = *LDSP(const u32x4, head * HB + row * RS + 16 * ch);
                float v[8] = {bflo(w.x), bfhi(w.x), bflo(w.y), bfhi(w.y), bflo(w.z), bfhi(w.z), bflo(w.w), bfhi(w.w)};
                float ss = 0.f;
#pragma unroll
                for (int e = 0; e < 8; ++e) ss += v[e] * v[e];
                ss += __shfl_xor(ss, 1); ss += __shfl_xor(ss, 2); ss += __shfl_xor(ss, 4); ss += __shfl_xor(ss, 8);
                const float rn = 1.0f / sqrtf(ss * (1.f / 128.f) + EPS);
                const int col = (2 * hp + head) * 128 + 8 * ch;
                const u32x4 z = *(const u32x4*)(PROJ + hg_tile(3, b, c, 2 * hp + head) + rem * 8);
                const f32x4 g0 = *(const f32x4*)(a.hnorm_g + col), g1 = *(const f32x4*)(a.hnorm_g + col + 4);
                u32x4 o; o.x = pk2(v[0] * rn * g0.x * bflo(z.x), v[1] * rn * g0.y * bfhi(z.x)); o.y = pk2(v[2] * rn * g0.z * bflo(z.y), v[3] * rn * g0.w * bfhi(z.y));
                o.z = pk2(v[4] * rn * g1.x * bflo(z.z), v[5] * rn * g1.y * bfhi(z.z)); o.w = pk2(v[6] * rn * g1.z * bflo(z.w), v[7] * rn * g1.w * bfhi(z.w));
                *(u32x4*)(MIX + (r0 + row) * DMIX + col) = o;
            }
        }
    }
    if (MODE == 0) {
        float* su = SUMH + ((sbase + part) * 2 + hhd) * 16384 + (size_t)(vb * 4) * 1024 + lane;
#pragma unroll
        for (int kt = 0; kt < 4; ++kt)
#pragma unroll
            for (int i = 0; i < 16; ++i) su[kt * 1024 + i * 64] = acc[kt][i];
        if (tid < 256) DTOT[(sbase + part) * 256 + tid] = dprod;
    } else if (part == NPART - 1) {
        float* SP = a.out + O_HP + ((size_t)b * 8 + 2 * hp + hhd) * 128 * 128 + (size_t)(4 * hl) * 128 + 32 * vb + c31;
#pragma unroll
        for (int kt = 0; kt < 4; ++kt)
#pragma unroll
            for (int i = 0; i < 16; ++i) SP[(size_t)(32 * kt + ACCROW0(i)) * 128] = acc[kt][i];
    }
    __syncthreads();
#undef HG_TILE
#undef HG_ISSUE
}

template <int MODE>
__device__ __forceinline__ void p3b_mlstm(const Args& a, LAS unsigned char* lds, int b, int h, int part, int tid, int wave, int lane) {
    constexpr unsigned RS = 528;
    constexpr unsigned OKE = (MODE == 1) ? 33792u : 0u, OV = OKE + 32768u, OA = OV + 32768u;
    constexpr unsigned ON = (MODE == 1) ? OA + 8192u : 131072u, OD = ON + 1024, OBT = OD + 256, ORS = OBT + 256, OCS = ORS + 256, OSTG = OCS + 1024 + 256;
    static_assert(MODE == 0 || OSTG + 64 * RS <= (unsigned)MISC_OFF, "LDS layout");
    const int hl = lane >> 5, c31 = lane & 31;
    const bf16_t* PROJ = (const bf16_t*)(a.ws + WS_PROJ);
    const bf16_t* QM = (const bf16_t*)(a.ws + WS_QM); const bf16_t* KM = (const bf16_t*)(a.ws + WS_KM); const bf16_t* VM = (const bf16_t*)(a.ws + WS_VM); const bf16_t* XC = (const bf16_t*)(a.ws + WS_XC);
    const bf16_t* AM = (const bf16_t*)(a.ws + WS_AM);
    bf16_t* MIX = (bf16_t*)(a.ws + WS_MIX);
    float* SUMM = (float*)(a.ws + WS_SUMM); float* SUMN = (float*)(a.ws + WS_SUMN); float* SUMS = (float*)(a.ws + WS_SUMS);
    f32x16 acc[8];
#pragma unroll
    for (int kt = 0; kt < 8; ++kt)
#pragma unroll
        for (int i = 0; i < 16; ++i) acc[kt][i] = 0.f;
    if (tid < 256) *LDSP(float, ON + tid * 4) = 0.f;
    float mu = 0.f, mrun = (MODE == 0) ? -1e30f : 0.f, bsum = 0.f;
    const size_t sbase = ((size_t)b * 4 + h) * 3;
    if (MODE == 1 && part > 0) {
        float muU[3], Bq[3], Mq[3], cq[3];
#pragma unroll
        for (int q = 0; q < 3; ++q) { const float* s3 = SUMS + (sbase + (q < part ? q : 0)) * 4; muU[q] = s3[0]; Bq[q] = s3[1]; Mq[q] = s3[2]; }
        float sb = 0.f, mus = -1e30f, e[3];
#pragma unroll
        for (int q = 2; q >= 0; --q) { if (q < part) { e[q] = muU[q] + sb; mus = fmaxf(mus, e[q]); sb += Bq[q]; } else e[q] = -1e30f; }
#pragma unroll
        for (int q = 0; q < 3; ++q) { cq[q] = (q < part) ? __expf(e[q] - mus) : 0.f; if (q < part) mrun = fmaxf(mrun + Bq[q], Mq[q]); }
        mu = mus;
        const float* su0 = SUMM + (sbase + 0) * 65536 + (size_t)(wave * 8) * 1024 + lane * 16;
#pragma unroll
        for (int kp = 0; kp < 4; ++kp) {
            f32x4 t[3][2][4];
#pragma unroll
            for (int q = 0; q < 3; ++q) { const float* su = su0 + (size_t)(q < part ? q : 0) * 65536;
#pragma unroll
                for (int k2 = 0; k2 < 2; ++k2)
#pragma unroll
                    for (int g = 0; g < 4; ++g) t[q][k2][g] = *(const f32x4*)(su + (2 * kp + k2) * 1024 + 4 * g); }
#pragma unroll
            for (int k2 = 0; k2 < 2; ++k2)
#pragma unroll
                for (int g = 0; g < 4; ++g)
#pragma unroll
                    for (int e4 = 0; e4 < 4; ++e4) acc[2 * kp + k2][4 * g + e4] = cq[0] * t[0][k2][g][e4] + cq[1] * t[1][k2][g][e4] + cq[2] * t[2][k2][g][e4];
            asm volatile("" : "+v"(acc[2 * kp]), "+v"(acc[2 * kp + 1]) :: "memory");
        }
        if (tid < 256) { float n = 0.f;
#pragma unroll
            for (int q = 0; q < 3; ++q) n += cq[q] * SUMN[(sbase + (q < part ? q : 0)) * 256 + tid];
            *LDSP(float, ON + tid * 4) = n; }
    }
    const unsigned xs_ = (unsigned)((c31 >> 1) & 7);
    const unsigned fb_ = (unsigned)c31 * 128u + (((unsigned)hl ^ (xs_ & 1u)) << 4) + ((xs_ >> 1) << 5);
    unsigned o_perm = lp_perm(lane, RS), o_rowA = OA + fb_, o_trV = OV + 4096u * (unsigned)wave + fb_, o_trK = OKE + fb_;
    unsigned o_st = OSTG + 4u * hl * RS + (32u * wave + c31) * 2u, o_h = 16u * hl;
    const int c_end = (part + 1) * CPP;
    float preRL = 0.f, preC = 0.f, preBL = 0.f;
#define ML_DMA_TILE(gsrc, ldsoff, n) do { const char* g_ = (const char*)(gsrc) + vK; \
        _Pragma("unroll") for (int i_ = 0; i_ < (n); ++i_) __builtin_amdgcn_global_load_lds((const unsigned*)(g_ + i_ * 8192), (LAS unsigned*)(lds + (ldsoff) + i_ * 8192u + 1024u * (unsigned)wave), 16, 0, 0); } while (0)
#define ML_ISSUE(cc, bufo) do { const size_t task_ = ((size_t)b * NCH + (cc)) * 4 + h; \
        const unsigned vK = (unsigned)(tl >> 3) * 128u + ((((unsigned)tl & 7u) ^ (((unsigned)tl >> 4) & 7u)) << 4); \
        ML_DMA_TILE(KM + (task_ << 14), (bufo) + OKE, 4); ML_DMA_TILE(VM + (task_ << 14), (bufo) + OV, 4); \
        if (MODE == 1) { ML_DMA_TILE(AM + task_ * 4096, OA, 1); \
            if (wave < 4) __builtin_amdgcn_global_load_lds((const unsigned*)((const float*)(a.ws + WS_CSK) + task_ * 256 + (tl & 255)), (LAS unsigned*)(lds + OCS + 256u * (unsigned)wave), 4, 0, 0); \
            else if (wave == 4) __builtin_amdgcn_global_load_lds((const unsigned*)((const float*)(a.ws + WS_BT) + task_ * 64 + (tl & 63)), (LAS unsigned*)(lds + OBT), 4, 0, 0); \
            else if (wave == 5) __builtin_amdgcn_global_load_lds((const unsigned*)((const float*)(a.ws + WS_RS) + task_ * 64 + (tl & 63)), (LAS unsigned*)(lds + ORS), 4, 0, 0); \
            _Pragma("unroll") for (int i_ = 0; i_ < 5; ++i_) { if (i_ < 4 || wave == 0) { const unsigned q_ = 512u * i_ + (unsigned)tl, row_ = (q_ * 1986u) >> 16; unsigned cp_ = q_ - 33u * row_; cp_ = cp_ > 31u ? 31u : cp_;   \
                __builtin_amdgcn_global_load_lds((const unsigned*)((const char*)(QM + (task_ << 14)) + (row_ * 32u + cp_) * 16u), (LAS unsigned*)(lds + i_ * 8192u + 1024u * (unsigned)wave), 16, 0, 0); } } } \
        else { preC = ((const float*)(a.ws + WS_CSK))[task_ * 256 + (tl & 255)]; preBL = ((const float*)(a.ws + WS_BT))[task_ * 64 + 63]; } \
        preRL = ((const float*)(a.ws + WS_RL))[task_]; } while (0)
    __syncthreads();
    { int tl = tid; asm volatile("" : "+v"(tl)); ML_ISSUE(part * CPP, 0u); }
    for (int c = part * CPP; c < c_end; ++c) {
        int tl = tid; asm volatile("" : "+v"(tl));
        asm volatile("" : "+v"(o_perm), "+v"(o_rowA), "+v"(o_trV), "+v"(o_trK), "+v"(o_st), "+v"(o_h));
        const size_t r0 = (size_t)b * TP + (size_t)c * 64;
        const size_t task = ((size_t)b * NCH + c) * 4 + h;
        const float R = preRL, cskv = preC, bL0 = preBL;
        if (MODE == 1) {
            if (c == part * CPP) asm volatile("s_waitcnt vmcnt(0)" ::: "memory"); else asm volatile("s_waitcnt vmcnt(4)" ::: "memory");
        } else asm volatile("s_waitcnt vmcnt(0)" ::: "memory");
        __syncthreads();
        const unsigned bo = (MODE == 0) ? (unsigned)((c - part * CPP) & 1) * 65536u : 0u;
        if (MODE == 0) { if (c + 1 < c_end) ML_ISSUE(c + 1, 65536u - bo); }
        const float sc = __expf(mu - R);
        f32x16 o0, o1; bf16x8 vf[4];
        if (MODE == 1) {
            { const int t = tl >> 3, sub = tl & 7; float p = 0.f;
#pragma unroll
              for (int j = 0; j < 4; ++j) { const u32x4 w = *LDSP(const u32x4, t * RS + (sub * 32 + 8 * j) * 2);
                  const f32x4 n0 = *LDSP(const f32x4, ON + (sub * 32 + 8 * j) * 4), n1 = *LDSP(const f32x4, ON + (sub * 32 + 8 * j + 4) * 4);
                  p += bflo(w.x) * n0.x + bfhi(w.x) * n0.y + bflo(w.y) * n0.z + bfhi(w.y) * n0.w + bflo(w.z) * n1.x + bfhi(w.z) * n1.y + bflo(w.w) * n1.z + bfhi(w.w) * n1.w; }
              p += __shfl_xor(p, 1); p += __shfl_xor(p, 2); p += __shfl_xor(p, 4);
              if (sub == 0) { const float den = fmaxf(fabsf(sc * p + *LDSP(const float, ORS + t * 4)), __expf(-(*LDSP(const float, OBT + t * 4) + R)));
                  *LDSP(float, OD + t * 4) = __builtin_amdgcn_rcpf(den); } }
        }
#pragma unroll
        for (int kt = 0; kt < 8; ++kt)
#pragma unroll
            for (int i = 0; i < 16; ++i) acc[kt][i] *= sc;
        if (MODE == 1) {
#pragma unroll
            for (int i = 0; i < 16; ++i) { o0[i] = 0.f; o1[i] = 0.f; }
#pragma unroll
            for (int kt = 0; kt < 8; ++kt) {
                { const bf16x8 bf = acc_frag<0>(acc[kt]);
                  o0 = MFMA32(frag_perm(lds, o_perm + 64 * kt), bf, o0); o1 = MFMA32(frag_perm(lds, o_perm + 32 * RS + 64 * kt), bf, o1); }
                { const bf16x8 bf = acc_frag<1>(acc[kt]);
                  o0 = MFMA32(frag_perm(lds, o_perm + 64 * kt + 32), bf, o0); o1 = MFMA32(frag_perm(lds, o_perm + 32 * RS + 64 * kt + 32), bf, o1); }
                asm volatile("" : "+v"(o0), "+v"(o1) :: "memory");
            }
        }
#pragma unroll
        for (int js = 0; js < 4; ++js) vf[js] = frag_row(lds, ((o_trV + bo) ^ (32u * js)));
        if (MODE == 1) {
#pragma unroll
            for (int js = 0; js < 4; ++js) { const unsigned oa = o_rowA ^ (32u * js); o0 = MFMA32(frag_row(lds, oa), vf[js], o0); o1 = MFMA32(frag_row(lds, oa + 4096u), vf[js], o1); }
            asm volatile("" : "+v"(o0), "+v"(o1) :: "memory");
        }
        { unsigned okj[4];
#pragma unroll
          for (int js = 0; js < 4; ++js) okj[js] = (o_trK + bo) ^ (32u * js);
#pragma unroll
          for (int kt = 0; kt < 8; ++kt) {
#pragma unroll
            for (int js = 0; js < 4; ++js) acc[kt] = MFMA32(frag_row(lds, okj[js] + 4096u * kt), vf[js], acc[kt]);
            asm volatile("" : "+v"(acc[kt]) :: "memory"); } }
        const float bL = (MODE == 1) ? *LDSP(const float, OBT + 63 * 4) : bL0;
#ifndef RPN
#define RPN 2
#endif
        u32x4 rpm[4], rpz[4], rpx[4];
        if (MODE == 1) {
#pragma unroll
            for (int i = 0; i < RPN; ++i) { const int idx = tl + NTHR * i;
                rpm[i] = *(const u32x4*)(PROJ + ml_tile(6, b, c, h) + idx * 8);
                rpz[i] = *(const u32x4*)(PROJ + ml_tile(5, b, c, h) + idx * 8);
                rpx[i] = *(const u32x4*)(XC + (task << 14) + idx * 8); }
        }
        if (MODE == 0) { if (tl < 256) *LDSP(float, ON + tl * 4) = sc * *LDSP(const float, ON + tl * 4) + cskv; }
        if (MODE == 1) {
            __builtin_amdgcn_sched_barrier(0);
            __syncthreads();
            if (tl < 256) *LDSP(float, ON + tl * 4) = sc * *LDSP(const float, ON + tl * 4) + *LDSP(const float, OCS + tl * 4);
            if (c + 1 < c_end) ML_ISSUE(c + 1, 0u);
#pragma unroll
            for (int g4 = 0; g4 < 4; ++g4) {
                const f32x4 d0 = *LDSP(const f32x4, OD + o_h + 32 * g4), d1 = *LDSP(const f32x4, OD + o_h + 128 + 32 * g4);
#pragma unroll
                for (int e = 0; e < 4; ++e) {
                    *LDSP(bf16_t, o_st + (8 * g4 + e) * RS) = f2bf(o0[4 * g4 + e] * d0[e]);
                    *LDSP(bf16_t, o_st + (32 + 8 * g4 + e) * RS) = f2bf(o1[4 * g4 + e] * d1[e]);
                }
            }
            __syncthreads();
#pragma unroll
            for (int i = 0; i < 4; ++i) { const int idx = tl + NTHR * i, row = idx >> 5, ch = idx & 31, col = h * 256 + 8 * ch;
                const u32x4 w = *LDSP(const u32x4, OSTG + row * RS + 16 * ch);
                const u32x4 mo = (i < RPN) ? rpm[i] : *(const u32x4*)(PROJ + ml_tile(6, b, c, h) + idx * 8);
                float v[8] = {bflo(w.x) * bflo(mo.x), bfhi(w.x) * bfhi(mo.x), bflo(w.y) * bflo(mo.y), bfhi(w.y) * bfhi(mo.y), bflo(w.z) * bflo(mo.z), bfhi(w.z) * bfhi(mo.z), bflo(w.w) * bflo(mo.w), bfhi(w.w) * bfhi(mo.w)};
                float ss = 0.f;
#pragma unroll
                for (int e = 0; e < 8; ++e) ss += v[e] * v[e];
                ss += __shfl_xor(ss, 1); ss += __shfl_xor(ss, 2); ss += __shfl_xor(ss, 4); ss += __shfl_xor(ss, 8); ss += __shfl_xor(ss, 16);
                const float rn = 1.0f / sqrtf(ss * (1.f / 256.f) + EPS);
                const u32x4 z = (i < RPN) ? rpz[i] : *(const u32x4*)(PROJ + ml_tile(5, b, c, h) + idx * 8);
                const u32x4 xc = (i < RPN) ? rpx[i] : *(const u32x4*)(XC + (task << 14) + idx * 8);
                const f32x4 g0 = *(const f32x4*)(a.mnorm_g + col), g1 = *(const f32x4*)(a.mnorm_g + col + 4), k0 = *(const f32x4*)(a.skip + col), k1 = *(const f32x4*)(a.skip + col + 4);
                u32x4 o;
                o.x = pk2((v[0] * rn * g0.x + k0.x * bflo(xc.x)) * bflo(z.x), (v[1] * rn * g0.y + k0.y * bfhi(xc.x)) * bfhi(z.x));
                o.y = pk2((v[2] * rn * g0.z + k0.z * bflo(xc.y)) * bflo(z.y), (v[3] * rn * g0.w + k0.w * bfhi(xc.y)) * bfhi(z.y));
                o.z = pk2((v[4] * rn * g1.x + k1.x * bflo(xc.z)) * bflo(z.z), (v[5] * rn * g1.y + k1.y * bfhi(xc.z)) * bfhi(z.z));
                o.w = pk2((v[6] * rn * g1.z + k1.z * bflo(xc.w)) * bflo(z.w), (v[7] * rn * g1.w + k1.w * bfhi(xc.w)) * bfhi(z.w));
                *(u32x4*)(MIX + (r0 + row) * DMIX + 1024 + col) = o;
            }
        }
        mu = bL + R; mrun = bL + fmaxf(mrun, R); bsum += bL;
    }
    __syncthreads();
    if (MODE == 0) {
        float* su = SUMM + (sbase + part) * 65536 + (size_t)(wave * 8) * 1024 + lane * 16;
#pragma unroll
        for (int kt = 0; kt < 8; ++kt)
#pragma unroll
            for (int g = 0; g < 4; ++g) *(f32x4*)(su + kt * 1024 + 4 * g) = (f32x4){acc[kt][4 * g], acc[kt][4 * g + 1], acc[kt][4 * g + 2], acc[kt][4 * g + 3]};
        if (tid < 256) SUMN[(sbase + part) * 256 + tid] = *LDSP(const float, ON + tid * 4);
        if (tid == 0) { float* s3 = SUMS + (sbase + part) * 4; s3[0] = mu; s3[1] = bsum; s3[2] = mrun; }
    } else if (part == NPART - 1) {
        const float fs = __expf(mu - mrun);
        float* CP = a.out + O_CP + ((size_t)b * 4 + h) * 65536 + (size_t)(4 * hl) * 256 + 32 * wave + c31;
#pragma unroll
        for (int kt = 0; kt < 8; ++kt)
#pragma unroll
            for (int i = 0; i < 16; ++i) CP[(size_t)(32 * kt + ACCROW0(i)) * 256] = acc[kt][i] * fs;
        if (tid < 256) a.out[O_NP + ((size_t)b * 4 + h) * 256 + tid] = *LDSP(const float, ON + tid * 4) * fs;
        if (tid == 0) a.out[O_MP + b * 4 + h] = mrun;
    }
    __syncthreads();
#undef ML_ISSUE
#undef ML_DMA_TILE
}

__device__ __forceinline__ void p3b_sample_hgrn(const Args& a, LAS unsigned char* lds, int b, int h, int tid, int wave, int lane) {
    LAS float* sq = (LAS float*)lds; LAS float* sf = sq + 512; LAS float* sk = sf + 512; LAS float* sv = sk + 512;
    LAS float* sPO = sv + 512;
    const bf16_t* PROJ = (const bf16_t*)(a.ws + WS_PROJ) + PS_OFF - (size_t)MP * NPROJ;   const float* LOGFS = (const float*)(a.ws + WS_LOGFS);
    const size_t rb = (size_t)MP + (size_t)b * 4;
    const int vq = tid & 31, kr = tid >> 5;
    const float* S0 = a.st_h + ((size_t)b * 8 + h) * 16384; float* S1 = a.out + O_HS + ((size_t)b * 8 + h) * 16384;
    f32x4 S[8];
#pragma unroll
    for (int i = 0; i < 8; ++i) S[i] = __builtin_nontemporal_load((const f32x4*)(S0 + (size_t)(kr + 16 * i) * 128 + 4 * vq));
    __syncthreads();
    { const int t = tid >> 7, k = tid & 127; const float f = __expf(LOGFS[((size_t)b * 4 + t) * 1024 + h * 128 + k]);
      sf[tid] = f; sk[tid] = 1.f - f; sq[tid] = bf2f(PROJ[(rb + t) * NPROJ + h * 128 + k]); sv[tid] = bf2f(PROJ[(rb + t) * NPROJ + 2048 + h * 128 + k]); }
    __syncthreads();
    f32x4 vv[4], po[4];
#pragma unroll
    for (int t = 0; t < 4; ++t) { vv[t] = *(const LAS f32x4*)(sv + t * 128 + 4 * vq); po[t] = (f32x4){0.f, 0.f, 0.f, 0.f}; }
#pragma unroll
    for (int i = 0; i < 8; ++i) { const int k = kr + 16 * i;
#pragma unroll
        for (int t = 0; t < 4; ++t) { S[i] = S[i] * sf[t * 128 + k] + vv[t] * sk[t * 128 + k]; po[t] += S[i] * sq[t * 128 + k]; }
        __builtin_nontemporal_store(S[i], (f32x4*)(S1 + (size_t)k * 128 + 4 * vq)); }
#pragma unroll
    for (int t = 0; t < 4; ++t) *(LAS f32x4*)(sPO + (kr * 4 + t) * 128 + 4 * vq) = po[t];
    __syncthreads();
    if (wave < 4) { const int t = wave; float o[2]; float ss = 0.f;
#pragma unroll
        for (int j = 0; j < 2; ++j) { const int v = lane + 64 * j; float s = 0.f;
#pragma unroll
            for (int r = 0; r < 16; ++r) s += sPO[(r * 4 + t) * 128 + v];
            o[j] = s; ss += s * s; }
        ss = wave_sum(ss); const float rn = 1.0f / sqrtf(ss * (1.f / 128.f) + EPS);
#pragma unroll
        for (int j = 0; j < 2; ++j) { const int col = h * 128 + lane + 64 * j;
            const float z = bf2f(PROJ[(rb + t) * NPROJ + 3072 + col]);
            ((bf16_t*)(a.ws + WS_MIX))[(rb + t) * DMIX + col] = f2bf(o[j] * rn * a.hnorm_g[col] * z); }
    }
}
__device__ __forceinline__ void p3b_sample_hgrn4(const Args& a, LAS unsigned char* lds, int b, int hq, int tid, int wave, int lane) {
    LAS float* sT = (LAS float*)lds;
    LAS float* sPO = sT + 8192;
    const bf16_t* PROJ = (const bf16_t*)(a.ws + WS_PROJ) + PS_OFF - (size_t)MP * NPROJ; const float* LOGFS = (const float*)(a.ws + WS_LOGFS);
    const size_t rb = (size_t)MP + (size_t)b * 4;
    const int vq = tid & 31, kr = tid >> 5, h0 = 4 * hq;
    const float* S0 = a.st_h + ((size_t)b * 8 + h0) * 16384; float* S1 = a.out + O_HS + ((size_t)b * 8 + h0) * 16384;
    f32x4 S[8], Sn[8];
#pragma unroll
    for (int i = 0; i < 8; ++i) S[i] = __builtin_nontemporal_load((const f32x4*)(S0 + (size_t)(kr + 16 * i) * 128 + 4 * vq));
    float lf[4], qv[4], vvv[4], zr[4][2], gr[4][2];
    { const int t = tid >> 7, k = tid & 127;
#pragma unroll
      for (int hh = 0; hh < 4; ++hh) { const int col = (h0 + hh) * 128 + k;
          lf[hh] = LOGFS[((size_t)b * 4 + t) * 1024 + col]; qv[hh] = bf2f(PROJ[(rb + t) * NPROJ + col]); vvv[hh] = bf2f(PROJ[(rb + t) * NPROJ + 2048 + col]); } }
    { const int t = wave & 3;
#pragma unroll
      for (int hh = 0; hh < 4; ++hh)
#pragma unroll
          for (int j = 0; j < 2; ++j) { const int col = (h0 + hh) * 128 + lane + 64 * j; zr[hh][j] = bf2f(PROJ[(rb + t) * NPROJ + 3072 + col]); gr[hh][j] = a.hnorm_g[col]; } }
    __syncthreads();
#pragma unroll
    for (int hh = 0; hh < 4; ++hh) { const float f = __expf(lf[hh]); LAS float* p = sT + hh * 2048 + tid;
        p[0] = qv[hh]; p[512] = f; p[1024] = 1.f - f; p[1536] = vvv[hh]; }
    __syncthreads();
#pragma unroll
    for (int hh = 0; hh < 4; ++hh) {
        const LAS float* sq = sT + hh * 2048; const LAS float* sf = sq + 512; const LAS float* sk = sf + 512; const LAS float* sv = sk + 512;
        LAS float* po_ = sPO + (hh & 1) * 8192;
        if (hh < 3) {
#pragma unroll
            for (int i = 0; i < 8; ++i) Sn[i] = __builtin_nontemporal_load((const f32x4*)(S0 + (size_t)(hh + 1) * 16384 + (size_t)(kr + 16 * i) * 128 + 4 * vq));
        }
        f32x4 vv[4], po[4];
#pragma unroll
        for (int t = 0; t < 4; ++t) { vv[t] = *(const LAS f32x4*)(sv + t * 128 + 4 * vq); po[t] = (f32x4){0.f, 0.f, 0.f, 0.f}; }
#pragma unroll
        for (int i = 0; i < 8; ++i) { const int k = kr + 16 * i;
#pragma unroll
            for (int t = 0; t < 4; ++t) { S[i] = S[i] * sf[t * 128 + k] + vv[t] * sk[t * 128 + k]; po[t] += S[i] * sq[t * 128 + k]; }
            __builtin_nontemporal_store(S[i], (f32x4*)(S1 + (size_t)hh * 16384 + (size_t)k * 128 + 4 * vq)); }
#pragma unroll
        for (int t = 0; t < 4; ++t) *(LAS f32x4*)(po_ + (kr * 4 + t) * 128 + 4 * vq) = po[t];
        __syncthreads();
        if (wave < 4) { const int t = wave; float o[2]; float ss = 0.f;
#pragma unroll
            for (int j = 0; j < 2; ++j) { const int v = lane + 64 * j; float s_ = 0.f;
#pragma unroll
                for (int r = 0; r < 16; ++r) s_ += po_[(r * 4 + t) * 128 + v];
                o[j] = s_; ss += s_ * s_; }
            ss = wave_sum(ss); const float rn = 1.0f / sqrtf(ss * (1.f / 128.f) + EPS);
#pragma unroll
            for (int j = 0; j < 2; ++j) { const int col = (h0 + hh) * 128 + lane + 64 * j;
                ((bf16_t*)(a.ws + WS_MIX))[(rb + t) * DMIX + col] = f2bf(o[j] * rn * gr[hh][j] * zr[hh][j]); }
        }
        if (hh < 3) {
#pragma unroll
            for (int i = 0; i < 8; ++i) S[i] = Sn[i];
        }
    }
}
__device__ __forceinline__ void p3b_sample_mlstm(const Args& a, LAS unsigned char* lds, int b, int h, int tid, int wave, int lane) {
    LAS float* sxc = (LAS float*)lds; LAS float* sq = sxc + 1024; LAS float* sk = sq + 1024; LAS float* sv = sk + 1024;
    LAS float* sDen = sv + 1024;
    LAS float* sPN = sDen + 16;
    const bf16_t* PROJ = (const bf16_t*)(a.ws + WS_PROJ) + PS_OFF - (size_t)MP * NPROJ;   const float* GATE = (const float*)(a.ws + WS_GATE);
    const size_t rb = (size_t)MP + (size_t)b * 4;
    const int vq = tid & 63, kr = tid >> 6;
    const float* C0 = a.st_C + ((size_t)b * 4 + h) * 65536; float* C1 = a.out + O_CS + ((size_t)b * 4 + h) * 65536;
    f32x4 Ca[8], Cb[8];
#pragma unroll
    for (int i = 0; i < 8; ++i) { Ca[i] = __builtin_nontemporal_load((const f32x4*)(C0 + (size_t)(kr + 8 * i) * 256 + 4 * vq)); Cb[i] = __builtin_nontemporal_load((const f32x4*)(C0 + (size_t)(kr + 8 * (8 + i)) * 256 + 4 * vq)); }
    __syncthreads();
    if (tid < 256) {
        const int t = tid >> 6, g = tid & 63, ch = h * 256 + 4 * g, gg = h * 64 + g;
        float e[4][4];
#pragma unroll
        for (int w = 0; w < 4; ++w) { const int idx = t + w;
            if (idx < 3) { const f32x4 x = *(const f32x4*)(a.st_conv + ((size_t)b * 3 + idx) * 1024 + ch); e[w][0] = x.x; e[w][1] = x.y; e[w][2] = x.z; e[w][3] = x.w; }
            else { const u32x2 x = *(const u32x2*)(PROJ + (rb + idx - 3) * NPROJ + 4096 + ch); e[w][0] = bflo(x.x); e[w][1] = bfhi(x.x); e[w][2] = bflo(x.y); e[w][3] = bfhi(x.y); } }
        float xc[4];
#pragma unroll
        for (int i = 0; i < 4; ++i) { float cv = a.conv_b[ch + i];
#pragma unroll
            for (int w = 0; w < 4; ++w) cv += a.conv_w[w * 1024 + ch + i] * e[w][i];
            xc[i] = cv * sigmoidf_(cv); }
#pragma unroll
        for (int j = 0; j < 4; ++j) { float q = 0.f, k = 0.f, v = 0.f;
#pragma unroll
            for (int i = 0; i < 4; ++i) { q += xc[i] * a.wq[gg * 16 + 4 * i + j]; k += xc[i] * a.wk[gg * 16 + 4 * i + j]; v += e[3][i] * a.wv[gg * 16 + 4 * i + j]; }
            sxc[t * 256 + 4 * g + j] = xc[j]; sq[t * 256 + 4 * g + j] = q; sk[t * 256 + 4 * g + j] = k * 0.0625f; sv[t * 256 + 4 * g + j] = v; }
        if (t == 3) {
#pragma unroll
            for (int j = 0; j < 3; ++j) *(f32x4*)(a.out + O_VS + ((size_t)b * 3 + j) * 1024 + ch) = (f32x4){e[1 + j][0], e[1 + j][1], e[1 + j][2], e[1 + j][3]};
        }
    }
    float fd[4], iw[4], mt[4];
    { float m = a.st_m[b * 4 + h];
#pragma unroll
      for (int t = 0; t < 4; ++t) { const float ig = GATE[(rb + t) * 8 + h], lf = GATE[(rb + t) * 8 + 4 + h]; const float mn = fmaxf(lf + m, ig);
          fd[t] = __expf(lf + m - mn); iw[t] = __expf(ig - mn); mt[t] = mn; m = mn; } }
    __syncthreads();
    if (tid < 256) { float n = a.st_n[((size_t)b * 4 + h) * 256 + tid]; float pd[4];
#pragma unroll
        for (int t = 0; t < 4; ++t) { n = fd[t] * n + iw[t] * sk[t * 256 + tid]; pd[t] = sq[t * 256 + tid] * n; }
        a.out[O_NS + ((size_t)b * 4 + h) * 256 + tid] = n;
#pragma unroll
        for (int t = 0; t < 4; ++t) { const float s = wave_sum(pd[t]); if (lane == 0) sDen[wave * 4 + t] = s; } }
    f32x4 vv[4], pn[4];
#pragma unroll
    for (int t = 0; t < 4; ++t) { vv[t] = *(const LAS f32x4*)(sv + t * 256 + 4 * vq) * iw[t]; pn[t] = (f32x4){0.f, 0.f, 0.f, 0.f}; }
#define SM_BATCH(C, bi, reload) do { \
        _Pragma("unroll") for (int i = 0; i < 8; ++i) { const int k = kr + 8 * (8 * (bi) + i); \
            _Pragma("unroll") for (int t = 0; t < 4; ++t) { C[i] = C[i] * fd[t] + vv[t] * sk[t * 256 + k]; pn[t] += C[i] * sq[t * 256 + k]; } \
            __builtin_nontemporal_store(C[i], (f32x4*)(C1 + (size_t)k * 256 + 4 * vq)); \
            if (reload) C[i] = __builtin_nontemporal_load((const f32x4*)(C0 + (size_t)(kr + 8 * (8 * ((bi) + 2) + i)) * 256 + 4 * vq)); } } while (0)
    SM_BATCH(Ca, 0, true); SM_BATCH(Cb, 1, true); SM_BATCH(Ca, 2, false); SM_BATCH(Cb, 3, false);
#undef SM_BATCH
#pragma unroll
    for (int t = 0; t < 4; ++t) *(LAS f32x4*)(sPN + (kr * 4 + t) * 256 + 4 * vq) = pn[t];
    __syncthreads();
    if (wave < 4) { const int t = wave;
        const float den = sDen[t] + sDen[4 + t] + sDen[8 + t] + sDen[12 + t];
        const float hden = fmaxf(fabsf(den), __expf(-mt[t]));
        float hm[4]; float ss = 0.f;
#pragma unroll
        for (int j = 0; j < 4; ++j) { const int v = lane + 64 * j; float s = 0.f;
#pragma unroll
            for (int r = 0; r < 8; ++r) s += sPN[(r * 4 + t) * 256 + v];
            hm[j] = s / hden * bf2f(PROJ[(rb + t) * NPROJ + 6144 + h * 256 + v]); ss += hm[j] * hm[j]; }
        ss = wave_sum(ss); const float rn = 1.0f / sqrtf(ss * (1.f / 256.f) + EPS);
#pragma unroll
        for (int j = 0; j < 4; ++j) { const int v = lane + 64 * j, col = h * 256 + v;
            const float z = bf2f(PROJ[(rb + t) * NPROJ + 5120 + col]);
            ((bf16_t*)(a.ws + WS_MIX))[(rb + t) * DMIX + 1024 + col] = f2bf((hm[j] * rn * a.mnorm_g[col] + a.skip[col] * sxc[t * 256 + v]) * z); }
        if (t == 3 && lane == 0) a.out[O_MS + b * 4 + h] = mt[3];
    }
}

typedef float f32x4v __attribute__((ext_vector_type(4)));
__device__ __forceinline__ void small_gemm_out(const Args& a, int vcu, int G, int wave, int lane, unsigned* cnt_s) {
    const bf16_t* MIX = (const bf16_t*)(a.ws + WS_MIX); const bf16_t* WoutT = (const bf16_t*)(a.ws + WS_WOUT); const float* MOD = (const float*)(a.ws + WS_MOD);
    const int r = lane & 15, kq = lane >> 4;
    for (int t = vcu * NWAVES + wave; t < 32 * 64; t += G * NWAVES) {
        const int mt = t >> 6, nt = t & 63;
        const bf16_t* ap = MIX + (size_t)(MP + 16 * mt + r) * DMIX + 8 * kq;
        const bf16_t* bp = WoutT + (size_t)(16 * nt + r) * DMIX + 8 * kq;
        f32x4v acc = {0.f, 0.f, 0.f, 0.f};
        bf16x8 af[8], bfr[8], an[8], bn[8];
#pragma unroll
        for (int j = 0; j < 8; ++j) { af[j] = *(const bf16x8*)(ap + 32 * j); bfr[j] = *(const bf16x8*)(bp + 32 * j); }
#pragma unroll 1
        for (int k0 = 0; k0 < DMIX; k0 += 512) {
#pragma unroll
            for (int j = 0; j < 8; ++j) { an[j] = *(const bf16x8*)(ap + k0 + 256 + 32 * j); bn[j] = *(const bf16x8*)(bp + k0 + 256 + 32 * j); }
#pragma unroll
            for (int j = 0; j < 8; ++j) acc = __builtin_amdgcn_mfma_f32_16x16x32_bf16(af[j], bfr[j], acc, 0, 0, 0);
            const int kn = (k0 + 512 < DMIX) ? k0 + 512 : k0;
#pragma unroll
            for (int j = 0; j < 8; ++j) { af[j] = *(const bf16x8*)(ap + kn + 32 * j); bfr[j] = *(const bf16x8*)(bp + kn + 32 * j); }
#pragma unroll
            for (int j = 0; j < 8; ++j) acc = __builtin_amdgcn_mfma_f32_16x16x32_bf16(an[j], bn[j], acc, 0, 0, 0);
        }
        const int col = 16 * nt + r;
#pragma unroll
        for (int i = 0; i < 4; ++i) { const int row = 16 * mt + 4 * kq + i;
            const float g = MOD[(size_t)(BP + (row >> 2)) * 3072 + 2048 + col];
            const float v = a.x_s[(size_t)row * DM + col] + g * acc[i];
            if (cnt_s) store_wt_f32(a.out + O_Y + (size_t)(MP + row) * DM + col, v); else a.out[O_Y + (size_t)(MP + row) * DM + col] = v; }
        if (cnt_s) { asm volatile("s_waitcnt vmcnt(0)" ::: "memory"); if (lane == 0) (void)xb_add(cnt_s + 64 * mt, 1u); }
    }
}
__device__ __forceinline__ void rms_row_inplace(const Args& a, size_t r, int lane) {
    float* yr = a.out + O_Y + r * DM;
    f32x4 v[4]; float s = 0.f;
#pragma unroll
    for (int j = 0; j < 4; ++j) { v[j] = *(const f32x4*)(yr + 4 * lane + 256 * j); s += (v[j].x * v[j].x + v[j].y * v[j].y) + (v[j].z * v[j].z + v[j].w * v[j].w); }
    const float rinv = 1.0f / sqrtf(wave_sum(s) * (1.f / DM) + EPS);
#pragma unroll
    for (int j = 0; j < 4; ++j) { const f32x4 g = *(const f32x4*)(a.final_g + 4 * lane + 256 * j); *(f32x4*)(yr + 4 * lane + 256 * j) = v[j] * rinv * g; }
}

__device__ __forceinline__ void phase5(const Args& a, int vcu, int G, int wave, int lane) {
    const int gw = vcu * NWAVES + wave, NGW = G * NWAVES;
    f32x4 nx[4];
    if (gw < MT) {
#pragma unroll
        for (int j = 0; j < 4; ++j) nx[j] = *(const f32x4*)(a.out + O_Y + (size_t)gw * DM + 4 * lane + 256 * j);
    }
    f32x4 g[4];
#pragma unroll
    for (int j = 0; j < 4; ++j) g[j] = *(const f32x4*)(a.final_g + 4 * lane + 256 * j);
    for (int r = gw; r < MT; r += NGW) {
        float* yr = a.out + O_Y + (size_t)r * DM;
        f32x4 v[4]; float s = 0.f;
#pragma unroll
        for (int j = 0; j < 4; ++j) { v[j] = nx[j]; s += (v[j].x * v[j].x + v[j].y * v[j].y) + (v[j].z * v[j].z + v[j].w * v[j].w); }
        if (r + NGW < MT) {
#pragma unroll
            for (int j = 0; j < 4; ++j) nx[j] = *(const f32x4*)(yr + (size_t)NGW * DM + 4 * lane + 256 * j);
        }
        const float rinv = 1.0f / sqrtf(wave_sum(s) * (1.f / DM) + EPS);
#pragma unroll
        for (int j = 0; j < 4; ++j) *(f32x4*)(yr + 4 * lane + 256 * j) = v[j] * rinv * g[j];
    }
}

__global__ void __launch_bounds__(NTHR, 2) mk_fwd(Args a) {
    extern __shared__ __attribute__((aligned(16))) unsigned char lds_raw[];
    LAS unsigned char* lds = (LAS unsigned char*)lds_raw;
    volatile LAS unsigned* MISC = (volatile LAS unsigned*)(lds + MISC_OFF);
    int tid = threadIdx.x, lane = tid & 63, wave = __builtin_amdgcn_readfirstlane(tid >> 6);
#define RELAUNDER() do { asm volatile("" : "+v"(tid)); lane = tid & 63; wave = __builtin_amdgcn_readfirstlane(tid >> 6); } while (0)
    const int G = gridDim.x; const int bx = blockIdx.x; const int vcu = (G % 8 == 0) ? (bx % 8) * (G / 8) + bx / 8 : bx;
    for (int u = tid; u < (LDS_BYTES - MISC_OFF) / 4; u += NTHR) ((LAS unsigned*)(lds + MISC_OFF))[u] = 0u;
    __syncthreads();
    XcdBarrier bar = xcd_barrier_post((unsigned*)(a.ws + WS_CTL) + CW_BAR, MISC + 8);

    phase0(a, lds, vcu, G, tid, wave, lane);
    xcd_barrier(bar); RELAUNDER();
    phase1(a, lds, vcu, G, tid, wave, lane);
    xcd_barrier(bar); RELAUNDER();
    {
        pg8::Gemm g{(const bf16_t*)(a.ws + WS_XN), (const bf16_t*)(a.ws + WS_WIN), MT, NPROJ, DM};
        pg8::StaticOrder S; S.init(MT, NPROJ, G, bx);
        EpiProj E{(bf16_t*)(a.ws + WS_PROJ), (float*)(a.ws + WS_LOGF), (float*)(a.ws + WS_LOGFS), a.b_in, a.lb_logits};
        pg8::gemm_phase<EpiProj, pg8::StaticOrder, true, true>(lds, g, S, E);
    }
    xcd_barrier(bar); RELAUNDER();
    for (int t = vcu; t < 3072; t += G) {
        RELAUNDER();
        const int tn = -1;
        if (t < 1024) p3a_mlstm(a, lds, t >> 7, (t >> 2) & 31, t & 3, tid, wave, lane, tn);
        else { const int u = t - 1024; p3a_hgrn(a, lds, u >> 8, (u >> 3) & 31, u & 7, tid, wave, lane, tn); }
    }
    xcd_barrier(bar); RELAUNDER();
    const int rid = bx;
    if (rid < 96) p3b_mlstm<0>(a, lds, rid / 12, (rid / 3) & 3, rid % 3, tid, wave, lane);
    else if (rid < 192) { const int u = rid - 96; p3b_hgrn<0>(a, lds, u / 12, (u / 3) & 3, u % 3, tid, wave, lane);
        RELAUNDER(); { const int t = 128 + u; p3b_sample_mlstm(a, lds, t >> 2, t & 3, tid, wave, lane); } }
    else {
        for (int k = 0; k < 2; ++k) { RELAUNDER(); const int t = (rid - 192) * 2 + k; p3b_sample_mlstm(a, lds, t >> 2, t & 3, tid, wave, lane); }
    }
    xcd_barrier(bar); RELAUNDER();
    if (rid < 128) p3b_mlstm<1>(a, lds, rid >> 4, (rid >> 2) & 3, rid & 3, tid, wave, lane);
    else { const int u = rid - 128; p3b_hgrn<1>(a, lds, u >> 4, (u >> 2) & 3, u & 3, tid, wave, lane); }
    for (;;) {
        RELAUNDER();
        __syncthreads();
        if (tid == 0) MISC[16] = 224u + __hip_atomic_fetch_add((unsigned*)(a.ws + WS_CTL) + CW_QUEUE, 1u, __ATOMIC_RELAXED, __HIP_MEMORY_SCOPE_AGENT);
        __syncthreads();
        const int t = (int)MISC[16];
        if (t >= 768) break;
        if (t < 512) p3b_sample_mlstm(a, lds, t >> 2, t & 3, tid, wave, lane);
        else { const int u = t - 512; p3b_sample_hgrn4(a, lds, u >> 1, u & 1, tid, wave, lane); }
    }
    xcd_barrier(bar); RELAUNDER();
    {
        pg8::Gemm g{(const bf16_t*)(a.ws + WS_MIX), (const bf16_t*)(a.ws + WS_WOUT), MP, DM, DMIX};
        pg8::StaticOrder S; S.init(MP, DM, G, bx);
        unsigned* ctl = (unsigned*)(a.ws + WS_CTL);
        if (G == 256) {
            EpiOutFused E{a.out + O_Y, a.x_p, (const float*)(a.ws + WS_MOD), a.final_g, (float*)(a.ws + WS_STATS), ctl + CW_PANEL};
            pg8::gemm_phase<EpiOutFused, pg8::StaticOrder, true, true>(lds, g, S, E);
            small_gemm_out(a, vcu, G, wave, lane, ctl + CW_SROW);
            { const int t = vcu * NWAVES + wave;
              if ((t & 3) == 0) { unsigned* cs = ctl + CW_SROW + 64 * (t >> 6); unsigned sp = 0;
                  while (xb_ld(cs) < 64u) { __builtin_amdgcn_s_sleep(1); if (++sp > (1u << 20)) break; }
                  __builtin_amdgcn_fence(__ATOMIC_ACQUIRE, "agent"); asm volatile("s_waitcnt vmcnt(0)" ::: "memory");
                  rms_row_inplace(a, (size_t)MP + (t >> 2), lane); } }
        } else {
            EpiOut E{a.out + O_Y, a.x_p, a.x_s, (const float*)(a.ws + WS_MOD)};
            pg8::gemm_phase<EpiOut, pg8::StaticOrder, true, true>(lds, g, S, E);
            small_gemm_out(a, vcu, G, wave, lane, nullptr);
            xcd_barrier(bar); RELAUNDER();
            phase5(a, vcu, G, wave, lane);
        }
    }
}

extern "C" void kernel_launch(void* const* d_in, const int* in_sizes, int n_in, void* d_out, int out_size, void* d_ws, size_t ws_size, hipStream_t stream) {
    static int grid = 0;
    if (grid == 0) {
        if (n_in != 25 || (size_t)out_size != O_END || ws_size < WS_END2) { fprintf(stderr, "kernel_launch: unexpected shapes: n_in %d out %d (want %zu) ws %zu (want %zu)\n", n_in, out_size, (size_t)O_END, ws_size, (size_t)WS_END); grid = -1; return; }
        int dev = 0, cus = 0, per_cu = 0;
        if (hipGetDevice(&dev) != hipSuccess || hipDeviceGetAttribute(&cus, hipDeviceAttributeMultiprocessorCount, dev) != hipSuccess) { grid = -1; return; }
        if (hipFuncSetAttribute((const void*)mk_fwd, hipFuncAttributeMaxDynamicSharedMemorySize, LDS_BYTES) != hipSuccess) { fprintf(stderr, "hipFuncSetAttribute failed\n"); grid = -1; return; }
        if (hipOccupancyMaxActiveBlocksPerMultiprocessor(&per_cu, (const void*)mk_fwd, NTHR, LDS_BYTES) != hipSuccess || per_cu < 1) { fprintf(stderr, "occupancy query: %d\n", per_cu); grid = -1; return; }
        (void)hipGetLastError();
        grid = cus;
    }
    if (grid < 0) return;
    (void)hipMemsetAsync((char*)d_ws + WS_CTL, 0, CTL_ZERO_BYTES, stream);
    Args a{};
    const float** ap = (const float**)&a;
    for (int i = 0; i < 25; ++i) ap[i] = (const float*)d_in[i];
    a.out = (float*)d_out; a.ws = (unsigned char*)d_ws;
    void* args[] = {&a};
    hipError_t e = hipLaunchCooperativeKernel((const void*)mk_fwd, dim3(grid), dim3(NTHR), args, LDS_BYTES, stream);
    if (e != hipSuccess) fprintf(stderr, "cooperative launch failed: %s (grid %d)\n", hipGetErrorString(e), grid);
}
```

```cpp
#include <hip/hip_runtime.h>
#include <cstdio>
#include <cstdint>

#define LAS __attribute__((address_space(3)))
typedef unsigned short bf16_t;
typedef short bf16x8 __attribute__((ext_vector_type(8)));
typedef short s16x4 __attribute__((ext_vector_type(4)));
typedef float f32x4 __attribute__((ext_vector_type(4)));
typedef float f32x16 __attribute__((ext_vector_type(16)));
typedef unsigned u32x4 __attribute__((ext_vector_type(4)));
typedef unsigned u32x2 __attribute__((ext_vector_type(2)));

namespace pg8 {
constexpr int BM = 256, BK = 64, HALF = 128, HTB = HALF * BK * 2, STAGE_BYTES = 8 * HTB, NXCD = 8, WGM = 8;
__host__ __device__ __forceinline__ int lds_byte(int r, int c) { const int st = (r >> 4) * 2 + (c >> 5), rr = r & 15, cc = c & 31, ob = rr * 64 + cc * 2; return st * 1024 + (ob ^ (((ob >> 9) & 1) << 5)); }
__host__ __device__ __forceinline__ void stage_rc(int b, int& R, int& C) { const int st = b / 1024, sb = b % 1024, swz = sb ^ (((sb >> 9) & 1) << 5); R = (st >> 1) * 16 + swz / 64; C = (st & 1) * 32 + (swz % 64) / 2; }
__host__ __device__ __forceinline__ int perm32(int rho) { const int n = rho >> 4, i = rho & 15; return 8 * (i >> 2) + 4 * n + (i & 3); }
struct Unit { int pm, pn; };
struct Gemm { const bf16_t* A; const bf16_t* Bt; int M, N, K; };
struct StaticOrder {
    int nM, nN, nwg, G, c;
    __host__ __device__ void init(int M, int N, int G_, int c_) { nM = M / BM; nN = N / BM; nwg = nM * nN; G = G_; c = c_; }
    __host__ __device__ bool next(int i, Unit& u) const {
        const long L = (long)i * G + c; if (L >= nwg) return false;
        int wgid = (int)L; { const int q = nwg / NXCD, r = nwg % NXCD, xcd = wgid % NXCD, off = wgid / NXCD; wgid = (xcd < r ? xcd * (q + 1) : r * (q + 1) + (xcd - r) * q) + off; }
        const int nig = WGM * nN, gid = wgid / nig, fm = gid * WGM, gsz = (nM - fm) < WGM ? (nM - fm) : WGM;
        u.pm = fm + ((wgid % nig) % gsz); u.pn = (wgid % nig) / gsz; return true;
    }
};
template <class Epi, class Sched, bool ALIGN_EPI = false, bool SP2 = false>
__device__ __forceinline__ void gemm_phase(LAS unsigned char* lds, const Gemm g, const Sched& S, const Epi& E) {
    const int tid = threadIdx.x, wid = __builtin_amdgcn_readfirstlane(tid >> 6), lane = tid & 63, wr = wid >> 2, wc = wid & 3, fr = lane & 15, fq = lane >> 4;
    const int K = g.K, nt = K / BK;
    unsigned voffA[2], voffB[2];
#pragma unroll
    for (int i = 0; i < 2; ++i) { int R, C; stage_rc(tid * 16 + i * 8192, R, C); const int Rb = Epi::PERM ? ((R & ~31) + perm32(R & 31)) : R;
        voffA[i] = (unsigned)(R * K + C) * 2u; voffB[i] = (unsigned)(Rb * K + C) * 2u; }
    const size_t kstep = (size_t)(BK * 2);
    const size_t hstep = (size_t)HALF * K * 2;
    const size_t tstep = 2 * hstep;
    const unsigned ldsw = (unsigned)wid * 1024u;
    const int aoff = lds_byte(wr * 64 + fr, fq * 8), boff = lds_byte(wc * 32 + fr, fq * 8);
#define PG8_SA(b, h) (((b) * 2 + (h)) * HTB)
#define PG8_SB(b, h) ((4 + (b) * 2 + (h)) * HTB)
#define PG8_STAGE(bufoff, gbase, voff) do { _Pragma("unroll") for (int _i = 0; _i < 2; ++_i) \
        __builtin_amdgcn_global_load_lds((const unsigned*)((const char*)(gbase) + (voff)[_i]), (LAS unsigned*)(lds + (bufoff) + ldsw + _i * 8192), 16, 0, 0); } while (0)
#define PG8_LDA(dst, b, h) do { _Pragma("unroll") for (int m = 0; m < 4; ++m) _Pragma("unroll") for (int k = 0; k < 2; ++k) dst[m][k] = *(const LAS bf16x8*)(lds + PG8_SA(b, h) + aoff + m * 2048 + k * 1024); } while (0)
#define PG8_LDB(dst, b, h) do { _Pragma("unroll") for (int n = 0; n < 2; ++n) _Pragma("unroll") for (int k = 0; k < 2; ++k) dst[n][k] = *(const LAS bf16x8*)(lds + PG8_SB(b, h) + boff + n * 2048 + k * 1024); } while (0)
#define PG8_MMA(ai, bj, At, Bt) do { __builtin_amdgcn_s_setprio(1); _Pragma("unroll") for (int m = 0; m < 4; ++m) _Pragma("unroll") for (int n = 0; n < 2; ++n) _Pragma("unroll") for (int k = 0; k < 2; ++k) \
        acc[ai][bj][m][n] = __builtin_amdgcn_mfma_f32_16x16x32_bf16(Bt[n][k], At[m][k], acc[ai][bj][m][n], 0, 0, 0); __builtin_amdgcn_s_setprio(0); } while (0)
#define PG8_WAIT_V(n) asm volatile("s_waitcnt vmcnt(" #n ")" ::: "memory")
#define PG8_WAIT_L(n) asm volatile("s_waitcnt lgkmcnt(" #n ")" ::: "memory")
#define PG8_BAR __builtin_amdgcn_s_barrier()
#define PG8_SCHED __builtin_amdgcn_sched_barrier(0)
    Unit cur, nxt; int ui = 0;
    if (!S.next(0, cur)) return;
    f32x4 acc[2][2][4][2];
#pragma unroll
    for (int a = 0; a < 2; ++a)
#pragma unroll
        for (int b = 0; b < 2; ++b)
#pragma unroll
            for (int m = 0; m < 4; ++m)
#pragma unroll
                for (int n = 0; n < 2; ++n) acc[a][b][m][n] = (f32x4){0.f, 0.f, 0.f, 0.f};
    bf16x8 At[4][2], B0[2][2], B1[2][2];
    const char* cA = (const char*)g.A + (size_t)cur.pm * tstep; const char* cB = (const char*)g.Bt + (size_t)cur.pn * tstep;
    if constexpr (SP2) {
        PG8_STAGE(PG8_SB(0, 0), cB, voffB); PG8_STAGE(PG8_SB(0, 1), cB + hstep, voffB); PG8_STAGE(PG8_SA(0, 0), cA, voffA); PG8_STAGE(PG8_SA(0, 1), cA + hstep, voffA);
        if (wr == 1) PG8_BAR;
        PG8_WAIT_V(2); PG8_BAR;
        PG8_STAGE(PG8_SB(1, 0), cB + kstep, voffB); PG8_STAGE(PG8_SA(1, 0), cA + kstep, voffA); PG8_STAGE(PG8_SB(1, 1), cB + hstep + kstep, voffB);
        PG8_WAIT_V(6); PG8_BAR;
    } else {
        PG8_STAGE(PG8_SB(0, 0), cB, voffB); PG8_STAGE(PG8_SA(0, 0), cA, voffA); PG8_STAGE(PG8_SB(0, 1), cB + hstep, voffB); PG8_STAGE(PG8_SA(0, 1), cA + hstep, voffA);
        if (wr == 1) PG8_BAR;
        PG8_WAIT_V(4); PG8_BAR;
        PG8_STAGE(PG8_SB(1, 0), cB + kstep, voffB); PG8_STAGE(PG8_SA(1, 0), cA + kstep, voffA); PG8_STAGE(PG8_SB(1, 1), cB + hstep + kstep, voffB);
        PG8_WAIT_V(6); PG8_BAR;
    }
    for (;;) {
        const bool has_next = S.next(ui + 1, nxt);
        const char* nA = has_next ? (const char*)g.A + (size_t)nxt.pm * tstep : cA; const char* nB = has_next ? (const char*)g.Bt + (size_t)nxt.pn * tstep : cB;
        for (int t = 0; t < nt; t += 2) {
            const bool last = (t == nt - 2);
            const char* a1 = cA + (size_t)(t + 1) * kstep;
            const char* a2 = last ? nA : cA + (size_t)(t + 2) * kstep; const char* b2 = last ? nB : cB + (size_t)(t + 2) * kstep;
            const char* a3 = a2 + kstep; const char* b3 = b2 + kstep;
            if constexpr (SP2) {
            PG8_LDB(B0, 0, 0); PG8_LDB(B1, 0, 1); PG8_SCHED; PG8_LDA(At, 0, 0); PG8_STAGE(PG8_SA(1, 1), a1 + hstep, voffA);
            PG8_WAIT_V(8); PG8_WAIT_L(0); PG8_BAR; PG8_MMA(0, 0, At, B0); PG8_MMA(0, 1, At, B1); PG8_BAR; PG8_SCHED;
            PG8_LDA(At, 0, 1); PG8_STAGE(PG8_SB(0, 0), b2, voffB); PG8_STAGE(PG8_SB(0, 1), b2 + hstep, voffB); PG8_STAGE(PG8_SA(0, 0), a2, voffA);
            PG8_WAIT_V(8); PG8_WAIT_L(0); PG8_BAR; PG8_MMA(1, 0, At, B0); PG8_MMA(1, 1, At, B1); PG8_BAR; PG8_SCHED;
            PG8_LDB(B0, 1, 0); PG8_LDB(B1, 1, 1); PG8_SCHED; PG8_LDA(At, 1, 0); PG8_STAGE(PG8_SA(0, 1), a2 + hstep, voffA);
            PG8_WAIT_V(8); PG8_WAIT_L(0); PG8_BAR; PG8_MMA(0, 0, At, B0); PG8_MMA(0, 1, At, B1); PG8_BAR; PG8_SCHED;
            PG8_LDA(At, 1, 1); PG8_STAGE(PG8_SB(1, 0), b3, voffB); PG8_STAGE(PG8_SB(1, 1), b3 + hstep, voffB); PG8_STAGE(PG8_SA(1, 0), a3, voffA);
            PG8_WAIT_V(8); PG8_WAIT_L(0); PG8_BAR; PG8_MMA(1, 0, At, B0); PG8_MMA(1, 1, At, B1); PG8_BAR; PG8_SCHED;
            } else {
            PG8_LDB(B0, 0, 0); PG8_SCHED; PG8_LDA(At, 0, 0); PG8_STAGE(PG8_SA(1, 1), a1 + hstep, voffA);
            PG8_WAIT_L(8); PG8_BAR; PG8_WAIT_L(0); PG8_MMA(0, 0, At, B0); PG8_BAR; PG8_SCHED;
            PG8_LDB(B1, 0, 1); PG8_STAGE(PG8_SB(0, 0), b2, voffB);
            PG8_BAR; PG8_WAIT_L(0); PG8_MMA(0, 1, At, B1); PG8_BAR;
            PG8_LDA(At, 0, 1); PG8_STAGE(PG8_SA(0, 0), a2, voffA);
            PG8_BAR; PG8_WAIT_L(0); PG8_MMA(1, 0, At, B0); PG8_BAR; PG8_SCHED;
            PG8_STAGE(PG8_SB(0, 1), b2 + hstep, voffB);
            PG8_WAIT_V(6); PG8_BAR; PG8_MMA(1, 1, At, B1); PG8_BAR;
            PG8_LDB(B0, 1, 0); PG8_SCHED; PG8_LDA(At, 1, 0); PG8_STAGE(PG8_SA(0, 1), a2 + hstep, voffA);
            PG8_WAIT_L(8); PG8_BAR; PG8_WAIT_L(0); PG8_MMA(0, 0, At, B0); PG8_BAR; PG8_SCHED;
            PG8_LDB(B1, 1, 1); PG8_STAGE(PG8_SB(1, 0), b3, voffB);
            PG8_BAR; PG8_WAIT_L(0); PG8_MMA(0, 1, At, B1); PG8_BAR;
            PG8_LDA(At, 1, 1); PG8_STAGE(PG8_SA(1, 0), a3, voffA);
            PG8_BAR; PG8_WAIT_L(0); PG8_MMA(1, 0, At, B0); PG8_BAR; PG8_SCHED;
            PG8_STAGE(PG8_SB(1, 1), b3 + hstep, voffB);
            PG8_WAIT_V(6); PG8_BAR; PG8_MMA(1, 1, At, B1); PG8_BAR;
            }
        }
        if constexpr (ALIGN_EPI) { if (wr == 0) PG8_BAR; }
        if constexpr (!Epi::AFTER_DRAIN) E(acc, cur, wr, wc, fr, fq);
        if (!has_next) break;
#pragma unroll
        for (int a = 0; a < 2; ++a)
#pragma unroll
            for (int b = 0; b < 2; ++b)
#pragma unroll
                for (int m = 0; m < 4; ++m)
#pragma unroll
                    for (int n = 0; n < 2; ++n) acc[a][b][m][n] = (f32x4){0.f, 0.f, 0.f, 0.f};
        cur = nxt; cA = nA; cB = nB; ++ui;
        if constexpr (ALIGN_EPI) { if (wr == 1) PG8_BAR; }
    }
    PG8_WAIT_V(0);
    if constexpr (!ALIGN_EPI) { if (wr == 0) PG8_BAR; }
    PG8_BAR;
    if constexpr (Epi::AFTER_DRAIN) E.fused(acc, cur, wr, wc, fr, fq, lds, wid, lane);
#undef PG8_SA
#undef PG8_SB
#undef PG8_STAGE
#undef PG8_LDA
#undef PG8_LDB
#undef PG8_MMA
#undef PG8_WAIT_V
#undef PG8_WAIT_L
#undef PG8_BAR
#undef PG8_SCHED
}
}

constexpr int NWAVES = 8, NTHR = 512;
constexpr int DM = 1024;
constexpr int BP = 8, TP = 2048, MP = BP * TP;
constexpr int BS = 128, TS = 4, MS = BS * TS;
constexpr int MT = MP + MS;
constexpr int NMOD = BP + BS;
constexpr int WIN_LD = 7176, NPROJ = 7168, DMIX = 2048;
constexpr int NCH = TP / 64;
constexpr float EPS = 1e-6f;

constexpr size_t SEGSZ = (size_t)MP * 1024;
constexpr size_t PS_OFF = 7 * SEGSZ;
__device__ __forceinline__ size_t hg_tile(int seg, int b, int c, int head) { return (size_t)seg * SEGSZ + ((size_t)((b * NCH + c) * 8 + head) << 13); }
__device__ __forceinline__ size_t ml_tile(int seg, int b, int c, int h) { return (size_t)seg * SEGSZ + ((size_t)((b * NCH + c) * 4 + h) << 14); }
constexpr size_t MiB = 1u << 20;
constexpr size_t WS_CTL = 0, CTL_ZERO_BYTES = 64 * 1024;
constexpr size_t WS_WIN = 2 * MiB;
constexpr size_t WS_WOUT = 16 * MiB;
constexpr size_t WS_MOD = 20 * MiB;
constexpr size_t WS_GATE = 22 * MiB;
constexpr size_t WS_DEC = 23 * MiB;
constexpr size_t WS_BT = 24 * MiB;
constexpr size_t WS_RS = 24 * MiB + 512 * 1024;
constexpr size_t WS_CSK = 25 * MiB;
constexpr size_t WS_RL = 26 * MiB;
constexpr size_t WS_GW = 26 * MiB + 64 * 1024;
constexpr size_t WS_LOGFS = 26 * MiB + 512 * 1024;
constexpr size_t WS_AH = 30 * MiB;
constexpr size_t WS_AM = 46 * MiB;
constexpr size_t WS_XN = 54 * MiB;
constexpr size_t WS_QM = WS_XN;
constexpr size_t WS_PROJ = 88 * MiB;
constexpr size_t WS_LOGF = 320 * MiB;
constexpr size_t WS_MIX = WS_LOGF;
constexpr size_t WS_KM = 388 * MiB, WS_VM = 420 * MiB, WS_XC = 452 * MiB;
constexpr size_t WS_END = 484 * MiB;
constexpr size_t O_Y = 0;
constexpr size_t O_HP = (size_t)MT * DM;
constexpr size_t O_CP = O_HP + (size_t)BP * 8 * 128 * 128;
constexpr size_t O_NP = O_CP + (size_t)BP * 4 * 256 * 256;
constexpr size_t O_MP = O_NP + (size_t)BP * 4 * 256;
constexpr size_t O_VP = O_MP + (size_t)BP * 4;
constexpr size_t O_HS = O_VP + (size_t)BP * 3 * 1024;
constexpr size_t O_CS = O_HS + (size_t)BS * 8 * 128 * 128;
constexpr size_t O_NS = O_CS + (size_t)BS * 4 * 256 * 256;
constexpr size_t O_MS = O_NS + (size_t)BS * 4 * 256;
constexpr size_t O_VS = O_MS + (size_t)BS * 4;
constexpr size_t O_END = O_VS + (size_t)BS * 3 * 1024;

constexpr int RING_BYTES = 131072, LDS_BYTES = 147456, MISC_OFF = LDS_BYTES - 1024;
constexpr int CW_BAR = 4096, CW_QUEUE = 2048, CW_PANEL = 8192, CW_SROW = 12288;

#define LDS_WAIT() asm volatile("s_waitcnt lgkmcnt(0)" ::: "memory")
__device__ __forceinline__ float bf2f(unsigned u16) { return __uint_as_float(u16 << 16); }
__device__ __forceinline__ float bflo(unsigned w) { return __uint_as_float(w << 16); }
__device__ __forceinline__ float bfhi(unsigned w) { return __uint_as_float(w & 0xffff0000u); }
typedef __bf16 bf16v2_t __attribute__((ext_vector_type(2)));
__device__ __forceinline__ unsigned pk2(float lo, float hi) { bf16v2_t v; v[0] = (__bf16)lo; v[1] = (__bf16)hi; return __builtin_bit_cast(unsigned, v); }
__device__ __forceinline__ bf16_t f2bf(float f) { return __builtin_bit_cast(bf16_t, (__bf16)f); }
__device__ __forceinline__ float wave_sum(float v) {
#pragma unroll
    for (int o = 1; o < 64; o <<= 1) v += __shfl_xor(v, o);
    return v;
}
__device__ __forceinline__ float sigmoidf_(float x) { return __builtin_amdgcn_rcpf(1.f + __expf(-x)); }

#define XB_TMO      128
#define XB_XCNT(j)  (256  + 64 * (j))
#define XB_XSUB(j)  (1280 + 64 * (j))
#define XB_XGEN(j)  (2304 + 64 * (j))
#define XB_TOP      3328
#define XB_TOPGEN   3392
#define XCD_BAR_WORDS 3456
#define XB_SPIN_CAP (1u << 18)
__device__ __forceinline__ unsigned xb_ld(unsigned* p)              { return __hip_atomic_load(p, __ATOMIC_RELAXED, __HIP_MEMORY_SCOPE_AGENT); }
__device__ __forceinline__ unsigned xb_add(unsigned* p, unsigned v) { return __hip_atomic_fetch_add(p, v, __ATOMIC_RELAXED, __HIP_MEMORY_SCOPE_AGENT); }
__device__ __forceinline__ unsigned xb_xcc_id() { return (unsigned)__builtin_amdgcn_s_getreg((3 << 11) | 20) & 0xFu; }
#define XB_SPIN(cond, bar) do { unsigned _sp = 0; while (cond) { __builtin_amdgcn_s_sleep(1); \
    if ((++_sp & 255u) == 0u) { if (xb_ld(&(bar)[XB_TMO])) break; if (_sp > XB_SPIN_CAP) { atomicAdd(&(bar)[XB_TMO], 1u); break; } } } } while (0)
struct XcdBarrier { unsigned* bar; unsigned x; volatile LAS unsigned* st; };
__device__ __forceinline__ XcdBarrier xcd_barrier_post(unsigned* bar, volatile LAS unsigned* st) {
    XcdBarrier b; b.bar = bar; b.x = xb_xcc_id(); b.st = st;
    if (threadIdx.x == 0) (void)xb_add(&bar[XB_XCNT(b.x)], 1u);
    return b;
}
__device__ __forceinline__ void xcd_barrier_complete(unsigned* bar, unsigned x, unsigned& nloc, unsigned& nx) {
    const unsigned G = gridDim.x * gridDim.y * gridDim.z;
    unsigned sum, cnt, mine, sp = 0u;
    for (;;) {
        sum = 0u; cnt = 0u; mine = 0u;
#pragma unroll
        for (unsigned j = 0; j < 16; ++j) { const unsigned c = xb_ld(&bar[XB_XCNT(j)]); sum += c; cnt += (c > 0u) ? 1u : 0u; mine = (j == x) ? c : mine; }
        if (sum == G) break;
        __builtin_amdgcn_s_sleep(1);
        if ((++sp & 255u) == 0u) { if (xb_ld(&bar[XB_TMO])) break; if (sp > XB_SPIN_CAP) { atomicAdd(&bar[XB_TMO], 1u); break; } }
    }
    nloc = mine > 0u ? mine : 1u; nx = cnt > 0u ? cnt : 1u;
}
__device__ __forceinline__ void xcd_barrier(const XcdBarrier& b) {
    asm volatile("s_waitcnt vmcnt(0)" ::: "memory");
    __syncthreads();
    if (threadIdx.x == 0) {
        unsigned* bar = b.bar;
        __builtin_amdgcn_s_waitcnt(0);
        unsigned nloc = b.st[0], nx = b.st[1];
        if (nloc == 0u) { xcd_barrier_complete(bar, b.x, nloc, nx); b.st[0] = nloc; b.st[1] = nx; }
        const unsigned old = xb_add(&bar[XB_XSUB(b.x)], 1u);
        const unsigned gen = old / nloc;
        if (old + 1u == (gen + 1u) * nloc) {
            __builtin_amdgcn_fence(__ATOMIC_RELEASE, "agent");
            asm volatile("s_waitcnt vmcnt(0)" ::: "memory");
            const unsigned og = xb_add(&bar[XB_TOP], 1u);
            const unsigned tg = og / nx;
            if (og + 1u == (tg + 1u) * nx) xb_add(&bar[XB_TOPGEN], 1u);
            else XB_SPIN(xb_ld(&bar[XB_TOPGEN]) == tg, bar);
            __builtin_amdgcn_fence(__ATOMIC_ACQUIRE, "agent");
            xb_add(&bar[XB_XGEN(b.x)], 1u);
            asm volatile("s_waitcnt vmcnt(0)" ::: "memory");
        } else {
            XB_SPIN(xb_ld(&bar[XB_XGEN(b.x)]) == gen, bar);
            __builtin_amdgcn_fence(__ATOMIC_ACQUIRE, "agent");
            asm volatile("s_waitcnt vmcnt(0)" ::: "memory");
        }
    }
    __syncthreads();
}

struct Args {
    const float *x_p, *x_s, *c_p, *c_s, *st_h, *st_C, *st_n, *st_m, *st_conv, *w_ada, *b_ada, *norm_g, *w_in, *b_in, *lb_logits, *hnorm_g,
                *conv_w, *conv_b, *wq, *wk, *wv, *mnorm_g, *skip, *w_out, *final_g;
    float* out; unsigned char* ws;
};

__device__ __forceinline__ void transposes(const Args& a, LAS unsigned char* lds, int vcu, int G, int tid, int wave, int lane);
__device__ __forceinline__ void phase1(const Args& a, LAS unsigned char* lds, int vcu, int G, int tid, int wave, int lane) {
    LAS float* sg = (LAS float*)lds;
    { const float* GW = (const float*)(a.ws + WS_GW); f32x4 tv[4];
#pragma unroll
      for (int i = 0; i < 4; ++i) tv[i] = *(const f32x4*)(GW + 4 * (tid + NTHR * i));
#pragma unroll
      for (int i = 0; i < 4; ++i) *(LAS f32x4*)(sg + 4 * (tid + NTHR * i)) = tv[i]; }
    __syncthreads();
    const float* MOD = (const float*)(a.ws + WS_MOD);
    bf16_t* XN = (bf16_t*)(a.ws + WS_XN); float* GATE = (float*)(a.ws + WS_GATE);
    const int gw = vcu * NWAVES + wave, NGW = G * NWAVES;
    f32x4 nx[4];
    if (gw < MT) { const float* xr = gw < MP ? a.x_p + (size_t)gw * DM : a.x_s + (size_t)(gw - MP) * DM;
#pragma unroll
        for (int j = 0; j < 4; ++j) nx[j] = *(const f32x4*)(xr + 4 * lane + 256 * j); }
    for (int r = gw; r < MT; r += NGW) {
        const int mb = r < MP ? (r >> 11) : BP + ((r - MP) >> 2);
        const float* shift = MOD + (size_t)mb * 3072; const float* scale = shift + 1024;
        f32x4 v[4]; float s = 0.f;
#pragma unroll
        for (int j = 0; j < 4; ++j) { v[j] = nx[j]; s += (v[j].x * v[j].x + v[j].y * v[j].y) + (v[j].z * v[j].z + v[j].w * v[j].w); }
        if (r + NGW < MT) { const int rn = r + NGW; const float* xr = rn < MP ? a.x_p + (size_t)rn * DM : a.x_s + (size_t)(rn - MP) * DM;
#pragma unroll
            for (int j = 0; j < 4; ++j) nx[j] = *(const f32x4*)(xr + 4 * lane + 256 * j); }
        const float rinv = 1.0f / sqrtf(wave_sum(s) * (1.f / DM) + EPS);
        float gd[8];
#pragma unroll
        for (int gi = 0; gi < 8; ++gi) gd[gi] = 0.f;
#pragma unroll
        for (int j = 0; j < 4; ++j) {
            const int col = 4 * lane + 256 * j;
            const f32x4 g = *(const f32x4*)(a.norm_g + col), sc = *(const f32x4*)(scale + col), sh = *(const f32x4*)(shift + col);
            f32x4 h = v[j] * rinv * g * (sc + 1.0f) + sh;
            u32x2 o; o.x = pk2(h.x, h.y); o.y = pk2(h.z, h.w);
            *(u32x2*)(XN + (size_t)r * DM + col) = o;
#pragma unroll
            for (int gi = 0; gi < 8; ++gi) { const f32x4 w = *(const LAS f32x4*)(sg + gi * 1024 + col); gd[gi] += (h.x * w.x + h.y * w.y) + (h.z * w.z + h.w * w.w); }
        }
#pragma unroll
        for (int gi = 0; gi < 8; ++gi) gd[gi] = wave_sum(gd[gi]);
        if (lane < 8) {
            float val = 0.f;
#pragma unroll
            for (int gi = 0; gi < 8; ++gi) val = (lane == gi) ? gd[gi] : val;
            val += a.b_in[NPROJ + lane];
            if (lane >= 4) val = fminf(val, 0.f) - log1pf(__expf(-fabsf(val)));
            GATE[(size_t)r * 8 + lane] = val;
        }
    }
}

__device__ __forceinline__ void store_wt_f32(float* p, float v) { asm volatile("global_store_dword %0, %1, off sc1\n\ts_nop 1" :: "v"(p), "v"(v) : "memory"); }
struct EpiProj {
    static constexpr bool PERM = true, AFTER_DRAIN = false;
    bf16_t* PROJ; float* LOGF; float* LOGFS; const float* bias; const float* lbl;
    __device__ __forceinline__ void operator()(const f32x4 (&acc)[2][2][4][2], const pg8::Unit& u, int wr, int wc, int fr, int fq) const {
        const int seg = u.pn >> 2;
        const int row0 = u.pm * 256 + wr * 64 + fr, col0 = u.pn * 256 + wc * 32 + 8 * fq, cs0 = col0 & 1023;
        const bool prompt = u.pm < MP / 256;
        unsigned cpart[2];
#pragma unroll
        for (int bj = 0; bj < 2; ++bj) { const int cs = cs0 + bj * 128; cpart[bj] = seg < 4 ? (unsigned)(((cs >> 7) << 13) + (cs & 127)) : (unsigned)(((cs >> 8) << 14) + (cs & 255)); }
        const int tsh = seg < 4 ? 7 : 8;
        f32x4 bv[2][2], lb[2][2];
#pragma unroll
        for (int bj = 0; bj < 2; ++bj)
#pragma unroll
            for (int n = 0; n < 2; ++n) {
                bv[bj][n] = *(const f32x4*)(bias + col0 + bj * 128 + 4 * n);
                if (seg == 1) { const int c = col0 - 1024 + bj * 128 + 4 * n; const f32x4 l0 = *(const f32x4*)(lbl + c), l1 = *(const f32x4*)(lbl + 1024 + c);
                    f32x4 t; t.x = 1.f / (1.f + __expf(l1.x - l0.x)); t.y = 1.f / (1.f + __expf(l1.y - l0.y)); t.z = 1.f / (1.f + __expf(l1.z - l0.z)); t.w = 1.f / (1.f + __expf(l1.w - l0.w)); lb[bj][n] = t; }
                else lb[bj][n] = (f32x4){0.f, 0.f, 0.f, 0.f};
            }
#pragma unroll
        for (int ai = 0; ai < 2; ++ai)
#pragma unroll
            for (int m = 0; m < 4; ++m) {
                const int row = row0 + ai * 128 + m * 16;
                const size_t rpart = prompt ? ((size_t)(row >> 6) << 16) + (size_t)((row & 63) << tsh) : 0;
#pragma unroll
                for (int bj = 0; bj < 2; ++bj) {
                    f32x4 v0 = acc[ai][bj][m][0] + bv[bj][0], v1 = acc[ai][bj][m][1] + bv[bj][1];
                    if (seg == 1) {
                        float* dst = prompt ? LOGF + rpart + cpart[bj] : LOGFS + (size_t)(row - MP) * 1024 + cs0 + bj * 128;
                        f32x4 o0, o1;
#pragma unroll
                        for (int e = 0; e < 4; ++e) { const float l0 = lb[bj][0][e], l1 = lb[bj][1][e];
                            o0[e] = __logf(l0 + (1.f - l0) * sigmoidf_(v0[e])); o1[e] = __logf(l1 + (1.f - l1) * sigmoidf_(v1[e])); }
                        *(f32x4*)dst = o0; *(f32x4*)(dst + 4) = o1;
                    } else {
                        if (seg == 3 || seg == 5) {
#pragma unroll
                            for (int e = 0; e < 4; ++e) { v0[e] = v0[e] * sigmoidf_(v0[e]); v1[e] = v1[e] * sigmoidf_(v1[e]); }
                        } else if (seg == 6) {
#pragma unroll
                            for (int e = 0; e < 4; ++e) { v0[e] = sigmoidf_(v0[e]); v1[e] = sigmoidf_(v1[e]); }
                        }
                        u32x4 w; w.x = pk2(v0[0], v0[1]); w.y = pk2(v0[2], v0[3]); w.z = pk2(v1[0], v1[1]); w.w = pk2(v1[2], v1[3]);
                        bf16_t* dst = prompt ? PROJ + (size_t)seg * SEGSZ + rpart + cpart[bj] : PROJ + PS_OFF + (size_t)(row - MP) * NPROJ + col0 + bj * 128;
                        *(u32x4*)dst = w;
                    }
                }
            }
    }
};
struct EpiOut {
    static constexpr bool PERM = true, AFTER_DRAIN = false;
    float* Y; const float* xp; const float* xs; const float* MOD;
    __device__ __forceinline__ void operator()(const f32x4 (&acc)[2][2][4][2], const pg8::Unit& u, int wr, int wc, int fr, int fq) const {
        const int row0 = u.pm * 256 + wr * 64 + fr, col0 = u.pn * 256 + wc * 32 + 8 * fq;
#pragma unroll
        for (int ai = 0; ai < 2; ++ai)
#pragma unroll
            for (int m = 0; m < 4; ++m) {
                const int row = row0 + ai * 128 + m * 16;
                const float* xr = row < MP ? xp + (size_t)row * DM : xs + (size_t)(row - MP) * DM;
                const int mb = row < MP ? (row >> 11) : BP + ((row - MP) >> 2);
                const float* gate = MOD + (size_t)mb * 3072 + 2048;
#pragma unroll
                for (int bj = 0; bj < 2; ++bj)
#pragma unroll
                    for (int n = 0; n < 2; ++n) {
                        const int col = col0 + bj * 128 + 4 * n;
                        const f32x4 xv = *(const f32x4*)(xr + col), gv = *(const f32x4*)(gate + col);
                        *(f32x4*)(Y + (size_t)row * DM + col) = xv + gv * acc[ai][bj][m][n];
                    }
            }
    }
};

struct EpiOutFused {
    static constexpr bool PERM = true, AFTER_DRAIN = true;
    float* Y; const float* xp; const float* MOD; const float* fg; float* STATS; unsigned* cnt;
    __device__ __forceinline__ void operator()(const f32x4 (&)[2][2][4][2], const pg8::Unit&, int, int, int, int) const {}
    __device__ __forceinline__ void fused(f32x4 (&acc)[2][2][4][2], const pg8::Unit& u, int wr, int wc, int fr, int fq, LAS unsigned char* lds, int wid, int lane) const {
        LAS float* P = (LAS float*)lds;
        LAS float* S = (LAS float*)(lds + 4096);
        const int tid = wid * 64 + lane;
        const int row0 = u.pm * 256 + wr * 64 + fr, col0 = u.pn * 256 + wc * 32 + 8 * fq;
        const float* gate = MOD + (size_t)(u.pm >> 3) * 3072 + 2048;
        f32x4 gv[2][2];
#pragma unroll
        for (int bj = 0; bj < 2; ++bj)
#pragma unroll
            for (int n = 0; n < 2; ++n) gv[bj][n] = *(const f32x4*)(gate + col0 + bj * 128 + 4 * n);
#pragma unroll
        for (int ai = 0; ai < 2; ++ai)
#pragma unroll
            for (int m = 0; m < 4; ++m) {
                const int row = row0 + ai * 128 + m * 16; float sq = 0.f;
#pragma unroll
                for (int bj = 0; bj < 2; ++bj)
#pragma unroll
                    for (int n = 0; n < 2; ++n) { const f32x4 xv = *(const f32x4*)(xp + (size_t)row * DM + col0 + bj * 128 + 4 * n);
                        const f32x4 v = xv + gv[bj][n] * acc[ai][bj][m][n]; acc[ai][bj][m][n] = v; sq += (v.x * v.x + v.y * v.y) + (v.z * v.z + v.w * v.w); }
                sq += __shfl_xor(sq, 16); sq += __shfl_xor(sq, 32);
                if (fq == 0) P[(ai * 128 + wr * 64 + m * 16 + fr) * 4 + wc] = sq;
            }
        __syncthreads();
        if (tid < 256) { const f32x4 p4 = *(const LAS f32x4*)(P + tid * 4);
            __hip_atomic_store(STATS + ((size_t)u.pm * 256 + tid) * 4 + u.pn, (p4.x + p4.y) + (p4.z + p4.w), __ATOMIC_RELAXED, __HIP_MEMORY_SCOPE_AGENT); }
        asm volatile("s_waitcnt vmcnt(0)" ::: "memory");
        __syncthreads();
        if (tid == 0) { (void)xb_add(cnt + 64 * u.pm, 1u);
            unsigned sp = 0; while (xb_ld(cnt + 64 * u.pm) < 4u) { __builtin_amdgcn_s_sleep(1); if (++sp > (1u << 20)) break; } }
        __syncthreads();
        if (tid < 256) { const float* st = STATS + ((size_t)u.pm * 256 + tid) * 4; float t = 0.f;
#pragma unroll
            for (int j = 0; j < 4; ++j) t += __hip_atomic_load(st + j, __ATOMIC_RELAXED, __HIP_MEMORY_SCOPE_AGENT);
            S[tid] = 1.0f / sqrtf(t * (1.f / DM) + EPS); }
        __syncthreads();
        f32x4 fgv[2][2];
#pragma unroll
        for (int bj = 0; bj < 2; ++bj)
#pragma unroll
            for (int n = 0; n < 2; ++n) fgv[bj][n] = *(const f32x4*)(fg + col0 + bj * 128 + 4 * n);
#pragma unroll
        for (int ai = 0; ai < 2; ++ai)
#pragma unroll
            for (int m = 0; m < 4; ++m) {
                const int rl = ai * 128 + wr * 64 + m * 16 + fr; const float ri = S[rl];
#pragma unroll
                for (int bj = 0; bj < 2; ++bj)
#pragma unroll
                    for (int n = 0; n < 2; ++n) *(f32x4*)(Y + (size_t)(u.pm * 256 + rl) * DM + col0 + bj * 128 + 4 * n) = acc[ai][bj][m][n] * ri * fgv[bj][n];
            }
    }
};
#define LDSP(type, off) ((LAS type*)(lds + (off)))
__device__ __forceinline__ unsigned lp_row(int lane, unsigned RS) { return (unsigned)(lane & 31) * RS + 16u * (unsigned)(lane >> 5); }
__device__ __forceinline__ unsigned lp_perm(int lane, unsigned RS) { return (unsigned)(lane & 31) * RS + 8u * (unsigned)(lane >> 5); }
__device__ __forceinline__ unsigned lp_tr(int lane, unsigned RS) { return ((unsigned)(lane >> 5) * 8u + (unsigned)((lane & 15) >> 2)) * RS + (((unsigned)(lane >> 4) & 1u) * 16u + (unsigned)(lane & 3) * 4u) * 2u; }
__device__ __forceinline__ bf16x8 frag_row(LAS unsigned char* lds, unsigned off) { return *LDSP(const bf16x8, off); }
__device__ __forceinline__ bf16x8 frag_perm(LAS unsigned char* lds, unsigned off) {
    const s16x4 lo = *LDSP(const s16x4, off), hi = *LDSP(const s16x4, off + 16);
    bf16x8 r; r[0] = lo[0]; r[1] = lo[1]; r[2] = lo[2]; r[3] = lo[3]; r[4] = hi[0]; r[5] = hi[1]; r[6] = hi[2]; r[7] = hi[3]; return r;
}
template <unsigned RS> __device__ __forceinline__ bf16x8 frag_tr(LAS unsigned char* lds, unsigned off) {
    const s16x4 lo = __builtin_amdgcn_ds_read_tr16_b64_v4i16(LDSP(s16x4, off));
    const s16x4 hi = __builtin_amdgcn_ds_read_tr16_b64_v4i16(LDSP(s16x4, off + 4 * RS));
    bf16x8 r; r[0] = lo[0]; r[1] = lo[1]; r[2] = lo[2]; r[3] = lo[3]; r[4] = hi[0]; r[5] = hi[1]; r[6] = hi[2]; r[7] = hi[3]; return r;
}
template <int S> __device__ __forceinline__ bf16x8 acc_frag(const f32x16& x) {
    u32x4 w; w.x = pk2(x[8 * S + 0], x[8 * S + 1]); w.y = pk2(x[8 * S + 2], x[8 * S + 3]); w.z = pk2(x[8 * S + 4], x[8 * S + 5]); w.w = pk2(x[8 * S + 6], x[8 * S + 7]);
    return __builtin_bit_cast(bf16x8, w);
}
#define MFMA32(a, b, c) __builtin_amdgcn_mfma_f32_32x32x16_bf16(a, b, c, 0, 0, 0)
__device__ __forceinline__ int accrow(int i, int h) { return (i & 3) + 8 * (i >> 2) + 4 * h; }
#define ACCROW0(i) (((i) & 3) + 8 * ((i) >> 2))

__device__ __forceinline__ void p0_transpose_tile(const float* W, int ldw, int K, bf16_t* WT, LAS unsigned char* lds, int kb, int nb, int tid, int wave, int lane) {
    constexpr unsigned RS = 528;
    const int k0 = 64 * kb, n0 = 256 * nb;
    f32x4 v[8];
#pragma unroll
    for (int i = 0; i < 8; ++i) { const int idx = tid + NTHR * i, k = idx >> 6, nq = idx & 63; v[i] = *(const f32x4*)(W + (size_t)(k0 + k) * ldw + n0 + 4 * nq); }
#pragma unroll
    for (int i = 0; i < 8; ++i) { const int idx = tid + NTHR * i, k = idx >> 6, nq = idx & 63; u32x2 o; o.x = pk2(v[i].x, v[i].y); o.y = pk2(v[i].z, v[i].w); *LDSP(u32x2, k * RS + 8 * nq) = o; }
    __syncthreads();
    const unsigned ot = lp_tr(lane, RS) + 64u * wave;
#pragma unroll
    for (int rb = 0; rb < 4; ++rb) { const bf16x8 f = frag_tr<RS>(lds, ot + 16 * rb * RS);
        *(bf16x8*)(WT + (size_t)(n0 + 32 * wave + (lane & 31)) * K + k0 + 16 * rb + 8 * (lane >> 5)) = f; }
    __syncthreads();
}
__device__ __forceinline__ void transposes(const Args& a, LAS unsigned char* lds, int vcu, int G, int tid, int wave, int lane);
__device__ __forceinline__ void phase0(const Args& a, LAS unsigned char* lds, int vcu, int G, int tid, int wave, int lane) {
    float* MOD = (float*)(a.ws + WS_MOD);
    for (int cb = vcu; cb < 96; cb += G) {
        const int c0 = 32 * cb;
#pragma unroll
        for (int hb = 0; hb < 2; ++hb) { f32x4 v[8];
#pragma unroll
            for (int i = 0; i < 8; ++i) { const int k = (tid >> 3) + 64 * (8 * hb + i); v[i] = *(const f32x4*)(a.w_ada + (size_t)k * 3072 + c0 + 4 * (tid & 7)); }
#pragma unroll
            for (int i = 0; i < 8; ++i) { const int k = (tid >> 3) + 64 * (8 * hb + i); u32x2 o; o.x = pk2(v[i].x, v[i].y); o.y = pk2(v[i].z, v[i].w); *LDSP(u32x2, k * 80 + 8 * (tid & 7)) = o; } }
        __syncthreads();
        if (wave < 5) {
            const int hl = lane >> 5, rr = 32 * wave + (lane & 31), rc = rr < NMOD ? rr : NMOD - 1;
            const float* cr = (rc < BP ? a.c_p + (size_t)rc * DM : a.c_s + (size_t)(rc - BP) * DM) + 8 * hl;
            const unsigned ot = lp_tr(lane, 80);
            f32x16 acc;
#pragma unroll
            for (int i = 0; i < 16; ++i) acc[i] = 0.f;
            f32x4 cv[8][2], cnx[8][2];
#pragma unroll
            for (int j = 0; j < 8; ++j) { cnx[j][0] = *(const f32x4*)(cr + 16 * j); cnx[j][1] = *(const f32x4*)(cr + 16 * j + 4); }
#pragma unroll 1
            for (int k0 = 0; k0 < DM; k0 += 128) {
#pragma unroll
                for (int j = 0; j < 8; ++j) { cv[j][0] = cnx[j][0]; cv[j][1] = cnx[j][1]; }
                { const int kn = (k0 + 128 < DM) ? k0 + 128 : k0;
#pragma unroll
                  for (int j = 0; j < 8; ++j) { cnx[j][0] = *(const f32x4*)(cr + kn + 16 * j); cnx[j][1] = *(const f32x4*)(cr + kn + 16 * j + 4); } }
#pragma unroll
                for (int j = 0; j < 8; ++j) {
                    float sv[8];
#pragma unroll
                    for (int e = 0; e < 4; ++e) { sv[e] = cv[j][0][e] * sigmoidf_(cv[j][0][e]); sv[4 + e] = cv[j][1][e] * sigmoidf_(cv[j][1][e]); }
                    u32x4 w; w.x = pk2(sv[0], sv[1]); w.y = pk2(sv[2], sv[3]); w.z = pk2(sv[4], sv[5]); w.w = pk2(sv[6], sv[7]);
                    acc = MFMA32(__builtin_bit_cast(bf16x8, w), frag_tr<80>(lds, ot + (unsigned)(k0 + 16 * j) * 80u), acc);
                }
            }
#pragma unroll
            for (int i = 0; i < 16; ++i) { const int r = 32 * wave + accrow(i, hl);
                if (r < NMOD) MOD[(size_t)r * 3072 + c0 + (lane & 31)] = acc[i] + a.b_ada[c0 + (lane & 31)]; }
        }
        __syncthreads();
    }
    if (vcu >= 96) transposes(a, lds, vcu - 96, G - 96, tid, wave, lane);
    if (vcu == G - 1) {
        float* GW = (float*)(a.ws + WS_GW);
        float tv[16];
#pragma unroll
        for (int i = 0; i < 16; ++i) { const int idx = tid + NTHR * i; tv[i] = a.w_in[(size_t)(idx >> 3) * WIN_LD + NPROJ + (idx & 7)]; }
#pragma unroll
        for (int i = 0; i < 16; ++i) { const int idx = tid + NTHR * i; GW[(idx & 7) * 1024 + (idx >> 3)] = tv[i]; }
    }
}
__device__ __forceinline__ void transposes(const Args& a, LAS unsigned char* lds, int vcu, int G, int tid, int wave, int lane) {
    bf16_t* WinT = (bf16_t*)(a.ws + WS_WIN); bf16_t* WoutT = (bf16_t*)(a.ws + WS_WOUT);
    constexpr int I_IN = (DM / 64) * (NPROJ / 256), I_OUT = (DMIX / 64) * (DM / 256);
    for (int it = vcu; it < I_IN + I_OUT; it += G) {
        if (it < I_IN) p0_transpose_tile(a.w_in, WIN_LD, DM, WinT, lds, it / (NPROJ / 256), it % (NPROJ / 256), tid, wave, lane);
        else { const int u = it - I_IN; p0_transpose_tile(a.w_out, DM, DMIX, WoutT, lds, u / (DM / 256), u % (DM / 256), tid, wave, lane); }
    }
}

__device__ __forceinline__ unsigned p3a_touch(const Args& a, int t, int tid) {
    const bf16_t* PROJ = (const bf16_t*)(a.ws + WS_PROJ);
    const unsigned* p;
    if (t < 1024) { const int b = t >> 7, c = (t >> 2) & 31, h = t & 3;
        p = (const unsigned*)(PROJ + ml_tile(4, b, c, h) + (tid & 255) * 64); }
    else { const int u = t - 1024, b = u >> 8, c = (u >> 3) & 31, h = u & 7;
        if (tid < 256) p = (const unsigned*)((const float*)(a.ws + WS_LOGF) + ((size_t)((b * NCH + c) * 8 + h) << 13) + tid * 32);
        else p = (const unsigned*)(PROJ + hg_tile(0, b, c, h) + (tid & 127) * 64); }
    return *p;
}
__device__ __forceinline__ void p3a_hgrn(const Args& a, LAS unsigned char* lds, int b, int c, int h, int tid, int wave, int lane, int tnext) {
    constexpr unsigned RS = 272, OQT = 8192, OKT = 8192 + 17408;
    bf16_t* PROJ = (bf16_t*)(a.ws + WS_PROJ);
    const float* LOGF = (const float*)(a.ws + WS_LOGF);
    const size_t r0 = (size_t)b * TP + (size_t)c * 64;
    const size_t task = ((size_t)b * NCH + c) * 8 + h;
    const int cq = tid & 31, tseg = tid >> 5;
    f32x4 lf[4]; u32x2 qw[4];
#pragma unroll
    for (int i = 0; i < 4; ++i) { const int t = 4 * tseg + i; lf[i] = *(const f32x4*)(LOGF + (task << 13) + t * 128 + 4 * cq); qw[i] = *(const u32x2*)(PROJ + hg_tile(0, b, c, h) + t * 128 + 4 * cq); }
    const unsigned pf = (tnext >= 0) ? p3a_touch(a, tnext, tid) : 0u;
    f32x4 gl[4]; gl[0] = lf[0]; gl[1] = gl[0] + lf[1]; gl[2] = gl[1] + lf[2]; gl[3] = gl[2] + lf[3];
    *LDSP(f32x4, (tseg * 128 + 4 * cq) * 4) = gl[3];
    __syncthreads();
    f32x4 off = {0.f, 0.f, 0.f, 0.f}, Gm = off, GL = off;
#pragma unroll
    for (int sg = 0; sg < 16; ++sg) { const f32x4 v = *LDSP(const f32x4, (sg * 128 + 4 * cq) * 4); GL += v; if (sg < 8) Gm += v; if (sg < tseg) off += v; }
#pragma unroll
    for (int i = 0; i < 4; ++i) { const int t = 4 * tseg + i;
        const f32x4 G = off + gl[i];
        const float q[4] = {bflo(qw[i].x), bfhi(qw[i].x), bflo(qw[i].y), bfhi(qw[i].y)};
        float qe[4], ke[4], qt[4], kt[4];
#pragma unroll
        for (int e = 0; e < 4; ++e) { const float kk = 1.f - __expf(lf[i][e]);
            qe[e] = q[e] * __expf(G[e]); ke[e] = kk * __expf(GL[e] - G[e]); qt[e] = q[e] * __expf(G[e] - Gm[e]); kt[e] = kk * __expf(Gm[e] - G[e]); }
        bf16_t* qp = PROJ + hg_tile(0, b, c, h) + t * 128 + 4 * cq;
        u32x2 o; o.x = pk2(qe[0], qe[1]); o.y = pk2(qe[2], qe[3]); *(u32x2*)qp = o;
        o.x = pk2(ke[0], ke[1]); o.y = pk2(ke[2], ke[3]); *(u32x2*)(qp + SEGSZ) = o;
        o.x = pk2(qt[0], qt[1]); o.y = pk2(qt[2], qt[3]); *LDSP(u32x2, OQT + t * RS + 8 * cq) = o;
        o.x = pk2(kt[0], kt[1]); o.y = pk2(kt[2], kt[3]); *LDSP(u32x2, OKT + t * RS + 8 * cq) = o;
    }
    if (tseg == 15) { f32x4 d; d.x = __expf(GL.x); d.y = __expf(GL.y); d.z = __expf(GL.z); d.w = __expf(GL.w); *(f32x4*)((float*)(a.ws + WS_DEC) + task * 128 + 4 * cq) = d; }
    __syncthreads();
    bf16_t* AH = (bf16_t*)(a.ws + WS_AH) + task * 4096;
    if (wave < 4) {
        const int ti = (wave == 0 || wave == 3) ? 0 : 1, tj = (wave == 2 || wave == 3) ? 1 : 0;
        const int hh = lane >> 5, c31 = lane & 31;
        f32x16 acc = {0.f, 0.f, 0.f, 0.f, 0.f, 0.f, 0.f, 0.f, 0.f, 0.f, 0.f, 0.f, 0.f, 0.f, 0.f, 0.f};
        if (wave < 3) {
            unsigned oa = OQT + lp_row(lane, RS) + 32u * ti * RS, ob = OKT + lp_row(lane, RS) + 32u * tj * RS;
#pragma unroll 4
            for (int ks = 0; ks < 8; ++ks) { acc = MFMA32(frag_row(lds, oa), frag_row(lds, ob), acc); oa += 32; ob += 32; }
        }
#pragma unroll
        for (int i = 0; i < 16; ++i) { const int t = 32 * ti + accrow(i, hh), j = 32 * tj + c31;
            AH[t * 64 + j] = f2bf((wave < 3 && j <= t) ? acc[i] : 0.f); }
    }
    asm volatile("" :: "v"(pf));
    __syncthreads();
}
__device__ __forceinline__ void p3a_mlstm(const Args& a, LAS unsigned char* lds, int b, int c, int h, int tid, int wave, int lane, int tnext) {
    constexpr unsigned RS = 528, OK_ = 33792, ORS_ = 67584, OCS_ = 67584 + 256;
    const bf16_t* PROJ = (const bf16_t*)(a.ws + WS_PROJ);
    const float* GATE = (const float*)(a.ws + WS_GATE);
    const size_t r0 = (size_t)b * TP + (size_t)c * 64;
    const size_t task = ((size_t)b * NCH + c) * 4 + h;
    if (tid < 64) *LDSP(float, ORS_ + tid * 4) = 0.f;
    const int tg = tid & 7, g = tid >> 3, ch = h * 256 + 4 * g, gg = h * 64 + g;
    const float ig = GATE[(r0 + lane) * 8 + h], lfg = GATE[(r0 + lane) * 8 + 4 + h];
    u32x2 muw[11];
#pragma unroll
    for (int rr = 0; rr < 11; ++rr) { const int t = 8 * tg - 3 + rr; const bool pad = (c == 0 && t < 0);
        const int tt_ = pad ? 0 : t;
        const u32x2 w = *(const u32x2*)(PROJ + ml_tile(4, b, tt_ < 0 ? c - 1 : c, h) + (tt_ & 63) * 256 + 4 * g);
        muw[rr].x = pad ? 0u : w.x; muw[rr].y = pad ? 0u : w.y; }
    float cw[4][4], cb[4], wq[4][4], wk[4][4], wv[4][4];
#pragma unroll
    for (int w = 0; w < 4; ++w) { const f32x4 t = *(const f32x4*)(a.conv_w + w * 1024 + ch); cw[w][0] = t.x; cw[w][1] = t.y; cw[w][2] = t.z; cw[w][3] = t.w; }
    { const f32x4 t = *(const f32x4*)(a.conv_b + ch); cb[0] = t.x; cb[1] = t.y; cb[2] = t.z; cb[3] = t.w; }
#pragma unroll
    for (int i = 0; i < 4; ++i) { const f32x4 t0 = *(const f32x4*)(a.wq + gg * 16 + 4 * i), t1 = *(const f32x4*)(a.wk + gg * 16 + 4 * i), t2 = *(const f32x4*)(a.wv + gg * 16 + 4 * i);
#pragma unroll
        for (int j = 0; j < 4; ++j) { wq[i][j] = t0[j]; wk[i][j] = t1[j] * 0.0625f; wv[i][j] = t2[j]; } }
    const unsigned pf = (tnext >= 0) ? p3a_touch(a, tnext, tid) : 0u;
    float bt = lfg;
#pragma unroll
    for (int o = 1; o < 64; o <<= 1) { const float n = __shfl_up(bt, o); if (lane >= o) bt += n; }
    const float av = ig - bt; float R = av;
#pragma unroll
    for (int o = 1; o < 64; o <<= 1) R = fmaxf(R, __shfl_xor(R, o));
    const float wtok = __expf(av - R);
    if (wave == 0) { ((float*)(a.ws + WS_BT))[task * 64 + lane] = bt; if (lane == 0) ((float*)(a.ws + WS_RL))[task] = R; }
    {
        bf16_t* XC = (bf16_t*)(a.ws + WS_XC); bf16_t* QM = (bf16_t*)(a.ws + WS_QM); bf16_t* KM = (bf16_t*)(a.ws + WS_KM); bf16_t* VM = (bf16_t*)(a.ws + WS_VM);
        float cs[4] = {0.f, 0.f, 0.f, 0.f};
        u32x4 kT[4], vT[4];
#pragma unroll
        for (int tp = 0; tp < 4; ++tp) { float k2[2][4], v2[2][4];
#pragma unroll
          for (int u = 0; u < 2; ++u) { const int tt = 2 * tp + u; const int t = 8 * tg + tt; const float wt = __shfl(wtok, t);
            float m0[4], m1[4], m2[4], m3[4];
            m0[0] = bflo(muw[tt].x); m0[1] = bfhi(muw[tt].x); m0[2] = bflo(muw[tt].y); m0[3] = bfhi(muw[tt].y);
            m1[0] = bflo(muw[tt + 1].x); m1[1] = bfhi(muw[tt + 1].x); m1[2] = bflo(muw[tt + 1].y); m1[3] = bfhi(muw[tt + 1].y);
            m2[0] = bflo(muw[tt + 2].x); m2[1] = bfhi(muw[tt + 2].x); m2[2] = bflo(muw[tt + 2].y); m2[3] = bfhi(muw[tt + 2].y);
            m3[0] = bflo(muw[tt + 3].x); m3[1] = bfhi(muw[tt + 3].x); m3[2] = bflo(muw[tt + 3].y); m3[3] = bfhi(muw[tt + 3].y);
            float xc[4], q[4], k[4];
#pragma unroll
            for (int i = 0; i < 4; ++i) { const float cv = cb[i] + cw[0][i] * m0[i] + cw[1][i] * m1[i] + cw[2][i] * m2[i] + cw[3][i] * m3[i]; xc[i] = cv * sigmoidf_(cv); }
#pragma unroll
            for (int j = 0; j < 4; ++j) { q[j] = xc[0] * wq[0][j] + xc[1] * wq[1][j] + xc[2] * wq[2][j] + xc[3] * wq[3][j];
                k[j] = (xc[0] * wk[0][j] + xc[1] * wk[1][j] + xc[2] * wk[2][j] + xc[3] * wk[3][j]) * wt;
                v2[u][j] = m3[0] * wv[0][j] + m3[1] * wv[1][j] + m3[2] * wv[2][j] + m3[3] * wv[3][j]; cs[j] += k[j]; k2[u][j] = k[j]; }
            const size_t go = (task << 14) + t * 256 + 4 * g;
            u32x2 o; o.x = pk2(xc[0], xc[1]); o.y = pk2(xc[2], xc[3]); *(u32x2*)(XC + go) = o;
            o.x = pk2(q[0], q[1]); o.y = pk2(q[2], q[3]); *(u32x2*)(QM + go) = o; *LDSP(u32x2, t * RS + 8 * g) = o;
            o.x = pk2(k[0], k[1]); o.y = pk2(k[2], k[3]); *LDSP(u32x2, OK_ + t * RS + 8 * g) = o;
          }
#pragma unroll
          for (int j = 0; j < 4; ++j) { kT[j][tp] = pk2(k2[0][j], k2[1][j]); vT[j][tp] = pk2(v2[0][j], v2[1][j]); }
        }
#pragma unroll
        for (int j = 0; j < 4; ++j) { const size_t go = (task << 14) + (size_t)(4 * g + j) * 64 + 8 * tg;
            *(u32x4*)(KM + go) = kT[j]; *(u32x4*)(VM + go) = vT[j]; }
#pragma unroll
        for (int j = 0; j < 4; ++j) { cs[j] += __shfl_xor(cs[j], 1); cs[j] += __shfl_xor(cs[j], 2); cs[j] += __shfl_xor(cs[j], 4); }
        if (tg == 0) *LDSP(f32x4, OCS_ + 16 * g) = (f32x4){cs[0], cs[1], cs[2], cs[3]};
        if (c == NCH - 1 && tg == 7) {
#pragma unroll
            for (int j = 0; j < 3; ++j) *(f32x4*)(a.out + O_VP + ((size_t)b * 3 + j) * 1024 + ch) = (f32x4){bflo(muw[8 + j].x), bfhi(muw[8 + j].x), bflo(muw[8 + j].y), bfhi(muw[8 + j].y)};
        }
    }
    __syncthreads();
    bf16_t* AM = (bf16_t*)(a.ws + WS_AM) + task * 4096;
    if (wave < 4) {
        const int ti = (wave == 0 || wave == 3) ? 0 : 1, tj = (wave == 2 || wave == 3) ? 1 : 0;
        const int hh = lane >> 5, c31 = lane & 31;
        f32x16 acc = {0.f, 0.f, 0.f, 0.f, 0.f, 0.f, 0.f, 0.f, 0.f, 0.f, 0.f, 0.f, 0.f, 0.f, 0.f, 0.f};
        if (wave < 3) {
            unsigned oa = lp_row(lane, RS) + 32u * ti * RS, ob = OK_ + lp_row(lane, RS) + 32u * tj * RS;
#pragma unroll 4
            for (int ks = 0; ks < 16; ++ks) { acc = MFMA32(frag_row(lds, oa), frag_row(lds, ob), acc); oa += 32; ob += 32; }
        }
        float pv[16];
#pragma unroll
        for (int i = 0; i < 16; ++i) { const int t = 32 * ti + accrow(i, hh), j = 32 * tj + c31;
            pv[i] = (wave < 3 && j <= t) ? acc[i] : 0.f;
            AM[t * 64 + j] = f2bf(pv[i]); }
        if (wave < 3) {
#pragma unroll
            for (int bit = 8; bit >= 1; bit >>= 1) {
#pragma unroll
                for (int m = 0; m < bit; ++m) { const bool up = (lane & bit) != 0; const float send = up ? pv[m] : pv[m + bit], keep = up ? pv[m + bit] : pv[m];
                    pv[m] = keep + __shfl_xor(send, bit); }
            }
            const float tot = pv[0] + __shfl_xor(pv[0], 16);
            if ((lane & 16) == 0) { const int i = lane & 15; atomicAdd((float*)LDSP(float, ORS_ + (32 * ti + accrow(i, hh)) * 4), tot); }
        }
    }
    asm volatile("" :: "v"(pf));
    __syncthreads();
    if (tid < 64) ((float*)(a.ws + WS_RS))[task * 64 + tid] = *LDSP(const float, ORS_ + tid * 4);
    if (tid < 256) ((float*)(a.ws + WS_CSK))[task * 256 + tid] = *LDSP(const float, OCS_ + tid * 4);
    __syncthreads();
}

constexpr int NPART = 4, CPP = NCH / NPART;
constexpr size_t WS_SUMH = 2 * MiB;
constexpr size_t WS_DTOT = 14 * MiB;
constexpr size_t WS_SUMM = 484 * MiB;
constexpr size_t WS_SUMN = 508 * MiB;
constexpr size_t WS_SUMS = 508 * MiB + 512 * 1024;
constexpr size_t WS_STATS = 509 * MiB;
constexpr size_t WS_END2 = 510 * MiB;

template <int MODE>
__device__ __forceinline__ void p3b_hgrn(const Args& a, LAS unsigned char* lds, int b, int hp, int part, int tid, int wave, int lane) {
    constexpr unsigned RS = 272, RSA = 144, HB = 62464;
    constexpr unsigned OKE = 17408, OV = 34816, OA = 52224, ODEC = 61440;
    const int hhd = wave >> 2, vb = wave & 3, hl = lane >> 5, c31 = lane & 31;
    const bf16_t* PROJ = (const bf16_t*)(a.ws + WS_PROJ);
    const bf16_t* AH = (const bf16_t*)(a.ws + WS_AH);
    const float* DEC = (const float*)(a.ws + WS_DEC);
    bf16_t* MIX = (bf16_t*)(a.ws + WS_MIX);
    float* SUMH = (float*)(a.ws + WS_SUMH); float* DTOT = (float*)(a.ws + WS_DTOT);
    f32x16 acc[4];
#pragma unroll
    for (int kt = 0; kt < 4; ++kt)
#pragma unroll
        for (int i = 0; i < 16; ++i) acc[kt][i] = 0.f;
    unsigned hb = (unsigned)hhd * HB;
    unsigned o_perm = hb + lp_perm(lane, RS), o_rowA = hb + OA + lp_row(lane, RSA), o_trV = hb + OV + lp_tr(lane, RS) + 64u * vb, o_trK = hb + OKE + lp_tr(lane, RS);
    unsigned o_dec = hb + ODEC + 16u * hl, o_st = hb + 4u * hl * RS + (32u * vb + c31) * 2u;
    const size_t sbase = ((size_t)b * 4 + hp) * 3;
    if (MODE == 1) {
        for (int q = 0; q < part; ++q) {
            __syncthreads();
            if (tid < 256) *LDSP(float, (tid >> 7) * HB + ODEC + (tid & 127) * 4) = DTOT[(sbase + q) * 256 + tid];
            __syncthreads();
            const float* su = SUMH + ((sbase + q) * 2 + hhd) * 16384 + (size_t)(vb * 4) * 1024 + lane;
#pragma unroll
            for (int kt = 0; kt < 4; ++kt)
#pragma unroll
                for (int g4 = 0; g4 < 4; ++g4) { const f32x4 d = *LDSP(const f32x4, o_dec + (32 * kt + 8 * g4) * 4);
#pragma unroll
                    for (int e = 0; e < 4; ++e) acc[kt][4 * g4 + e] = acc[kt][4 * g4 + e] * d[e] + su[kt * 1024 + (4 * g4 + e) * 64]; }
        }
    }
    float dprod = 1.f;
    constexpr int NT = (MODE == 0) ? 8 : 12;
    u32x4 pre[NT], preA[2]; float preD = 0.f;
#define HG_TILE(idx, tile, head, which) const int tile = (MODE == 0) ? ((idx) >> 10) : ((idx) >> 10), head = (MODE == 0) ? (tile >> 1) : (tile / 3), which = (MODE == 0) ? (1 + (tile & 1)) : (tile % 3)
#define HG_ISSUE(cc) do { \
        _Pragma("unroll") for (int i = 0; i < NT; ++i) { const int idx = tl + NTHR * i; HG_TILE(idx, tile, head, which); const int rem = idx & 1023; \
            pre[i] = *(const u32x4*)(PROJ + hg_tile(which, b, (cc), 2 * hp + head) + rem * 8); } \
        if (MODE == 1) { _Pragma("unroll") for (int i = 0; i < 2; ++i) { const int idx = tl + NTHR * i, head = idx >> 9, rem = idx & 511; \
            preA[i] = *(const u32x4*)(AH + (((size_t)b * NCH + (cc)) * 8 + 2 * hp + head) * 4096 + rem * 8); } } \
        if (tl < 256) preD = DEC[(((size_t)b * NCH + (cc)) * 8 + 2 * hp + (tl >> 7)) * 128 + (tl & 127)]; } while (0)
    { int tl = tid; HG_ISSUE(part * CPP); }
    for (int c = part * CPP; c < (part + 1) * CPP; ++c) {
        int tl = tid; asm volatile("" : "+v"(tl));
        asm volatile("" : "+v"(o_perm), "+v"(o_rowA), "+v"(o_trV), "+v"(o_trK), "+v"(o_dec), "+v"(o_st));
        __syncthreads();
#pragma unroll
        for (int i = 0; i < NT; ++i) { const int idx = tl + NTHR * i; HG_TILE(idx, tile, head, which); const int rem = idx & 1023, row = rem >> 4, ch = rem & 15;
            *LDSP(u32x4, head * HB + which * 17408 + row * RS + 16 * ch) = pre[i]; }
        if (MODE == 1) {
#pragma unroll
            for (int i = 0; i < 2; ++i) { const int idx = tl + NTHR * i, head = idx >> 9, rem = idx & 511, row = rem >> 3, ch = rem & 7;
                *LDSP(u32x4, head * HB + OA + row * RSA + 16 * ch) = preA[i]; } }
        if (tl < 256) { *LDSP(float, (tl >> 7) * HB + ODEC + (tl & 127) * 4) = preD; dprod *= preD; }
        __syncthreads();
        if (c + 1 < (part + 1) * CPP) HG_ISSUE(c + 1);
        f32x16 o0, o1; bf16x8 vf[4];
        if (MODE == 1) {
#pragma unroll
            for (int i = 0; i < 16; ++i) { o0[i] = 0.f; o1[i] = 0.f; }
#pragma unroll
            for (int kt = 0; kt < 4; ++kt) {
                { const bf16x8 bf = acc_frag<0>(acc[kt]);
                  o0 = MFMA32(frag_perm(lds, o_perm + 64 * kt), bf, o0); o1 = MFMA32(frag_perm(lds, o_perm + 32 * RS + 64 * kt), bf, o1); }
                { const bf16x8 bf = acc_frag<1>(acc[kt]);
                  o0 = MFMA32(frag_perm(lds, o_perm + 64 * kt + 32), bf, o0); o1 = MFMA32(frag_perm(lds, o_perm + 32 * RS + 64 * kt + 32), bf, o1); }
                asm volatile("" : "+v"(o0), "+v"(o1) :: "memory");
            }
        }
#pragma unroll
        for (int js = 0; js < 4; ++js) vf[js] = frag_tr<RS>(lds, o_trV + 16 * js * RS);
        if (MODE == 1) {
#pragma unroll
            for (int js = 0; js < 4; ++js) { o0 = MFMA32(frag_row(lds, o_rowA + 32 * js), vf[js], o0); o1 = MFMA32(frag_row(lds, o_rowA + 32 * RSA + 32 * js), vf[js], o1); }
            asm volatile("" : "+v"(o0), "+v"(o1) :: "memory");
        }
#pragma unroll
        for (int kt = 0; kt < 4; ++kt) {
#pragma unroll
            for (int g4 = 0; g4 < 4; ++g4) { const f32x4 d = *LDSP(const f32x4, o_dec + (32 * kt + 8 * g4) * 4);
                acc[kt][4 * g4 + 0] *= d.x; acc[kt][4 * g4 + 1] *= d.y; acc[kt][4 * g4 + 2] *= d.z; acc[kt][4 * g4 + 3] *= d.w; }
            asm volatile("" : "+v"(acc[kt]) :: "memory"); }
#pragma unroll
        for (int kt = 0; kt < 4; ++kt) {
#pragma unroll
            for (int js = 0; js < 4; ++js) acc[kt] = MFMA32(frag_tr<RS>(lds, o_trK + 16 * js * RS + 64 * kt), vf[js], acc[kt]);
            asm volatile("" : "+v"(acc[kt]) :: "memory"); }
        if (MODE == 1) {
            __builtin_amdgcn_sched_barrier(0);
            __syncthreads();
#pragma unroll
            for (int i = 0; i < 16; ++i) {
                *LDSP(bf16_t, o_st + ACCROW0(i) * RS) = f2bf(o0[i]);
                *LDSP(bf16_t, o_st + (32 + ACCROW0(i)) * RS) = f2bf(o1[i]);
            }
            __syncthreads();
            const size_t r0 = (size_t)b * TP + (size_t)c * 64;
#pragma unroll
            for (int i = 0; i < 4; ++i) { const int idx = tl + NTHR * i, head = idx >> 10, rem = idx & 1023, row = rem >> 4, ch = rem & 15;
                const u32x4 w = *LDSP(const u32x4, head * HB + row * RS + 16 * ch);
                float v[8] = {bflo(w.x), bfhi(w.x), bflo(w.y), bfhi(w.y), bflo(w.z), bfhi(w.z), bflo(w.w), bfhi(w.w)};
                float ss = 0.f;
#pragma unroll
                for (int e = 0; e < 8; ++e) ss += v[e] * v[e];
                ss += __shfl_xor(ss, 1); ss += __shfl_xor(ss, 2); ss += __shfl_xor(ss, 4); ss += __shfl_xor(ss, 8);
                const float rn = 1.0f / sqrtf(ss * (1.f / 128.f) + EPS);
                const int col = (2 * hp + head) * 128 + 8 * ch;
                const u32x4 z = *(const u32x4*)(PROJ + hg_tile(3, b, c, 2 * hp + head) + rem * 8);
                const f32x4 g0 = *(const f32x4*)(a.hnorm_g + col), g1 = *(const f32x4*)(a.hnorm_g + col + 4);
                u32x4 o; o.x = pk2(v[0] * rn * g0.x * bflo(z.x), v[1] * rn * g0.y * bfhi(z.x)); o.y = pk2(v[2] * rn * g0.z * bflo(z.y), v[3] * rn * g0.w * bfhi(z.y));
                o.z = pk2(v[4] * rn * g1.x * bflo(z.z), v[5] * rn * g1.y * bfhi(z.z)); o.w = pk2(v[6] * rn * g1.z * bflo(z.w), v[7] * rn * g1.w * bfhi(z.w));
                *(u32x4*)(MIX + (r0 + row) * DMIX + col) = o;
            }
        }
    }
    if (MODE == 0) {
        float* su = SUMH + ((sbase + part) * 2 + hhd) * 16384 + (size_t)(vb * 4) * 1024 + lane;
#pragma unroll
        for (int kt = 0; kt < 4; ++kt)
#pragma unroll
            for (int i = 0; i < 16; ++i) su[kt * 1024 + i * 64] = acc[kt][i];
        if (tid < 256) DTOT[(sbase + part) * 256 + tid] = dprod;
    } else if (part == NPART - 1) {
        float* SP = a.out + O_HP + ((size_t)b * 8 + 2 * hp + hhd) * 128 * 128 + (size_t)(4 * hl) * 128 + 32 * vb + c31;
#pragma unroll
        for (int kt = 0; kt < 4; ++kt)
#pragma unroll
            for (int i = 0; i < 16; ++i) SP[(size_t)(32 * kt + ACCROW0(i)) * 128] = acc[kt][i];
    }
    __syncthreads();
#undef HG_TILE
#undef HG_ISSUE
}

template <int MODE>
__device__ __forceinline__ void p3b_mlstm(const Args& a, LAS unsigned char* lds, int b, int h, int part, int tid, int wave, int lane) {
    constexpr unsigned RS = 528;
    constexpr unsigned OKE = (MODE == 1) ? 33792u : 0u, OV = OKE + 32768u, OA = OV + 32768u;
    constexpr unsigned ON = (MODE == 1) ? OA + 8192u : 131072u, OD = ON + 1024, OBT = OD + 256, ORS = OBT + 256, OCS = ORS + 256, OSTG = OCS + 1024 + 256;
    static_assert(MODE == 0 || OSTG + 64 * RS <= (unsigned)MISC_OFF, "LDS layout");
    const int hl = lane >> 5, c31 = lane & 31;
    const bf16_t* PROJ = (const bf16_t*)(a.ws + WS_PROJ);
    const bf16_t* QM = (const bf16_t*)(a.ws + WS_QM); const bf16_t* KM = (const bf16_t*)(a.ws + WS_KM); const bf16_t* VM = (const bf16_t*)(a.ws + WS_VM); const bf16_t* XC = (const bf16_t*)(a.ws + WS_XC);
    const bf16_t* AM = (const bf16_t*)(a.ws + WS_AM);
    bf16_t* MIX = (bf16_t*)(a.ws + WS_MIX);
    float* SUMM = (float*)(a.ws + WS_SUMM); float* SUMN = (float*)(a.ws + WS_SUMN); float* SUMS = (float*)(a.ws + WS_SUMS);
    f32x16 acc[8];
#pragma unroll
    for (int kt = 0; kt < 8; ++kt)
#pragma unroll
        for (int i = 0; i < 16; ++i) acc[kt][i] = 0.f;
    if (tid < 256) *LDSP(float, ON + tid * 4) = 0.f;
    float mu = 0.f, mrun = (MODE == 0) ? -1e30f : 0.f, bsum = 0.f;
    const size_t sbase = ((size_t)b * 4 + h) * 3;
    if (MODE == 1 && part > 0) {
        float muU[3], Bq[3], Mq[3], cq[3];
#pragma unroll
        for (int q = 0; q < 3; ++q) { const float* s3 = SUMS + (sbase + (q < part ? q : 0)) * 4; muU[q] = s3[0]; Bq[q] = s3[1]; Mq[q] = s3[2]; }
        float sb = 0.f, mus = -1e30f, e[3];
#pragma unroll
        for (int q = 2; q >= 0; --q) { if (q < part) { e[q] = muU[q] + sb; mus = fmaxf(mus, e[q]); sb += Bq[q]; } else e[q] = -1e30f; }
#pragma unroll
        for (int q = 0; q < 3; ++q) { cq[q] = (q < part) ? __expf(e[q] - mus) : 0.f; if (q < part) mrun = fmaxf(mrun + Bq[q], Mq[q]); }
        mu = mus;
        const float* su0 = SUMM + (sbase + 0) * 65536 + (size_t)(wave * 8) * 1024 + lane * 16;
#pragma unroll
        for (int kp = 0; kp < 4; ++kp) {
            f32x4 t[3][2][4];
#pragma unroll
            for (int q = 0; q < 3; ++q) { const float* su = su0 + (size_t)(q < part ? q : 0) * 65536;
#pragma unroll
                for (int k2 = 0; k2 < 2; ++k2)
#pragma unroll
                    for (int g = 0; g < 4; ++g) t[q][k2][g] = *(const f32x4*)(su + (2 * kp + k2) * 1024 + 4 * g); }
#pragma unroll
            for (int k2 = 0; k2 < 2; ++k2)
#pragma unroll
                for (int g = 0; g < 4; ++g)
#pragma unroll
                    for (int e4 = 0; e4 < 4; ++e4) acc[2 * kp + k2][4 * g + e4] = cq[0] * t[0][k2][g][e4] + cq[1] * t[1][k2][g][e4] + cq[2] * t[2][k2][g][e4];
            asm volatile("" : "+v"(acc[2 * kp]), "+v"(acc[2 * kp + 1]) :: "memory");
        }
        if (tid < 256) { float n = 0.f;
#pragma unroll
            for (int q = 0; q < 3; ++q) n += cq[q] * SUMN[(sbase + (q < part ? q : 0)) * 256 + tid];
            *LDSP(float, ON + tid * 4) = n; }
    }
    const unsigned xs_ = (unsigned)((c31 >> 1) & 7);
    const unsigned fb_ = (unsigned)c31 * 128u + (((unsigned)hl ^ (xs_ & 1u)) << 4) + ((xs_ >> 1) << 5);
    unsigned o_perm = lp_perm(lane, RS), o_rowA = OA + fb_, o_trV = OV + 4096u * (unsigned)wave + fb_, o_trK = OKE + fb_;
    unsigned o_st = OSTG + 4u * hl * RS + (32u * wave + c31) * 2u, o_h = 16u * hl;
    const int c_end = (part + 1) * CPP;
    float preRL = 0.f, preC = 0.f, preBL = 0.f;
#define ML_DMA_TILE(gsrc, ldsoff, n) do { const char* g_ = (const char*)(gsrc) + vK; \
        _Pragma("unroll") for (int i_ = 0; i_ < (n); ++i_) __builtin_amdgcn_global_load_lds((const unsigned*)(g_ + i_ * 8192), (LAS unsigned*)(lds + (ldsoff) + i_ * 8192u + 1024u * (unsigned)wave), 16, 0, 0); } while (0)
#define ML_ISSUE(cc, bufo) do { const size_t task_ = ((size_t)b * NCH + (cc)) * 4 + h; \
        const unsigned vK = (unsigned)(tl >> 3) * 128u + ((((unsigned)tl & 7u) ^ (((unsigned)tl >> 4) & 7u)) << 4); \
        ML_DMA_TILE(KM + (task_ << 14), (bufo) + OKE, 4); ML_DMA_TILE(VM + (task_ << 14), (bufo) + OV, 4); \
        if (MODE == 1) { ML_DMA_TILE(AM + task_ * 4096, OA, 1); \
            if (wave < 4) __builtin_amdgcn_global_load_lds((const unsigned*)((const float*)(a.ws + WS_CSK) + task_ * 256 + (tl & 255)), (LAS unsigned*)(lds + OCS + 256u * (unsigned)wave), 4, 0, 0); \
            else if (wave == 4) __builtin_amdgcn_global_load_lds((const unsigned*)((const float*)(a.ws + WS_BT) + task_ * 64 + (tl & 63)), (LAS unsigned*)(lds + OBT), 4, 0, 0); \
            else if (wave == 5) __builtin_amdgcn_global_load_lds((const unsigned*)((const float*)(a.ws + WS_RS) + task_ * 64 + (tl & 63)), (LAS unsigned*)(lds + ORS), 4, 0, 0); \
            _Pragma("unroll") for (int i_ = 0; i_ < 5; ++i_) { if (i_ < 4 || wave == 0) { const unsigned q_ = 512u * i_ + (unsigned)tl, row_ = (q_ * 1986u) >> 16; unsigned cp_ = q_ - 33u * row_; cp_ = cp_ > 31u ? 31u : cp_;   \
                __builtin_amdgcn_global_load_lds((const unsigned*)((const char*)(QM + (task_ << 14)) + (row_ * 32u + cp_) * 16u), (LAS unsigned*)(lds + i_ * 8192u + 1024u * (unsigned)wave), 16, 0, 0); } } } \
        else { preC = ((const float*)(a.ws + WS_CSK))[task_ * 256 + (tl & 255)]; preBL = ((const float*)(a.ws + WS_BT))[task_ * 64 + 63]; } \
        preRL = ((const float*)(a.ws + WS_RL))[task_]; } while (0)
    f32x4 g0 = {0.f, 0.f, 0.f, 0.f}, g1 = g0, k0 = g0, k1 = g0;
    if (MODE == 1) { const int col = h * 256 + 8 * (tid & 31); g0 = *(const f32x4*)(a.mnorm_g + col); g1 = *(const f32x4*)(a.mnorm_g + col + 4); k0 = *(const f32x4*)(a.skip + col); k1 = *(const f32x4*)(a.skip + col + 4);
        asm volatile("" : "+v"(g0), "+v"(g1), "+v"(k0), "+v"(k1)); }
    __syncthreads();
    { int tl = tid; asm volatile("" : "+v"(tl)); ML_ISSUE(part * CPP, 0u); }
    for (int c = part * CPP; c < c_end; ++c) {
        int tl = tid; asm volatile("" : "+v"(tl));
        asm volatile("" : "+v"(o_perm), "+v"(o_rowA), "+v"(o_trV), "+v"(o_trK), "+v"(o_st), "+v"(o_h));
        const size_t r0 = (size_t)b * TP + (size_t)c * 64;
        const size_t task = ((size_t)b * NCH + c) * 4 + h;
        const float R = preRL, cskv = preC, bL0 = preBL;
        if (MODE == 1) {
            if (c == part * CPP) asm volatile("s_waitcnt vmcnt(0)" ::: "memory"); else asm volatile("s_waitcnt vmcnt(4)" ::: "memory");
        } else asm volatile("s_waitcnt vmcnt(0)" ::: "memory");
        asm volatile("s_waitcnt lgkmcnt(0)" ::: "memory");
        __builtin_amdgcn_s_barrier();
        const unsigned bo = (MODE == 0) ? (unsigned)((c - part * CPP) & 1) * 65536u : 0u;
        if (MODE == 0) { if (c + 1 < c_end) ML_ISSUE(c + 1, 65536u - bo); }
        const float sc = __expf(mu - R);
        f32x16 o0, o1; bf16x8 vf[4];
        if (MODE == 1) {
            { const int t = tl >> 3, sub = tl & 7; float p = 0.f;
#pragma unroll
              for (int j = 0; j < 4; ++j) { const u32x4 w = *LDSP(const u32x4, t * RS + (sub * 32 + 8 * j) * 2);
                  const f32x4 n0 = *LDSP(const f32x4, ON + (sub * 32 + 8 * j) * 4), n1 = *LDSP(const f32x4, ON + (sub * 32 + 8 * j + 4) * 4);
                  p += bflo(w.x) * n0.x + bfhi(w.x) * n0.y + bflo(w.y) * n0.z + bfhi(w.y) * n0.w + bflo(w.z) * n1.x + bfhi(w.z) * n1.y + bflo(w.w) * n1.z + bfhi(w.w) * n1.w; }
              p += __shfl_xor(p, 1); p += __shfl_xor(p, 2); p += __shfl_xor(p, 4);
              if (sub == 0) { const float den = fmaxf(fabsf(sc * p + *LDSP(const float, ORS + t * 4)), __expf(-(*LDSP(const float, OBT + t * 4) + R)));
                  *LDSP(float, OD + t * 4) = __builtin_amdgcn_rcpf(den); } }
        }
#pragma unroll
        for (int kt = 0; kt < 8; ++kt)
#pragma unroll
            for (int i = 0; i < 16; ++i) acc[kt][i] *= sc;
        if (MODE == 1) {
#pragma unroll
            for (int i = 0; i < 16; ++i) { o0[i] = 0.f; o1[i] = 0.f; }
#pragma unroll
            for (int kt = 0; kt < 8; ++kt) {
                { const bf16x8 bf = acc_frag<0>(acc[kt]);
                  o0 = MFMA32(frag_perm(lds, o_perm + 64 * kt), bf, o0); o1 = MFMA32(frag_perm(lds, o_perm + 32 * RS + 64 * kt), bf, o1); }
                { const bf16x8 bf = acc_frag<1>(acc[kt]);
                  o0 = MFMA32(frag_perm(lds, o_perm + 64 * kt + 32), bf, o0); o1 = MFMA32(frag_perm(lds, o_perm + 32 * RS + 64 * kt + 32), bf, o1); }
                asm volatile("" : "+v"(o0), "+v"(o1) :: "memory");
            }
        }
#pragma unroll
        for (int js = 0; js < 4; ++js) vf[js] = frag_row(lds, ((o_trV + bo) ^ (32u * js)));
        if (MODE == 1) {
#pragma unroll
            for (int js = 0; js < 4; ++js) { const unsigned oa = o_rowA ^ (32u * js); o0 = MFMA32(frag_row(lds, oa), vf[js], o0); o1 = MFMA32(frag_row(lds, oa + 4096u), vf[js], o1); }
            asm volatile("" : "+v"(o0), "+v"(o1) :: "memory");
        }
        { unsigned okj[4];
#pragma unroll
          for (int js = 0; js < 4; ++js) okj[js] = (o_trK + bo) ^ (32u * js);
#pragma unroll
          for (int kt = 0; kt < 8; ++kt) {
#pragma unroll
            for (int js = 0; js < 4; ++js) acc[kt] = MFMA32(frag_row(lds, okj[js] + 4096u * kt), vf[js], acc[kt]);
            asm volatile("" : "+v"(acc[kt]) :: "memory"); } }
        const float bL = (MODE == 1) ? *LDSP(const float, OBT + 63 * 4) : bL0;
#ifndef RPN
#define RPN 2
#endif
        u32x4 rpm[4], rpz[4], rpx[4];
        if (MODE == 1) {
#pragma unroll
            for (int i = 0; i < RPN; ++i) { const int idx = tl + NTHR * i;
                rpm[i] = *(const u32x4*)(PROJ + ml_tile(6, b, c, h) + idx * 8);
                rpz[i] = *(const u32x4*)(PROJ + ml_tile(5, b, c, h) + idx * 8);
                rpx[i] = *(const u32x4*)(XC + (task << 14) + idx * 8); }
        }
        if (MODE == 0) { if (tl < 256) *LDSP(float, ON + tl * 4) = sc * *LDSP(const float, ON + tl * 4) + cskv; }
        if (MODE == 1) {
            __builtin_amdgcn_sched_barrier(0);
            __syncthreads();
            if (tl < 256) *LDSP(float, ON + tl * 4) = sc * *LDSP(const float, ON + tl * 4) + *LDSP(const float, OCS + tl * 4);
#pragma unroll
            for (int i = 0; i < RPN; ++i) asm volatile("" : "+v"(rpm[i]), "+v"(rpz[i]), "+v"(rpx[i]));
            if (c + 1 < c_end) ML_ISSUE(c + 1, 0u);
#pragma unroll
            for (int g4 = 0; g4 < 4; ++g4) {
                const f32x4 d0 = *LDSP(const f32x4, OD + o_h + 32 * g4), d1 = *LDSP(const f32x4, OD + o_h + 128 + 32 * g4);
#pragma unroll
                for (int e = 0; e < 4; ++e) {
                    *LDSP(bf16_t, o_st + (8 * g4 + e) * RS) = f2bf(o0[4 * g4 + e] * d0[e]);
                    *LDSP(bf16_t, o_st + (32 + 8 * g4 + e) * RS) = f2bf(o1[4 * g4 + e] * d1[e]);
                }
            }
            asm volatile("s_waitcnt lgkmcnt(0)" ::: "memory");
            __builtin_amdgcn_s_barrier();
#define ML_RPLOAD(i, M_, Z_, X_) do { const int idx_ = tl + NTHR * (i); \
                M_ = *(const u32x4*)(PROJ + ml_tile(6, b, c, h) + idx_ * 8); Z_ = *(const u32x4*)(PROJ + ml_tile(5, b, c, h) + idx_ * 8); X_ = *(const u32x4*)(XC + (task << 14) + idx_ * 8); \
                asm volatile("" ::: "memory"); } while (0)
#define ML_ROW(i, MO_, ZZ_, XC_) do { const int idx = tl + NTHR * (i), row = idx >> 5, ch = idx & 31, col = h * 256 + 8 * ch; \
                const u32x4 w = *LDSP(const u32x4, OSTG + row * RS + 16 * ch); \
                float v[8] = {bflo(w.x) * bflo(MO_.x), bfhi(w.x) * bfhi(MO_.x), bflo(w.y) * bflo(MO_.y), bfhi(w.y) * bfhi(MO_.y), bflo(w.z) * bflo(MO_.z), bfhi(w.z) * bfhi(MO_.z), bflo(w.w) * bflo(MO_.w), bfhi(w.w) * bfhi(MO_.w)}; \
                float ss = 0.f; \
                _Pragma("unroll") for (int e = 0; e < 8; ++e) ss += v[e] * v[e]; \
                ss += __shfl_xor(ss, 1); ss += __shfl_xor(ss, 2); ss += __shfl_xor(ss, 4); ss += __shfl_xor(ss, 8); ss += __shfl_xor(ss, 16); \
                const float rn = 1.0f / sqrtf(ss * (1.f / 256.f) + EPS); \
                u32x4 o; \
                o.x = pk2((v[0] * rn * g0.x + k0.x * bflo(XC_.x)) * bflo(ZZ_.x), (v[1] * rn * g0.y + k0.y * bfhi(XC_.x)) * bfhi(ZZ_.x)); \
                o.y = pk2((v[2] * rn * g0.z + k0.z * bflo(XC_.y)) * bflo(ZZ_.y), (v[3] * rn * g0.w + k0.w * bfhi(XC_.y)) * bfhi(ZZ_.y)); \
                o.z = pk2((v[4] * rn * g1.x + k1.x * bflo(XC_.z)) * bflo(ZZ_.z), (v[5] * rn * g1.y + k1.y * bfhi(XC_.z)) * bfhi(ZZ_.z)); \
                o.w = pk2((v[6] * rn * g1.z + k1.z * bflo(XC_.w)) * bflo(ZZ_.w), (v[7] * rn * g1.w + k1.w * bfhi(XC_.w)) * bfhi(ZZ_.w)); \
                *(u32x4*)(MIX + (r0 + row) * DMIX + 1024 + col) = o; } while (0)
            { u32x4 qm, qz, qx, sm, sz, sx;
              ML_RPLOAD(2, qm, qz, qx);
              ML_RPLOAD(3, sm, sz, sx);
              ML_ROW(0, rpm[0], rpz[0], rpx[0]);
              ML_ROW(1, rpm[1], rpz[1], rpx[1]);
              asm volatile("" : "+v"(qm), "+v"(qz), "+v"(qx), "+v"(sm), "+v"(sz), "+v"(sx) :: "memory");
              ML_ROW(2, qm, qz, qx);
              ML_ROW(3, sm, sz, sx); }
#undef ML_ROW
#undef ML_RPLOAD
        }
        mu = bL + R; mrun = bL + fmaxf(mrun, R); bsum += bL;
    }
    __syncthreads();
    if (MODE == 0) {
        float* su = SUMM + (sbase + part) * 65536 + (size_t)(wave * 8) * 1024 + lane * 16;
#pragma unroll
        for (int kt = 0; kt < 8; ++kt)
#pragma unroll
            for (int g = 0; g < 4; ++g) *(f32x4*)(su + kt * 1024 + 4 * g) = (f32x4){acc[kt][4 * g], acc[kt][4 * g + 1], acc[kt][4 * g + 2], acc[kt][4 * g + 3]};
        if (tid < 256) SUMN[(sbase + part) * 256 + tid] = *LDSP(const float, ON + tid * 4);
        if (tid == 0) { float* s3 = SUMS + (sbase + part) * 4; s3[0] = mu; s3[1] = bsum; s3[2] = mrun; }
    } else if (part == NPART - 1) {
        const float fs = __expf(mu - mrun);
        float* CP = a.out + O_CP + ((size_t)b * 4 + h) * 65536 + (size_t)(4 * hl) * 256 + 32 * wave + c31;
#pragma unroll
        for (int kt = 0; kt < 8; ++kt)
#pragma unroll
            for (int i = 0; i < 16; ++i) CP[(size_t)(32 * kt + ACCROW0(i)) * 256] = acc[kt][i] * fs;
        if (tid < 256) a.out[O_NP + ((size_t)b * 4 + h) * 256 + tid] = *LDSP(const float, ON + tid * 4) * fs;
        if (tid == 0) a.out[O_MP + b * 4 + h] = mrun;
    }
    __syncthreads();
#undef ML_ISSUE
#undef ML_DMA_TILE
}

__device__ __forceinline__ void p3b_sample_hgrn(const Args& a, LAS unsigned char* lds, int b, int h, int tid, int wave, int lane) {
    LAS float* sq = (LAS float*)lds; LAS float* sf = sq + 512; LAS float* sk = sf + 512; LAS float* sv = sk + 512;
    LAS float* sPO = sv + 512;
    const bf16_t* PROJ = (const bf16_t*)(a.ws + WS_PROJ) + PS_OFF - (size_t)MP * NPROJ;   const float* LOGFS = (const float*)(a.ws + WS_LOGFS);
    const size_t rb = (size_t)MP + (size_t)b * 4;
    const int vq = tid & 31, kr = tid >> 5;
    const float* S0 = a.st_h + ((size_t)b * 8 + h) * 16384; float* S1 = a.out + O_HS + ((size_t)b * 8 + h) * 16384;
    f32x4 S[8];
#pragma unroll
    for (int i = 0; i < 8; ++i) S[i] = __builtin_nontemporal_load((const f32x4*)(S0 + (size_t)(kr + 16 * i) * 128 + 4 * vq));
    __syncthreads();
    { const int t = tid >> 7, k = tid & 127; const float f = __expf(LOGFS[((size_t)b * 4 + t) * 1024 + h * 128 + k]);
      sf[tid] = f; sk[tid] = 1.f - f; sq[tid] = bf2f(PROJ[(rb + t) * NPROJ + h * 128 + k]); sv[tid] = bf2f(PROJ[(rb + t) * NPROJ + 2048 + h * 128 + k]); }
    __syncthreads();
    f32x4 vv[4], po[4];
#pragma unroll
    for (int t = 0; t < 4; ++t) { vv[t] = *(const LAS f32x4*)(sv + t * 128 + 4 * vq); po[t] = (f32x4){0.f, 0.f, 0.f, 0.f}; }
#pragma unroll
    for (int i = 0; i < 8; ++i) { const int k = kr + 16 * i;
#pragma unroll
        for (int t = 0; t < 4; ++t) { S[i] = S[i] * sf[t * 128 + k] + vv[t] * sk[t * 128 + k]; po[t] += S[i] * sq[t * 128 + k]; }
        __builtin_nontemporal_store(S[i], (f32x4*)(S1 + (size_t)k * 128 + 4 * vq)); }
#pragma unroll
    for (int t = 0; t < 4; ++t) *(LAS f32x4*)(sPO + (kr * 4 + t) * 128 + 4 * vq) = po[t];
    __syncthreads();
    if (wave < 4) { const int t = wave; float o[2]; float ss = 0.f;
#pragma unroll
        for (int j = 0; j < 2; ++j) { const int v = lane + 64 * j; float s = 0.f;
#pragma unroll
            for (int r = 0; r < 16; ++r) s += sPO[(r * 4 + t) * 128 + v];
            o[j] = s; ss += s * s; }
        ss = wave_sum(ss); const float rn = 1.0f / sqrtf(ss * (1.f / 128.f) + EPS);
#pragma unroll
        for (int j = 0; j < 2; ++j) { const int col = h * 128 + lane + 64 * j;
            const float z = bf2f(PROJ[(rb + t) * NPROJ + 3072 + col]);
            ((bf16_t*)(a.ws + WS_MIX))[(rb + t) * DMIX + col] = f2bf(o[j] * rn * a.hnorm_g[col] * z); }
    }
}
__device__ __forceinline__ void p3b_sample_hgrn4(const Args& a, LAS unsigned char* lds, int b, int hq, int tid, int wave, int lane) {
    LAS float* sT = (LAS float*)lds;
    LAS float* sPO = sT + 8192;
    const bf16_t* PROJ = (const bf16_t*)(a.ws + WS_PROJ) + PS_OFF - (size_t)MP * NPROJ; const float* LOGFS = (const float*)(a.ws + WS_LOGFS);
    const size_t rb = (size_t)MP + (size_t)b * 4;
    const int vq = tid & 31, kr = tid >> 5, h0 = 4 * hq;
    const float* S0 = a.st_h + ((size_t)b * 8 + h0) * 16384; float* S1 = a.out + O_HS + ((size_t)b * 8 + h0) * 16384;
    f32x4 S[8], Sn[8];
#pragma unroll
    for (int i = 0; i < 8; ++i) S[i] = __builtin_nontemporal_load((const f32x4*)(S0 + (size_t)(kr + 16 * i) * 128 + 4 * vq));
    float lf[4], qv[4], vvv[4], zr[4][2], gr[4][2];
    { const int t = tid >> 7, k = tid & 127;
#pragma unroll
      for (int hh = 0; hh < 4; ++hh) { const int col = (h0 + hh) * 128 + k;
          lf[hh] = LOGFS[((size_t)b * 4 + t) * 1024 + col]; qv[hh] = bf2f(PROJ[(rb + t) * NPROJ + col]); vvv[hh] = bf2f(PROJ[(rb + t) * NPROJ + 2048 + col]); } }
    { const int t = wave & 3;
#pragma unroll
      for (int hh = 0; hh < 4; ++hh)
#pragma unroll
          for (int j = 0; j < 2; ++j) { const int col = (h0 + hh) * 128 + lane + 64 * j; zr[hh][j] = bf2f(PROJ[(rb + t) * NPROJ + 3072 + col]); gr[hh][j] = a.hnorm_g[col]; } }
    __syncthreads();
#pragma unroll
    for (int hh = 0; hh < 4; ++hh) { const float f = __expf(lf[hh]); LAS float* p = sT + hh * 2048 + tid;
        p[0] = qv[hh]; p[512] = f; p[1024] = 1.f - f; p[1536] = vvv[hh]; }
    __syncthreads();
#pragma unroll
    for (int hh = 0; hh < 4; ++hh) {
        const LAS float* sq = sT + hh * 2048; const LAS float* sf = sq + 512; const LAS float* sk = sf + 512; const LAS float* sv = sk + 512;
        LAS float* po_ = sPO + (hh & 1) * 8192;
        if (hh < 3) {
#pragma unroll
            for (int i = 0; i < 8; ++i) Sn[i] = __builtin_nontemporal_load((const f32x4*)(S0 + (size_t)(hh + 1) * 16384 + (size_t)(kr + 16 * i) * 128 + 4 * vq));
        }
        f32x4 vv[4], po[4];
#pragma unroll
        for (int t = 0; t < 4; ++t) { vv[t] = *(const LAS f32x4*)(sv + t * 128 + 4 * vq); po[t] = (f32x4){0.f, 0.f, 0.f, 0.f}; }
#pragma unroll
        for (int i = 0; i < 8; ++i) { const int k = kr + 16 * i;
#pragma unroll
            for (int t = 0; t < 4; ++t) { S[i] = S[i] * sf[t * 128 + k] + vv[t] * sk[t * 128 + k]; po[t] += S[i] * sq[t * 128 + k]; }
            __builtin_nontemporal_store(S[i], (f32x4*)(S1 + (size_t)hh * 16384 + (size_t)k * 128 + 4 * vq)); }
#pragma unroll
        for (int t = 0; t < 4; ++t) *(LAS f32x4*)(po_ + (kr * 4 + t) * 128 + 4 * vq) = po[t];
        __syncthreads();
        if (wave < 4) { const int t = wave; float o[2]; float ss = 0.f;
#pragma unroll
            for (int j = 0; j < 2; ++j) { const int v = lane + 64 * j; float s_ = 0.f;
#pragma unroll
                for (int r = 0; r < 16; ++r) s_ += po_[(r * 4 + t) * 128 + v];
                o[j] = s_; ss += s_ * s_; }
            ss = wave_sum(ss); const float rn = 1.0f / sqrtf(ss * (1.f / 128.f) + EPS);
#pragma unroll
            for (int j = 0; j < 2; ++j) { const int col = (h0 + hh) * 128 + lane + 64 * j;
                ((bf16_t*)(a.ws + WS_MIX))[(rb + t) * DMIX + col] = f2bf(o[j] * rn * gr[hh][j] * zr[hh][j]); }
        }
        if (hh < 3) {
#pragma unroll
            for (int i = 0; i < 8; ++i) S[i] = Sn[i];
        }
    }
}
__device__ __forceinline__ void p3b_sample_mlstm(const Args& a, LAS unsigned char* lds, int b, int h, int tid, int wave, int lane) {
    LAS float* sxc = (LAS float*)lds; LAS float* sq = sxc + 1024; LAS float* sk = sq + 1024; LAS float* sv = sk + 1024;
    LAS float* sDen = sv + 1024;
    LAS float* sPN = sDen + 16;
    const bf16_t* PROJ = (const bf16_t*)(a.ws + WS_PROJ) + PS_OFF - (size_t)MP * NPROJ;   const float* GATE = (const float*)(a.ws + WS_GATE);
    const size_t rb = (size_t)MP + (size_t)b * 4;
    const int vq = tid & 63, kr = tid >> 6;
    const float* C0 = a.st_C + ((size_t)b * 4 + h) * 65536; float* C1 = a.out + O_CS + ((size_t)b * 4 + h) * 65536;
    f32x4 Ca[8], Cb[8];
#pragma unroll
    for (int i = 0; i < 8; ++i) { Ca[i] = __builtin_nontemporal_load((const f32x4*)(C0 + (size_t)(kr + 8 * i) * 256 + 4 * vq)); Cb[i] = __builtin_nontemporal_load((const f32x4*)(C0 + (size_t)(kr + 8 * (8 + i)) * 256 + 4 * vq)); }
    __syncthreads();
    if (tid < 256) {
        const int t = tid >> 6, g = tid & 63, ch = h * 256 + 4 * g, gg = h * 64 + g;
        float e[4][4];
#pragma unroll
        for (int w = 0; w < 4; ++w) { const int idx = t + w;
            if (idx < 3) { const f32x4 x = *(const f32x4*)(a.st_conv + ((size_t)b * 3 + idx) * 1024 + ch); e[w][0] = x.x; e[w][1] = x.y; e[w][2] = x.z; e[w][3] = x.w; }
            else { const u32x2 x = *(const u32x2*)(PROJ + (rb + idx - 3) * NPROJ + 4096 + ch); e[w][0] = bflo(x.x); e[w][1] = bfhi(x.x); e[w][2] = bflo(x.y); e[w][3] = bfhi(x.y); } }
        float xc[4];
#pragma unroll
        for (int i = 0; i < 4; ++i) { float cv = a.conv_b[ch + i];
#pragma unroll
            for (int w = 0; w < 4; ++w) cv += a.conv_w[w * 1024 + ch + i] * e[w][i];
            xc[i] = cv * sigmoidf_(cv); }
#pragma unroll
        for (int j = 0; j < 4; ++j) { float q = 0.f, k = 0.f, v = 0.f;
#pragma unroll
            for (int i = 0; i < 4; ++i) { q += xc[i] * a.wq[gg * 16 + 4 * i + j]; k += xc[i] * a.wk[gg * 16 + 4 * i + j]; v += e[3][i] * a.wv[gg * 16 + 4 * i + j]; }
            sxc[t * 256 + 4 * g + j] = xc[j]; sq[t * 256 + 4 * g + j] = q; sk[t * 256 + 4 * g + j] = k * 0.0625f; sv[t * 256 + 4 * g + j] = v; }
        if (t == 3) {
#pragma unroll
            for (int j = 0; j < 3; ++j) *(f32x4*)(a.out + O_VS + ((size_t)b * 3 + j) * 1024 + ch) = (f32x4){e[1 + j][0], e[1 + j][1], e[1 + j][2], e[1 + j][3]};
        }
    }
    float fd[4], iw[4], mt[4];
    { float m = a.st_m[b * 4 + h];
#pragma unroll
      for (int t = 0; t < 4; ++t) { const float ig = GATE[(rb + t) * 8 + h], lf = GATE[(rb + t) * 8 + 4 + h]; const float mn = fmaxf(lf + m, ig);
          fd[t] = __expf(lf + m - mn); iw[t] = __expf(ig - mn); mt[t] = mn; m = mn; } }
    __syncthreads();
    if (tid < 256) { float n = a.st_n[((size_t)b * 4 + h) * 256 + tid]; float pd[4];
#pragma unroll
        for (int t = 0; t < 4; ++t) { n = fd[t] * n + iw[t] * sk[t * 256 + tid]; pd[t] = sq[t * 256 + tid] * n; }
        a.out[O_NS + ((size_t)b * 4 + h) * 256 + tid] = n;
#pragma unroll
        for (int t = 0; t < 4; ++t) { const float s = wave_sum(pd[t]); if (lane == 0) sDen[wave * 4 + t] = s; } }
    f32x4 vv[4], pn[4];
#pragma unroll
    for (int t = 0; t < 4; ++t) { vv[t] = *(const LAS f32x4*)(sv + t * 256 + 4 * vq) * iw[t]; pn[t] = (f32x4){0.f, 0.f, 0.f, 0.f}; }
#define SM_BATCH(C, bi, reload) do { \
        _Pragma("unroll") for (int i = 0; i < 8; ++i) { const int k = kr + 8 * (8 * (bi) + i); \
            _Pragma("unroll") for (int t = 0; t < 4; ++t) { C[i] = C[i] * fd[t] + vv[t] * sk[t * 256 + k]; pn[t] += C[i] * sq[t * 256 + k]; } \
            __builtin_nontemporal_store(C[i], (f32x4*)(C1 + (size_t)k * 256 + 4 * vq)); \
            if (reload) C[i] = __builtin_nontemporal_load((const f32x4*)(C0 + (size_t)(kr + 8 * (8 * ((bi) + 2) + i)) * 256 + 4 * vq)); } } while (0)
    SM_BATCH(Ca, 0, true); SM_BATCH(Cb, 1, true); SM_BATCH(Ca, 2, false); SM_BATCH(Cb, 3, false);
#undef SM_BATCH
#pragma unroll
    for (int t = 0; t < 4; ++t) *(LAS f32x4*)(sPN + (kr * 4 + t) * 256 + 4 * vq) = pn[t];
    __syncthreads();
    if (wave < 4) { const int t = wave;
        const float den = sDen[t] + sDen[4 + t] + sDen[8 + t] + sDen[12 + t];
        const float hden = fmaxf(fabsf(den), __expf(-mt[t]));
        float hm[4]; float ss = 0.f;
#pragma unroll
        for (int j = 0; j < 4; ++j) { const int v = lane + 64 * j; float s = 0.f;
#pragma unroll
            for (int r = 0; r < 8; ++r) s += sPN[(r * 4 + t) * 256 + v];
            hm[j] = s / hden * bf2f(PROJ[(rb + t) * NPROJ + 6144 + h * 256 + v]); ss += hm[j] * hm[j]; }
        ss = wave_sum(ss); const float rn = 1.0f / sqrtf(ss * (1.f / 256.f) + EPS);
#pragma unroll
        for (int j = 0; j < 4; ++j) { const int v = lane + 64 * j, col = h * 256 + v;
            const float z = bf2f(PROJ[(rb + t) * NPROJ + 5120 + col]);
            ((bf16_t*)(a.ws + WS_MIX))[(rb + t) * DMIX + 1024 + col] = f2bf((hm[j] * rn * a.mnorm_g[col] + a.skip[col] * sxc[t * 256 + v]) * z); }
        if (t == 3 && lane == 0) a.out[O_MS + b * 4 + h] = mt[3];
    }
}

typedef float f32x4v __attribute__((ext_vector_type(4)));
__device__ __forceinline__ void small_gemm_out(const Args& a, int vcu, int G, int wave, int lane, unsigned* cnt_s) {
    const bf16_t* MIX = (const bf16_t*)(a.ws + WS_MIX); const bf16_t* WoutT = (const bf16_t*)(a.ws + WS_WOUT); const float* MOD = (const float*)(a.ws + WS_MOD);
    const int r = lane & 15, kq = lane >> 4;
    for (int t = vcu * NWAVES + wave; t < 32 * 64; t += G * NWAVES) {
        const int mt = t >> 6, nt = t & 63;
        const bf16_t* ap = MIX + (size_t)(MP + 16 * mt + r) * DMIX + 8 * kq;
        const bf16_t* bp = WoutT + (size_t)(16 * nt + r) * DMIX + 8 * kq;
        f32x4v acc = {0.f, 0.f, 0.f, 0.f};
        bf16x8 af[8], bfr[8], an[8], bn[8];
#pragma unroll
        for (int j = 0; j < 8; ++j) { af[j] = *(const bf16x8*)(ap + 32 * j); bfr[j] = *(const bf16x8*)(bp + 32 * j); }
#pragma unroll 1
        for (int k0 = 0; k0 < DMIX; k0 += 512) {
#pragma unroll
            for (int j = 0; j < 8; ++j) { an[j] = *(const bf16x8*)(ap + k0 + 256 + 32 * j); bn[j] = *(const bf16x8*)(bp + k0 + 256 + 32 * j); }
#pragma unroll
            for (int j = 0; j < 8; ++j) acc = __builtin_amdgcn_mfma_f32_16x16x32_bf16(af[j], bfr[j], acc, 0, 0, 0);
            const int kn = (k0 + 512 < DMIX) ? k0 + 512 : k0;
#pragma unroll
            for (int j = 0; j < 8; ++j) { af[j] = *(const bf16x8*)(ap + kn + 32 * j); bfr[j] = *(const bf16x8*)(bp + kn + 32 * j); }
#pragma unroll
            for (int j = 0; j < 8; ++j) acc = __builtin_amdgcn_mfma_f32_16x16x32_bf16(an[j], bn[j], acc, 0, 0, 0);
        }
        const int col = 16 * nt + r;
#pragma unroll
        for (int i = 0; i < 4; ++i) { const int row = 16 * mt + 4 * kq + i;
            const float g = MOD[(size_t)(BP + (row >> 2)) * 3072 + 2048 + col];
            const float v = a.x_s[(size_t)row * DM + col] + g * acc[i];
            if (cnt_s) store_wt_f32(a.out + O_Y + (size_t)(MP + row) * DM + col, v); else a.out[O_Y + (size_t)(MP + row) * DM + col] = v; }
        if (cnt_s) { asm volatile("s_waitcnt vmcnt(0)" ::: "memory"); if (lane == 0) (void)xb_add(cnt_s + 64 * mt, 1u); }
    }
}
__device__ __forceinline__ void rms_row_inplace(const Args& a, size_t r, int lane) {
    float* yr = a.out + O_Y + r * DM;
    f32x4 v[4]; float s = 0.f;
#pragma unroll
    for (int j = 0; j < 4; ++j) { v[j] = *(const f32x4*)(yr + 4 * lane + 256 * j); s += (v[j].x * v[j].x + v[j].y * v[j].y) + (v[j].z * v[j].z + v[j].w * v[j].w); }
    const float rinv = 1.0f / sqrtf(wave_sum(s) * (1.f / DM) + EPS);
#pragma unroll
    for (int j = 0; j < 4; ++j) { const f32x4 g = *(const f32x4*)(a.final_g + 4 * lane + 256 * j); *(f32x4*)(yr + 4 * lane + 256 * j) = v[j] * rinv * g; }
}

__device__ __forceinline__ void phase5(const Args& a, int vcu, int G, int wave, int lane) {
    const int gw = vcu * NWAVES + wave, NGW = G * NWAVES;
    f32x4 nx[4];
    if (gw < MT) {
#pragma unroll
        for (int j = 0; j < 4; ++j) nx[j] = *(const f32x4*)(a.out + O_Y + (size_t)gw * DM + 4 * lane + 256 * j);
    }
    f32x4 g[4];
#pragma unroll
    for (int j = 0; j < 4; ++j) g[j] = *(const f32x4*)(a.final_g + 4 * lane + 256 * j);
    for (int r = gw; r < MT; r += NGW) {
        float* yr = a.out + O_Y + (size_t)r * DM;
        f32x4 v[4]; float s = 0.f;
#pragma unroll
        for (int j = 0; j < 4; ++j) { v[j] = nx[j]; s += (v[j].x * v[j].x + v[j].y * v[j].y) + (v[j].z * v[j].z + v[j].w * v[j].w); }
        if (r + NGW < MT) {
#pragma unroll
            for (int j = 0; j < 4; ++j) nx[j] = *(const f32x4*)(yr + (size_t)NGW * DM + 4 * lane + 256 * j);
        }
        const float rinv = 1.0f / sqrtf(wave_sum(s) * (1.f / DM) + EPS);
#pragma unroll
        for (int j = 0; j < 4; ++j) *(f32x4*)(yr + 4 * lane + 256 * j) = v[j] * rinv * g[j];
    }
}

__global__ void __launch_bounds__(NTHR, 2) mk_fwd(Args a) {
    extern __shared__ __attribute__((aligned(16))) unsigned char lds_raw[];
    LAS unsigned char* lds = (LAS unsigned char*)lds_raw;
    volatile LAS unsigned* MISC = (volatile LAS unsigned*)(lds + MISC_OFF);
    int tid = threadIdx.x, lane = tid & 63, wave = __builtin_amdgcn_readfirstlane(tid >> 6);
#define RELAUNDER() do { asm volatile("" : "+v"(tid)); lane = tid & 63; wave = __builtin_amdgcn_readfirstlane(tid >> 6); } while (0)
    const int G = gridDim.x; const int bx = blockIdx.x; const int vcu = (G % 8 == 0) ? (bx % 8) * (G / 8) + bx / 8 : bx;
    for (int u = tid; u < (LDS_BYTES - MISC_OFF) / 4; u += NTHR) ((LAS unsigned*)(lds + MISC_OFF))[u] = 0u;
    __syncthreads();
    XcdBarrier bar = xcd_barrier_post((unsigned*)(a.ws + WS_CTL) + CW_BAR, MISC + 8);

    phase0(a, lds, vcu, G, tid, wave, lane);
    xcd_barrier(bar); RELAUNDER();
    phase1(a, lds, vcu, G, tid, wave, lane);
    xcd_barrier(bar); RELAUNDER();
    {
        pg8::Gemm g{(const bf16_t*)(a.ws + WS_XN), (const bf16_t*)(a.ws + WS_WIN), MT, NPROJ, DM};
        pg8::StaticOrder S; S.init(MT, NPROJ, G, bx);
        EpiProj E{(bf16_t*)(a.ws + WS_PROJ), (float*)(a.ws + WS_LOGF), (float*)(a.ws + WS_LOGFS), a.b_in, a.lb_logits};
        pg8::gemm_phase<EpiProj, pg8::StaticOrder, true, true>(lds, g, S, E);
    }
    xcd_barrier(bar); RELAUNDER();
    for (int t = vcu; t < 3072; t += G) {
        RELAUNDER();
        const int tn = -1;
        if (t < 1024) p3a_mlstm(a, lds, t >> 7, (t >> 2) & 31, t & 3, tid, wave, lane, tn);
        else { const int u = t - 1024; p3a_hgrn(a, lds, u >> 8, (u >> 3) & 31, u & 7, tid, wave, lane, tn); }
    }
    xcd_barrier(bar); RELAUNDER();
    const int rid = bx;
    if (rid < 96) p3b_mlstm<0>(a, lds, rid / 12, (rid / 3) & 3, rid % 3, tid, wave, lane);
    else if (rid < 192) { const int u = rid - 96; p3b_hgrn<0>(a, lds, u / 12, (u / 3) & 3, u % 3, tid, wave, lane);
        RELAUNDER(); { const int t = 128 + u; p3b_sample_mlstm(a, lds, t >> 2, t & 3, tid, wave, lane); } }
    else {
        for (int k = 0; k < 2; ++k) { RELAUNDER(); const int t = (rid - 192) * 2 + k; p3b_sample_mlstm(a, lds, t >> 2, t & 3, tid, wave, lane); }
    }
    xcd_barrier(bar); RELAUNDER();
    if (rid < 128) p3b_mlstm<1>(a, lds, rid >> 4, (rid >> 2) & 3, rid & 3, tid, wave, lane);
    else { const int u = rid - 128; p3b_hgrn<1>(a, lds, u >> 4, (u >> 2) & 3, u & 3, tid, wave, lane); }
    for (;;) {
        RELAUNDER();
        __syncthreads();
        if (tid == 0) MISC[16] = 224u + __hip_atomic_fetch_add((unsigned*)(a.ws + WS_CTL) + CW_QUEUE, 1u, __ATOMIC_RELAXED, __HIP_MEMORY_SCOPE_AGENT);
        __syncthreads();
        const int t = (int)MISC[16];
        if (t >= 768) break;
        if (t < 512) p3b_sample_mlstm(a, lds, t >> 2, t & 3, tid, wave, lane);
        else { const int u = t - 512; p3b_sample_hgrn4(a, lds, u >> 1, u & 1, tid, wave, lane); }
    }
    xcd_barrier(bar); RELAUNDER();
    {
        pg8::Gemm g{(const bf16_t*)(a.ws + WS_MIX), (const bf16_t*)(a.ws + WS_WOUT), MP, DM, DMIX};
        pg8::StaticOrder S; S.init(MP, DM, G, bx);
        unsigned* ctl = (unsigned*)(a.ws + WS_CTL);
        if (G == 256) {
            EpiOutFused E{a.out + O_Y, a.x_p, (const float*)(a.ws + WS_MOD), a.final_g, (float*)(a.ws + WS_STATS), ctl + CW_PANEL};
            pg8::gemm_phase<EpiOutFused, pg8::StaticOrder, true, true>(lds, g, S, E);
            small_gemm_out(a, vcu, G, wave, lane, ctl + CW_SROW);
            { const int t = vcu * NWAVES + wave;
              if ((t & 3) == 0) { unsigned* cs = ctl + CW_SROW + 64 * (t >> 6); unsigned sp = 0;
                  while (xb_ld(cs) < 64u) { __builtin_amdgcn_s_sleep(1); if (++sp > (1u << 20)) break; }
                  __builtin_amdgcn_fence(__ATOMIC_ACQUIRE, "agent"); asm volatile("s_waitcnt vmcnt(0)" ::: "memory");
                  rms_row_inplace(a, (size_t)MP + (t >> 2), lane); } }
        } else {
            EpiOut E{a.out + O_Y, a.x_p, a.x_s, (const float*)(a.ws + WS_MOD)};
            pg8::gemm_phase<EpiOut, pg8::StaticOrder, true, true>(lds, g, S, E);
            small_gemm_out(a, vcu, G, wave, lane, nullptr);
            xcd_barrier(bar); RELAUNDER();
            phase5(a, vcu, G, wave, lane);
        }
    }
}

extern "C" void kernel_launch(void* const* d_in, const int* in_sizes, int n_in, void* d_out, int out_size, void* d_ws, size_t ws_size, hipStream_t stream) {
    static int grid = 0;
    if (grid == 0) {
        if (n_in != 25 || (size_t)out_size != O_END || ws_size < WS_END2) { fprintf(stderr, "kernel_launch: unexpected shapes: n_in %d out %d (want %zu) ws %zu (want %zu)\n", n_in, out_size, (size_t)O_END, ws_size, (size_t)WS_END); grid = -1; return; }
        int dev = 0, cus = 0, per_cu = 0;
        if (hipGetDevice(&dev) != hipSuccess || hipDeviceGetAttribute(&cus, hipDeviceAttributeMultiprocessorCount, dev) != hipSuccess) { grid = -1; return; }
        if (hipFuncSetAttribute((const void*)mk_fwd, hipFuncAttributeMaxDynamicSharedMemorySize, LDS_BYTES) != hipSuccess) { fprintf(stderr, "hipFuncSetAttribute failed\n"); grid = -1; return; }
        if (hipOccupancyMaxActiveBlocksPerMultiprocessor(&per_cu, (const void*)mk_fwd, NTHR, LDS_BYTES) != hipSuccess || per_cu < 1) { fprintf(stderr, "occupancy query: %d\n", per_cu); grid = -1; return; }
        (void)hipGetLastError();
        grid = cus;
    }
    if (grid < 0) return;
    (void)hipMemsetAsync((char*)d_ws + WS_CTL, 0, CTL_ZERO_BYTES, stream);
    Args a{};
    const float** ap = (const float**)&a;
    for (int i = 0; i < 25; ++i) ap[i] = (const float*)d_in[i];
    a.out = (float*)d_out; a.ws = (unsigned char*)d_ws;
    void* args[] = {&a};
    hipError_t e = hipLaunchCooperativeKernel((const void*)mk_fwd, dim3(grid), dim3(NTHR), args, LDS_BYTES, stream);
    if (e != hipSuccess) fprintf(stderr, "cooperative launch failed: %s (grid %d)\n", hipGetErrorString(e), grid);
}
```

```cpp
#include <hip/hip_runtime.h>
#include <cstdio>
#include <cstdint>

#define LAS __attribute__((address_space(3)))
typedef unsigned short bf16_t;
typedef short bf16x8 __attribute__((ext_vector_type(8)));
typedef short s16x4 __attribute__((ext_vector_type(4)));
typedef float f32x4 __attribute__((ext_vector_type(4)));
typedef float f32x16 __attribute__((ext_vector_type(16)));
typedef unsigned u32x4 __attribute__((ext_vector_type(4)));
typedef unsigned u32x2 __attribute__((ext_vector_type(2)));

namespace pg8 {
constexpr int BM = 256, BK = 64, HALF = 128, HTB = HALF * BK * 2, STAGE_BYTES = 8 * HTB, NXCD = 8, WGM = 8;
__host__ __device__ __forceinline__ int lds_byte(int r, int c) { const int st = (r >> 4) * 2 + (c >> 5), rr = r & 15, cc = c & 31, ob = rr * 64 + cc * 2; return st * 1024 + (ob ^ (((ob >> 9) & 1) << 5)); }
__host__ __device__ __forceinline__ void stage_rc(int b, int& R, int& C) { const int st = b / 1024, sb = b % 1024, swz = sb ^ (((sb >> 9) & 1) << 5); R = (st >> 1) * 16 + swz / 64; C = (st & 1) * 32 + (swz % 64) / 2; }
__host__ __device__ __forceinline__ int perm32(int rho) { const int n = rho >> 4, i = rho & 15; return 8 * (i >> 2) + 4 * n + (i & 3); }
struct Unit { int pm, pn; };
struct Gemm { const bf16_t* A; const bf16_t* Bt; int M, N, K; };
struct StaticOrder {
    int nM, nN, nwg, G, c;
    __host__ __device__ void init(int M, int N, int G_, int c_) { nM = M / BM; nN = N / BM; nwg = nM * nN; G = G_; c = c_; }
    __host__ __device__ bool next(int i, Unit& u) const {
        const long L = (long)i * G + c; if (L >= nwg) return false;
        int wgid = (int)L; { const int q = nwg / NXCD, r = nwg % NXCD, xcd = wgid % NXCD, off = wgid / NXCD; wgid = (xcd < r ? xcd * (q + 1) : r * (q + 1) + (xcd - r) * q) + off; }
        const int nig = WGM * nN, gid = wgid / nig, fm = gid * WGM, gsz = (nM - fm) < WGM ? (nM - fm) : WGM;
        u.pm = fm + ((wgid % nig) % gsz); u.pn = (wgid % nig) / gsz; return true;
    }
};
template <class Epi, class Sched, bool ALIGN_EPI = false, bool SP2 = false>
__device__ __forceinline__ void gemm_phase(LAS unsigned char* lds, const Gemm g, const Sched& S, const Epi& E) {
    const int tid = threadIdx.x, wid = __builtin_amdgcn_readfirstlane(tid >> 6), lane = tid & 63, wr = wid >> 2, wc = wid & 3, fr = lane & 15, fq = lane >> 4;
    const int K = g.K, nt = K / BK;
    unsigned voffA[2], voffB[2];
#pragma unroll
    for (int i = 0; i < 2; ++i) { int R, C; stage_rc(tid * 16 + i * 8192, R, C); const int Rb = Epi::PERM ? ((R & ~31) + perm32(R & 31)) : R;
        voffA[i] = (unsigned)(R * K + C) * 2u; voffB[i] = (unsigned)(Rb * K + C) * 2u; }
    const size_t kstep = (size_t)(BK * 2);
    const size_t hstep = (size_t)HALF * K * 2;
    const size_t tstep = 2 * hstep;
    const unsigned ldsw = (unsigned)wid * 1024u;
    const int aoff = lds_byte(wr * 64 + fr, fq * 8), boff = lds_byte(wc * 32 + fr, fq * 8);
#define PG8_SA(b, h) (((b) * 2 + (h)) * HTB)
#define PG8_SB(b, h) ((4 + (b) * 2 + (h)) * HTB)
#define PG8_STAGE(bufoff, gbase, voff) do { _Pragma("unroll") for (int _i = 0; _i < 2; ++_i) \
        __builtin_amdgcn_global_load_lds((const unsigned*)((const char*)(gbase) + (voff)[_i]), (LAS unsigned*)(lds + (bufoff) + ldsw + _i * 8192), 16, 0, 0); } while (0)
#define PG8_LDA(dst, b, h) do { _Pragma("unroll") for (int m = 0; m < 4; ++m) _Pragma("unroll") for (int k = 0; k < 2; ++k) dst[m][k] = *(const LAS bf16x8*)(lds + PG8_SA(b, h) + aoff + m * 2048 + k * 1024); } while (0)
#define PG8_LDB(dst, b, h) do { _Pragma("unroll") for (int n = 0; n < 2; ++n) _Pragma("unroll") for (int k = 0; k < 2; ++k) dst[n][k] = *(const LAS bf16x8*)(lds + PG8_SB(b, h) + boff + n * 2048 + k * 1024); } while (0)
#define PG8_MMA(ai, bj, At, Bt) do { __builtin_amdgcn_s_setprio(1); _Pragma("unroll") for (int m = 0; m < 4; ++m) _Pragma("unroll") for (int n = 0; n < 2; ++n) _Pragma("unroll") for (int k = 0; k < 2; ++k) \
        acc[ai][bj][m][n] = __builtin_amdgcn_mfma_f32_16x16x32_bf16(Bt[n][k], At[m][k], acc[ai][bj][m][n], 0, 0, 0); __builtin_amdgcn_s_setprio(0); } while (0)
#define PG8_WAIT_V(n) asm volatile("s_waitcnt vmcnt(" #n ")" ::: "memory")
#define PG8_WAIT_L(n) asm volatile("s_waitcnt lgkmcnt(" #n ")" ::: "memory")
#define PG8_BAR __builtin_amdgcn_s_barrier()
#define PG8_SCHED __builtin_amdgcn_sched_barrier(0)
    Unit cur, nxt; int ui = 0;
    if (!S.next(0, cur)) return;
    f32x4 acc[2][2][4][2];
#pragma unroll
    for (int a = 0; a < 2; ++a)
#pragma unroll
        for (int b = 0; b < 2; ++b)
#pragma unroll
            for (int m = 0; m < 4; ++m)
#pragma unroll
                for (int n = 0; n < 2; ++n) acc[a][b][m][n] = (f32x4){0.f, 0.f, 0.f, 0.f};
    bf16x8 At[4][2], B0[2][2], B1[2][2];
    const char* cA = (const char*)g.A + (size_t)cur.pm * tstep; const char* cB = (const char*)g.Bt + (size_t)cur.pn * tstep;
    if constexpr (SP2) {
        PG8_STAGE(PG8_SB(0, 0), cB, voffB); PG8_STAGE(PG8_SB(0, 1), cB + hstep, voffB); PG8_STAGE(PG8_SA(0, 0), cA, voffA); PG8_STAGE(PG8_SA(0, 1), cA + hstep, voffA);
        if (wr == 1) PG8_BAR;
        PG8_WAIT_V(2); PG8_BAR;
        PG8_STAGE(PG8_SB(1, 0), cB + kstep, voffB); PG8_STAGE(PG8_SA(1, 0), cA + kstep, voffA); PG8_STAGE(PG8_SB(1, 1), cB + hstep + kstep, voffB);
        PG8_WAIT_V(6); PG8_BAR;
    } else {
        PG8_STAGE(PG8_SB(0, 0), cB, voffB); PG8_STAGE(PG8_SA(0, 0), cA, voffA); PG8_STAGE(PG8_SB(0, 1), cB + hstep, voffB); PG8_STAGE(PG8_SA(0, 1), cA + hstep, voffA);
        if (wr == 1) PG8_BAR;
        PG8_WAIT_V(4); PG8_BAR;
        PG8_STAGE(PG8_SB(1, 0), cB + kstep, voffB); PG8_STAGE(PG8_SA(1, 0), cA + kstep, voffA); PG8_STAGE(PG8_SB(1, 1), cB + hstep + kstep, voffB);
        PG8_WAIT_V(6); PG8_BAR;
    }
    for (;;) {
        const bool has_next = S.next(ui + 1, nxt);
        const char* nA = has_next ? (const char*)g.A + (size_t)nxt.pm * tstep : cA; const char* nB = has_next ? (const char*)g.Bt + (size_t)nxt.pn * tstep : cB;
        for (int t = 0; t < nt; t += 2) {
            const bool last = (t == nt - 2);
            const char* a1 = cA + (size_t)(t + 1) * kstep;
            const char* a2 = last ? nA : cA + (size_t)(t + 2) * kstep; const char* b2 = last ? nB : cB + (size_t)(t + 2) * kstep;
            const char* a3 = a2 + kstep; const char* b3 = b2 + kstep;
            if constexpr (SP2) {
            PG8_LDB(B0, 0, 0); PG8_LDB(B1, 0, 1); PG8_SCHED; PG8_LDA(At, 0, 0); PG8_STAGE(PG8_SA(1, 1), a1 + hstep, voffA);
            PG8_WAIT_V(8); PG8_WAIT_L(0); PG8_BAR; PG8_MMA(0, 0, At, B0); PG8_MMA(0, 1, At, B1); PG8_BAR; PG8_SCHED;
            PG8_LDA(At, 0, 1); PG8_STAGE(PG8_SB(0, 0), b2, voffB); PG8_STAGE(PG8_SB(0, 1), b2 + hstep, voffB); PG8_STAGE(PG8_SA(0, 0), a2, voffA);
            PG8_WAIT_V(8); PG8_WAIT_L(0); PG8_BAR; PG8_MMA(1, 0, At, B0); PG8_MMA(1, 1, At, B1); PG8_BAR; PG8_SCHED;
            PG8_LDB(B0, 1, 0); PG8_LDB(B1, 1, 1); PG8_SCHED; PG8_LDA(At, 1, 0); PG8_STAGE(PG8_SA(0, 1), a2 + hstep, voffA);
            PG8_WAIT_V(8); PG8_WAIT_L(0); PG8_BAR; PG8_MMA(0, 0, At, B0); PG8_MMA(0, 1, At, B1); PG8_BAR; PG8_SCHED;
            PG8_LDA(At, 1, 1); PG8_STAGE(PG8_SB(1, 0), b3, voffB); PG8_STAGE(PG8_SB(1, 1), b3 + hstep, voffB); PG8_STAGE(PG8_SA(1, 0), a3, voffA);
            PG8_WAIT_V(8); PG8_WAIT_L(0); PG8_BAR; PG8_MMA(1, 0, At, B0); PG8_MMA(1, 1, At, B1); PG8_BAR; PG8_SCHED;
            } else {
            PG8_LDB(B0, 0, 0); PG8_SCHED; PG8_LDA(At, 0, 0); PG8_STAGE(PG8_SA(1, 1), a1 + hstep, voffA);
            PG8_WAIT_L(8); PG8_BAR; PG8_WAIT_L(0); PG8_MMA(0, 0, At, B0); PG8_BAR; PG8_SCHED;
            PG8_LDB(B1, 0, 1); PG8_STAGE(PG8_SB(0, 0), b2, voffB);
            PG8_BAR; PG8_WAIT_L(0); PG8_MMA(0, 1, At, B1); PG8_BAR;
            PG8_LDA(At, 0, 1); PG8_STAGE(PG8_SA(0, 0), a2, voffA);
            PG8_BAR; PG8_WAIT_L(0); PG8_MMA(1, 0, At, B0); PG8_BAR; PG8_SCHED;
            PG8_STAGE(PG8_SB(0, 1), b2 + hstep, voffB);
            PG8_WAIT_V(6); PG8_BAR; PG8_MMA(1, 1, At, B1); PG8_BAR;
            PG8_LDB(B0, 1, 0); PG8_SCHED; PG8_LDA(At, 1, 0); PG8_STAGE(PG8_SA(0, 1), a2 + hstep, voffA);
            PG8_WAIT_L(8); PG8_BAR; PG8_WAIT_L(0); PG8_MMA(0, 0, At, B0); PG8_BAR; PG8_SCHED;
            PG8_LDB(B1, 1, 1); PG8_STAGE(PG8_SB(1, 0), b3, voffB);
            PG8_BAR; PG8_WAIT_L(0); PG8_MMA(0, 1, At, B1); PG8_BAR;
            PG8_LDA(At, 1, 1); PG8_STAGE(PG8_SA(1, 0), a3, voffA);
            PG8_BAR; PG8_WAIT_L(0); PG8_MMA(1, 0, At, B0); PG8_BAR; PG8_SCHED;
            PG8_STAGE(PG8_SB(1, 1), b3 + hstep, voffB);
            PG8_WAIT_V(6); PG8_BAR; PG8_MMA(1, 1, At, B1); PG8_BAR;
            }
        }
        if constexpr (ALIGN_EPI) { if (wr == 0) PG8_BAR; }
        if constexpr (!Epi::AFTER_DRAIN) E(acc, cur, wr, wc, fr, fq);
        if (!has_next) break;
#pragma unroll
        for (int a = 0; a < 2; ++a)
#pragma unroll
            for (int b = 0; b < 2; ++b)
#pragma unroll
                for (int m = 0; m < 4; ++m)
#pragma unroll
                    for (int n = 0; n < 2; ++n) acc[a][b][m][n] = (f32x4){0.f, 0.f, 0.f, 0.f};
        cur = nxt; cA = nA; cB = nB; ++ui;
        if constexpr (ALIGN_EPI) { if (wr == 1) PG8_BAR; }
    }
    PG8_WAIT_V(0);
    if constexpr (!ALIGN_EPI) { if (wr == 0) PG8_BAR; }
    PG8_BAR;
    if constexpr (Epi::AFTER_DRAIN) E.fused(acc, cur, wr, wc, fr, fq, lds, wid, lane);
#undef PG8_SA
#undef PG8_SB
#undef PG8_STAGE
#undef PG8_LDA
#undef PG8_LDB
#undef PG8_MMA
#undef PG8_WAIT_V
#undef PG8_WAIT_L
#undef PG8_BAR
#undef PG8_SCHED
}
}

constexpr int NWAVES = 8, NTHR = 512;
constexpr int DM = 1024;
constexpr int BP = 8, TP = 2048, MP = BP * TP;
constexpr int BS = 128, TS = 4, MS = BS * TS;
constexpr int MT = MP + MS;
constexpr int NMOD = BP + BS;
constexpr int WIN_LD = 7176, NPROJ = 7168, DMIX = 2048;
constexpr int NCH = TP / 64;
constexpr float EPS = 1e-6f;

constexpr size_t SEGSZ = (size_t)MP * 1024;
constexpr size_t PS_OFF = 7 * SEGSZ;
__device__ __forceinline__ size_t hg_tile(int seg, int b, int c, int head) { return (size_t)seg * SEGSZ + ((size_t)((b * NCH + c) * 8 + head) << 13); }
__device__ __forceinline__ size_t ml_tile(int seg, int b, int c, int h) { return (size_t)seg * SEGSZ + ((size_t)((b * NCH + c) * 4 + h) << 14); }
constexpr size_t MiB = 1u << 20;
constexpr size_t WS_CTL = 0, CTL_ZERO_BYTES = 64 * 1024;
constexpr size_t WS_WIN = 2 * MiB;
constexpr size_t WS_WOUT = 16 * MiB;
constexpr size_t WS_MOD = 20 * MiB;
constexpr size_t WS_GATE = 22 * MiB;
constexpr size_t WS_DEC = 23 * MiB;
constexpr size_t WS_BT = 24 * MiB;
constexpr size_t WS_RS = 24 * MiB + 512 * 1024;
constexpr size_t WS_CSK = 25 * MiB;
constexpr size_t WS_RL = 26 * MiB;
constexpr size_t WS_GW = 26 * MiB + 64 * 1024;
constexpr size_t WS_LOGFS = 26 * MiB + 512 * 1024;
constexpr size_t WS_AH = 30 * MiB;
constexpr size_t WS_AM = 46 * MiB;
constexpr size_t WS_XN = 54 * MiB;
constexpr size_t WS_QM = WS_XN;
constexpr size_t WS_PROJ = 88 * MiB;
constexpr size_t WS_LOGF = 320 * MiB;
constexpr size_t WS_MIX = WS_LOGF;
constexpr size_t WS_KM = 388 * MiB, WS_VM = 420 * MiB, WS_XC = 452 * MiB;
constexpr size_t WS_END = 484 * MiB;
constexpr size_t O_Y = 0;
constexpr size_t O_HP = (size_t)MT * DM;
constexpr size_t O_CP = O_HP + (size_t)BP * 8 * 128 * 128;
constexpr size_t O_NP = O_CP + (size_t)BP * 4 * 256 * 256;
constexpr size_t O_MP = O_NP + (size_t)BP * 4 * 256;
constexpr size_t O_VP = O_MP + (size_t)BP * 4;
constexpr size_t O_HS = O_VP + (size_t)BP * 3 * 1024;
constexpr size_t O_CS = O_HS + (size_t)BS * 8 * 128 * 128;
constexpr size_t O_NS = O_CS + (size_t)BS * 4 * 256 * 256;
constexpr size_t O_MS = O_NS + (size_t)BS * 4 * 256;
constexpr size_t O_VS = O_MS + (size_t)BS * 4;
constexpr size_t O_END = O_VS + (size_t)BS * 3 * 1024;

constexpr int RING_BYTES = 131072, LDS_BYTES = 147456, MISC_OFF = LDS_BYTES - 1024;
constexpr int CW_BAR = 4096, CW_QUEUE = 2048, CW_PANEL = 8192, CW_SROW = 12288;

#define LDS_WAIT() asm volatile("s_waitcnt lgkmcnt(0)" ::: "memory")
__device__ __forceinline__ float bf2f(unsigned u16) { return __uint_as_float(u16 << 16); }
__device__ __forceinline__ float bflo(unsigned w) { return __uint_as_float(w << 16); }
__device__ __forceinline__ float bfhi(unsigned w) { return __uint_as_float(w & 0xffff0000u); }
typedef __bf16 bf16v2_t __attribute__((ext_vector_type(2)));
__device__ __forceinline__ unsigned pk2(float lo, float hi) { bf16v2_t v; v[0] = (__bf16)lo; v[1] = (__bf16)hi; return __builtin_bit_cast(unsigned, v); }
__device__ __forceinline__ bf16_t f2bf(float f) { return __builtin_bit_cast(bf16_t, (__bf16)f); }
__device__ __forceinline__ float wave_sum(float v) {
#pragma unroll
    for (int o = 1; o < 64; o <<= 1) v += __shfl_xor(v, o);
    return v;
}
__device__ __forceinline__ float sigmoidf_(float x) { return __builtin_amdgcn_rcpf(1.f + __expf(-x)); }

#define XB_TMO      128
#define XB_XCNT(j)  (256  + 64 * (j))
#define XB_XSUB(j)  (1280 + 64 * (j))
#define XB_XGEN(j)  (2304 + 64 * (j))
#define XB_TOP      3328
#define XB_TOPGEN   3392
#define XCD_BAR_WORDS 3456
#define XB_SPIN_CAP (1u << 18)
__device__ __forceinline__ unsigned xb_ld(unsigned* p)              { return __hip_atomic_load(p, __ATOMIC_RELAXED, __HIP_MEMORY_SCOPE_AGENT); }
__device__ __forceinline__ unsigned xb_add(unsigned* p, unsigned v) { return __hip_atomic_fetch_add(p, v, __ATOMIC_RELAXED, __HIP_MEMORY_SCOPE_AGENT); }
__device__ __forceinline__ unsigned xb_xcc_id() { return (unsigned)__builtin_amdgcn_s_getreg((3 << 11) | 20) & 0xFu; }
#define XB_SPIN(cond, bar) do { unsigned _sp = 0; while (cond) { __builtin_amdgcn_s_sleep(1); \
    if ((++_sp & 255u) == 0u) { if (xb_ld(&(bar)[XB_TMO])) break; if (_sp > XB_SPIN_CAP) { atomicAdd(&(bar)[XB_TMO], 1u); break; } } } } while (0)
struct XcdBarrier { unsigned* bar; unsigned x; volatile LAS unsigned* st; };
__device__ __forceinline__ XcdBarrier xcd_barrier_post(unsigned* bar, volatile LAS unsigned* st) {
    XcdBarrier b; b.bar = bar; b.x = xb_xcc_id(); b.st = st;
    if (threadIdx.x == 0) (void)xb_add(&bar[XB_XCNT(b.x)], 1u);
    return b;
}
__device__ __forceinline__ void xcd_barrier_complete(unsigned* bar, unsigned x, unsigned& nloc, unsigned& nx) {
    const unsigned G = gridDim.x * gridDim.y * gridDim.z;
    unsigned sum, cnt, mine, sp = 0u;
    for (;;) {
        sum = 0u; cnt = 0u; mine = 0u;
#pragma unroll
        for (unsigned j = 0; j < 16; ++j) { const unsigned c = xb_ld(&bar[XB_XCNT(j)]); sum += c; cnt += (c > 0u) ? 1u : 0u; mine = (j == x) ? c : mine; }
        if (sum == G) break;
        __builtin_amdgcn_s_sleep(1);
        if ((++sp & 255u) == 0u) { if (xb_ld(&bar[XB_TMO])) break; if (sp > XB_SPIN_CAP) { atomicAdd(&bar[XB_TMO], 1u); break; } }
    }
    nloc = mine > 0u ? mine : 1u; nx = cnt > 0u ? cnt : 1u;
}
__device__ __forceinline__ void xcd_barrier(const XcdBarrier& b) {
    asm volatile("s_waitcnt vmcnt(0)" ::: "memory");
    __syncthreads();
    if (threadIdx.x == 0) {
        unsigned* bar = b.bar;
        __builtin_amdgcn_s_waitcnt(0);
        unsigned nloc = b.st[0], nx = b.st[1];
        if (nloc == 0u) { xcd_barrier_complete(bar, b.x, nloc, nx); b.st[0] = nloc; b.st[1] = nx; }
        const unsigned old = xb_add(&bar[XB_XSUB(b.x)], 1u);
        const unsigned gen = old / nloc;
        if (old + 1u == (gen + 1u) * nloc) {
            __builtin_amdgcn_fence(__ATOMIC_RELEASE, "agent");
            asm volatile("s_waitcnt vmcnt(0)" ::: "memory");
            const unsigned og = xb_add(&bar[XB_TOP], 1u);
            const unsigned tg = og / nx;
            if (og + 1u == (tg + 1u) * nx) xb_add(&bar[XB_TOPGEN], 1u);
            else XB_SPIN(xb_ld(&bar[XB_TOPGEN]) == tg, bar);
            __builtin_amdgcn_fence(__ATOMIC_ACQUIRE, "agent");
            xb_add(&bar[XB_XGEN(b.x)], 1u);
            asm volatile("s_waitcnt vmcnt(0)" ::: "memory");
        } else {
            XB_SPIN(xb_ld(&bar[XB_XGEN(b.x)]) == gen, bar);
            __builtin_amdgcn_fence(__ATOMIC_ACQUIRE, "agent");
            asm volatile("s_waitcnt vmcnt(0)" ::: "memory");
        }
    }
    __syncthreads();
}

struct Args {
    const float *x_p, *x_s, *c_p, *c_s, *st_h, *st_C, *st_n, *st_m, *st_conv, *w_ada, *b_ada, *norm_g, *w_in, *b_in, *lb_logits, *hnorm_g,
                *conv_w, *conv_b, *wq, *wk, *wv, *mnorm_g, *skip, *w_out, *final_g;
    float* out; unsigned char* ws;
};

__device__ __forceinline__ void transposes(const Args& a, LAS unsigned char* lds, int vcu, int G, int tid, int wave, int lane);
__device__ __forceinline__ void phase1(const Args& a, LAS unsigned char* lds, int vcu, int G, int tid, int wave, int lane) {
    LAS float* sg = (LAS float*)lds;
    { const float* GW = (const float*)(a.ws + WS_GW); f32x4 tv[4];
#pragma unroll
      for (int i = 0; i < 4; ++i) tv[i] = *(const f32x4*)(GW + 4 * (tid + NTHR * i));
#pragma unroll
      for (int i = 0; i < 4; ++i) *(LAS f32x4*)(sg + 4 * (tid + NTHR * i)) = tv[i]; }
    __syncthreads();
    const float* MOD = (const float*)(a.ws + WS_MOD);
    bf16_t* XN = (bf16_t*)(a.ws + WS_XN); float* GATE = (float*)(a.ws + WS_GATE);
    const int gw = vcu * NWAVES + wave, NGW = G * NWAVES;
    f32x4 nx[4];
    if (gw < MT) { const float* xr = gw < MP ? a.x_p + (size_t)gw * DM : a.x_s + (size_t)(gw - MP) * DM;
#pragma unroll
        for (int j = 0; j < 4; ++j) nx[j] = *(const f32x4*)(xr + 4 * lane + 256 * j); }
    for (int r = gw; r < MT; r += NGW) {
        const int mb = r < MP ? (r >> 11) : BP + ((r - MP) >> 2);
        const float* shift = MOD + (size_t)mb * 3072; const float* scale = shift + 1024;
        f32x4 v[4]; float s = 0.f;
#pragma unroll
        for (int j = 0; j < 4; ++j) { v[j] = nx[j]; s += (v[j].x * v[j].x + v[j].y * v[j].y) + (v[j].z * v[j].z + v[j].w * v[j].w); }
        if (r + NGW < MT) { const int rn = r + NGW; const float* xr = rn < MP ? a.x_p + (size_t)rn * DM : a.x_s + (size_t)(rn - MP) * DM;
#pragma unroll
            for (int j = 0; j < 4; ++j) nx[j] = *(const f32x4*)(xr + 4 * lane + 256 * j); }
        const float rinv = 1.0f / sqrtf(wave_sum(s) * (1.f / DM) + EPS);
        float gd[8];
#pragma unroll
        for (int gi = 0; gi < 8; ++gi) gd[gi] = 0.f;
#pragma unroll
        for (int j = 0; j < 4; ++j) {
            const int col = 4 * lane + 256 * j;
            const f32x4 g = *(const f32x4*)(a.norm_g + col), sc = *(const f32x4*)(scale + col), sh = *(const f32x4*)(shift + col);
            f32x4 h = v[j] * rinv * g * (sc + 1.0f) + sh;
            u32x2 o; o.x = pk2(h.x, h.y); o.y = pk2(h.z, h.w);
            *(u32x2*)(XN + (size_t)r * DM + col) = o;
#pragma unroll
            for (int gi = 0; gi < 8; ++gi) { const f32x4 w = *(const LAS f32x4*)(sg + gi * 1024 + col); gd[gi] += (h.x * w.x + h.y * w.y) + (h.z * w.z + h.w * w.w); }
        }
#pragma unroll
        for (int gi = 0; gi < 8; ++gi) gd[gi] = wave_sum(gd[gi]);
        if (lane < 8) {
            float val = 0.f;
#pragma unroll
            for (int gi = 0; gi < 8; ++gi) val = (lane == gi) ? gd[gi] : val;
            val += a.b_in[NPROJ + lane];
            if (lane >= 4) val = fminf(val, 0.f) - log1pf(__expf(-fabsf(val)));
            GATE[(size_t)r * 8 + lane] = val;
        }
    }
}

__device__ __forceinline__ void store_wt_f32(float* p, float v) { asm volatile("global_store_dword %0, %1, off sc1\n\ts_nop 1" :: "v"(p), "v"(v) : "memory"); }
struct EpiProj {
    static constexpr bool PERM = true, AFTER_DRAIN = false;
    bf16_t* PROJ; float* LOGF; float* LOGFS; const float* bias; const float* lbl;
    __device__ __forceinline__ void operator()(const f32x4 (&acc)[2][2][4][2], const pg8::Unit& u, int wr, int wc, int fr, int fq) const {
        const int seg = u.pn >> 2;
        const int row0 = u.pm * 256 + wr * 64 + fr, col0 = u.pn * 256 + wc * 32 + 8 * fq, cs0 = col0 & 1023;
        const bool prompt = u.pm < MP / 256;
        unsigned cpart[2];
#pragma unroll
        for (int bj = 0; bj < 2; ++bj) { const int cs = cs0 + bj * 128; cpart[bj] = seg < 4 ? (unsigned)(((cs >> 7) << 13) + (cs & 127)) : (unsigned)(((cs >> 8) << 14) + (cs & 255)); }
        const int tsh = seg < 4 ? 7 : 8;
        f32x4 bv[2][2], lb[2][2];
#pragma unroll
        for (int bj = 0; bj < 2; ++bj)
#pragma unroll
            for (int n = 0; n < 2; ++n) {
                bv[bj][n] = *(const f32x4*)(bias + col0 + bj * 128 + 4 * n);
                if (seg == 1) { const int c = col0 - 1024 + bj * 128 + 4 * n; const f32x4 l0 = *(const f32x4*)(lbl + c), l1 = *(const f32x4*)(lbl + 1024 + c);
                    f32x4 t; t.x = 1.f / (1.f + __expf(l1.x - l0.x)); t.y = 1.f / (1.f + __expf(l1.y - l0.y)); t.z = 1.f / (1.f + __expf(l1.z - l0.z)); t.w = 1.f / (1.f + __expf(l1.w - l0.w)); lb[bj][n] = t; }
                else lb[bj][n] = (f32x4){0.f, 0.f, 0.f, 0.f};
            }
#pragma unroll
        for (int ai = 0; ai < 2; ++ai)
#pragma unroll
            for (int m = 0; m < 4; ++m) {
                const int row = row0 + ai * 128 + m * 16;
                const size_t rpart = prompt ? ((size_t)(row >> 6) << 16) + (size_t)((row & 63) << tsh) : 0;
#pragma unroll
                for (int bj = 0; bj < 2; ++bj) {
                    f32x4 v0 = acc[ai][bj][m][0] + bv[bj][0], v1 = acc[ai][bj][m][1] + bv[bj][1];
                    if (seg == 1) {
                        float* dst = prompt ? LOGF + rpart + cpart[bj] : LOGFS + (size_t)(row - MP) * 1024 + cs0 + bj * 128;
                        f32x4 o0, o1;
#pragma unroll
                        for (int e = 0; e < 4; ++e) { const float l0 = lb[bj][0][e], l1 = lb[bj][1][e];
                            o0[e] = __logf(l0 + (1.f - l0) * sigmoidf_(v0[e])); o1[e] = __logf(l1 + (1.f - l1) * sigmoidf_(v1[e])); }
                        *(f32x4*)dst = o0; *(f32x4*)(dst + 4) = o1;
                    } else {
                        if (seg == 3 || seg == 5) {
#pragma unroll
                            for (int e = 0; e < 4; ++e) { v0[e] = v0[e] * sigmoidf_(v0[e]); v1[e] = v1[e] * sigmoidf_(v1[e]); }
                        } else if (seg == 6) {
#pragma unroll
                            for (int e = 0; e < 4; ++e) { v0[e] = sigmoidf_(v0[e]); v1[e] = sigmoidf_(v1[e]); }
                        }
                        u32x4 w; w.x = pk2(v0[0], v0[1]); w.y = pk2(v0[2], v0[3]); w.z = pk2(v1[0], v1[1]); w.w = pk2(v1[2], v1[3]);
                        bf16_t* dst = prompt ? PROJ + (size_t)seg * SEGSZ + rpart + cpart[bj] : PROJ + PS_OFF + (size_t)(row - MP) * NPROJ + col0 + bj * 128;
                        *(u32x4*)dst = w;
                    }
                }
            }
    }
};
struct EpiOut {
    static constexpr bool PERM = true, AFTER_DRAIN = false;
    float* Y; const float* xp; const float* xs; const float* MOD;
    __device__ __forceinline__ void operator()(const f32x4 (&acc)[2][2][4][2], const pg8::Unit& u, int wr, int wc, int fr, int fq) const {
        const int row0 = u.pm * 256 + wr * 64 + fr, col0 = u.pn * 256 + wc * 32 + 8 * fq;
#pragma unroll
        for (int ai = 0; ai < 2; ++ai)
#pragma unroll
            for (int m = 0; m < 4; ++m) {
                const int row = row0 + ai * 128 + m * 16;
                const float* xr = row < MP ? xp + (size_t)row * DM : xs + (size_t)(row - MP) * DM;
                const int mb = row < MP ? (row >> 11) : BP + ((row - MP) >> 2);
                const float* gate = MOD + (size_t)mb * 3072 + 2048;
#pragma unroll
                for (int bj = 0; bj < 2; ++bj)
#pragma unroll
                    for (int n = 0; n < 2; ++n) {
                        const int col = col0 + bj * 128 + 4 * n;
                        const f32x4 xv = *(const f32x4*)(xr + col), gv = *(const f32x4*)(gate + col);
                        *(f32x4*)(Y + (size_t)row * DM + col) = xv + gv * acc[ai][bj][m][n];
                    }
            }
    }
};

struct EpiOutFused {
    static constexpr bool PERM = true, AFTER_DRAIN = true;
    float* Y; const float* xp; const float* MOD; const float* fg; float* STATS; unsigned* cnt;
    __device__ __forceinline__ void operator()(const f32x4 (&)[2][2][4][2], const pg8::Unit&, int, int, int, int) const {}
    __device__ __forceinline__ void fused(f32x4 (&acc)[2][2][4][2], const pg8::Unit& u, int wr, int wc, int fr, int fq, LAS unsigned char* lds, int wid, int lane) const {
        LAS float* P = (LAS float*)lds;
        LAS float* S = (LAS float*)(lds + 4096);
        const int tid = wid * 64 + lane;
        const int row0 = u.pm * 256 + wr * 64 + fr, col0 = u.pn * 256 + wc * 32 + 8 * fq;
        const float* gate = MOD + (size_t)(u.pm >> 3) * 3072 + 2048;
        f32x4 gv[2][2];
#pragma unroll
        for (int bj = 0; bj < 2; ++bj)
#pragma unroll
            for (int n = 0; n < 2; ++n) gv[bj][n] = *(const f32x4*)(gate + col0 + bj * 128 + 4 * n);
#pragma unroll
        for (int ai = 0; ai < 2; ++ai)
#pragma unroll
            for (int m = 0; m < 4; ++m) {
                const int row = row0 + ai * 128 + m * 16; float sq = 0.f;
#pragma unroll
                for (int bj = 0; bj < 2; ++bj)
#pragma unroll
                    for (int n = 0; n < 2; ++n) { const f32x4 xv = *(const f32x4*)(xp + (size_t)row * DM + col0 + bj * 128 + 4 * n);
                        const f32x4 v = xv + gv[bj][n] * acc[ai][bj][m][n]; acc[ai][bj][m][n] = v; sq += (v.x * v.x + v.y * v.y) + (v.z * v.z + v.w * v.w); }
                sq += __shfl_xor(sq, 16); sq += __shfl_xor(sq, 32);
                if (fq == 0) P[(ai * 128 + wr * 64 + m * 16 + fr) * 4 + wc] = sq;
            }
        __syncthreads();
        if (tid < 256) { const f32x4 p4 = *(const LAS f32x4*)(P + tid * 4);
            __hip_atomic_store(STATS + ((size_t)u.pm * 256 + tid) * 4 + u.pn, (p4.x + p4.y) + (p4.z + p4.w), __ATOMIC_RELAXED, __HIP_MEMORY_SCOPE_AGENT); }
        asm volatile("s_waitcnt vmcnt(0)" ::: "memory");
        __syncthreads();
        if (tid == 0) { (void)xb_add(cnt + 64 * u.pm, 1u);
            unsigned sp = 0; while (xb_ld(cnt + 64 * u.pm) < 4u) { __builtin_amdgcn_s_sleep(1); if (++sp > (1u << 20)) break; } }
        __syncthreads();
        if (tid < 256) { const float* st = STATS + ((size_t)u.pm * 256 + tid) * 4; float t = 0.f;
#pragma unroll
            for (int j = 0; j < 4; ++j) t += __hip_atomic_load(st + j, __ATOMIC_RELAXED, __HIP_MEMORY_SCOPE_AGENT);
            S[tid] = 1.0f / sqrtf(t * (1.f / DM) + EPS); }
        __syncthreads();
        f32x4 fgv[2][2];
#pragma unroll
        for (int bj = 0; bj < 2; ++bj)
#pragma unroll
            for (int n = 0; n < 2; ++n) fgv[bj][n] = *(const f32x4*)(fg + col0 + bj * 128 + 4 * n);
#pragma unroll
        for (int ai = 0; ai < 2; ++ai)
#pragma unroll
            for (int m = 0; m < 4; ++m) {
                const int rl = ai * 128 + wr * 64 + m * 16 + fr; const float ri = S[rl];
#pragma unroll
                for (int bj = 0; bj < 2; ++bj)
#pragma unroll
                    for (int n = 0; n < 2; ++n) *(f32x4*)(Y + (size_t)(u.pm * 256 + rl) * DM + col0 + bj * 128 + 4 * n) = acc[ai][bj][m][n] * ri * fgv[bj][n];
            }
    }
};
#define LDSP(type, off) ((LAS type*)(lds + (off)))
__device__ __forceinline__ unsigned lp_row(int lane, unsigned RS) { return (unsigned)(lane & 31) * RS + 16u * (unsigned)(lane >> 5); }
__device__ __forceinline__ unsigned lp_perm(int lane, unsigned RS) { return (unsigned)(lane & 31) * RS + 8u * (unsigned)(lane >> 5); }
__device__ __forceinline__ unsigned lp_tr(int lane, unsigned RS) { return ((unsigned)(lane >> 5) * 8u + (unsigned)((lane & 15) >> 2)) * RS + (((unsigned)(lane >> 4) & 1u) * 16u + (unsigned)(lane & 3) * 4u) * 2u; }
__device__ __forceinline__ bf16x8 frag_row(LAS unsigned char* lds, unsigned off) { return *LDSP(const bf16x8, off); }
__device__ __forceinline__ bf16x8 frag_perm(LAS unsigned char* lds, unsigned off) {
    const s16x4 lo = *LDSP(const s16x4, off), hi = *LDSP(const s16x4, off + 16);
    bf16x8 r; r[0] = lo[0]; r[1] = lo[1]; r[2] = lo[2]; r[3] = lo[3]; r[4] = hi[0]; r[5] = hi[1]; r[6] = hi[2]; r[7] = hi[3]; return r;
}
template <unsigned RS> __device__ __forceinline__ bf16x8 frag_tr(LAS unsigned char* lds, unsigned off) {
    const s16x4 lo = __builtin_amdgcn_ds_read_tr16_b64_v4i16(LDSP(s16x4, off));
    const s16x4 hi = __builtin_amdgcn_ds_read_tr16_b64_v4i16(LDSP(s16x4, off + 4 * RS));
    bf16x8 r; r[0] = lo[0]; r[1] = lo[1]; r[2] = lo[2]; r[3] = lo[3]; r[4] = hi[0]; r[5] = hi[1]; r[6] = hi[2]; r[7] = hi[3]; return r;
}
template <int S> __device__ __forceinline__ bf16x8 acc_frag(const f32x16& x) {
    u32x4 w; w.x = pk2(x[8 * S + 0], x[8 * S + 1]); w.y = pk2(x[8 * S + 2], x[8 * S + 3]); w.z = pk2(x[8 * S + 4], x[8 * S + 5]); w.w = pk2(x[8 * S + 6], x[8 * S + 7]);
    return __builtin_bit_cast(bf16x8, w);
}
#define MFMA32(a, b, c) __builtin_amdgcn_mfma_f32_32x32x16_bf16(a, b, c, 0, 0, 0)
__device__ __forceinline__ int accrow(int i, int h) { return (i & 3) + 8 * (i >> 2) + 4 * h; }
#define ACCROW0(i) (((i) & 3) + 8 * ((i) >> 2))

__device__ __forceinline__ void p0_transpose_tile(const float* W, int ldw, int K, bf16_t* WT, LAS unsigned char* lds, int kb, int nb, int tid, int wave, int lane) {
    constexpr unsigned RS = 528;
    const int k0 = 64 * kb, n0 = 256 * nb;
    f32x4 v[8];
#pragma unroll
    for (int i = 0; i < 8; ++i) { const int idx = tid + NTHR * i, k = idx >> 6, nq = idx & 63; v[i] = *(const f32x4*)(W + (size_t)(k0 + k) * ldw + n0 + 4 * nq); }
#pragma unroll
    for (int i = 0; i < 8; ++i) { const int idx = tid + NTHR * i, k = idx >> 6, nq = idx & 63; u32x2 o; o.x = pk2(v[i].x, v[i].y); o.y = pk2(v[i].z, v[i].w); *LDSP(u32x2, k * RS + 8 * nq) = o; }
    __syncthreads();
    const unsigned ot = lp_tr(lane, RS) + 64u * wave;
#pragma unroll
    for (int rb = 0; rb < 4; ++rb) { const bf16x8 f = frag_tr<RS>(lds, ot + 16 * rb * RS);
        *(bf16x8*)(WT + (size_t)(n0 + 32 * wave + (lane & 31)) * K + k0 + 16 * rb + 8 * (lane >> 5)) = f; }
    __syncthreads();
}
__device__ __forceinline__ void transposes(const Args& a, LAS unsigned char* lds, int vcu, int G, int tid, int wave, int lane);
__device__ __forceinline__ void phase0(const Args& a, LAS unsigned char* lds, int vcu, int G, int tid, int wave, int lane) {
    float* MOD = (float*)(a.ws + WS_MOD);
    for (int cb = vcu; cb < 96; cb += G) {
        const int c0 = 32 * cb;
#pragma unroll
        for (int hb = 0; hb < 2; ++hb) { f32x4 v[8];
#pragma unroll
            for (int i = 0; i < 8; ++i) { const int k = (tid >> 3) + 64 * (8 * hb + i); v[i] = *(const f32x4*)(a.w_ada + (size_t)k * 3072 + c0 + 4 * (tid & 7)); }
#pragma unroll
            for (int i = 0; i < 8; ++i) { const int k = (tid >> 3) + 64 * (8 * hb + i); u32x2 o; o.x = pk2(v[i].x, v[i].y); o.y = pk2(v[i].z, v[i].w); *LDSP(u32x2, k * 80 + 8 * (tid & 7)) = o; } }
        __syncthreads();
        if (wave < 5) {
            const int hl = lane >> 5, rr = 32 * wave + (lane & 31), rc = rr < NMOD ? rr : NMOD - 1;
            const float* cr = (rc < BP ? a.c_p + (size_t)rc * DM : a.c_s + (size_t)(rc - BP) * DM) + 8 * hl;
            const unsigned ot = lp_tr(lane, 80);
            f32x16 acc;
#pragma unroll
            for (int i = 0; i < 16; ++i) acc[i] = 0.f;
            f32x4 cv[8][2], cnx[8][2];
#pragma unroll
            for (int j = 0; j < 8; ++j) { cnx[j][0] = *(const f32x4*)(cr + 16 * j); cnx[j][1] = *(const f32x4*)(cr + 16 * j + 4); }
#pragma unroll 1
            for (int k0 = 0; k0 < DM; k0 += 128) {
#pragma unroll
                for (int j = 0; j < 8; ++j) { cv[j][0] = cnx[j][0]; cv[j][1] = cnx[j][1]; }
                { const int kn = (k0 + 128 < DM) ? k0 + 128 : k0;
#pragma unroll
                  for (int j = 0; j < 8; ++j) { cnx[j][0] = *(const f32x4*)(cr + kn + 16 * j); cnx[j][1] = *(const f32x4*)(cr + kn + 16 * j + 4); } }
#pragma unroll
                for (int j = 0; j < 8; ++j) {
                    float sv[8];
#pragma unroll
                    for (int e = 0; e < 4; ++e) { sv[e] = cv[j][0][e] * sigmoidf_(cv[j][0][e]); sv[4 + e] = cv[j][1][e] * sigmoidf_(cv[j][1][e]); }
                    u32x4 w; w.x = pk2(sv[0], sv[1]); w.y = pk2(sv[2], sv[3]); w.z = pk2(sv[4], sv[5]); w.w = pk2(sv[6], sv[7]);
                    acc = MFMA32(__builtin_bit_cast(bf16x8, w), frag_tr<80>(lds, ot + (unsigned)(k0 + 16 * j) * 80u), acc);
                }
            }
#pragma unroll
            for (int i = 0; i < 16; ++i) { const int r = 32 * wave + accrow(i, hl);
                if (r < NMOD) MOD[(size_t)r * 3072 + c0 + (lane & 31)] = acc[i] + a.b_ada[c0 + (lane & 31)]; }
        }
        __syncthreads();
    }
    if (vcu >= 96) transposes(a, lds, vcu - 96, G - 96, tid, wave, lane);
    if (vcu == G - 1) {
        float* GW = (float*)(a.ws + WS_GW);
        float tv[16];
#pragma unroll
        for (int i = 0; i < 16; ++i) { const int idx = tid + NTHR * i; tv[i] = a.w_in[(size_t)(idx >> 3) * WIN_LD + NPROJ + (idx & 7)]; }
#pragma unroll
        for (int i = 0; i < 16; ++i) { const int idx = tid + NTHR * i; GW[(idx & 7) * 1024 + (idx >> 3)] = tv[i]; }
    }
}
__device__ __forceinline__ void transposes(const Args& a, LAS unsigned char* lds, int vcu, int G, int tid, int wave, int lane) {
    bf16_t* WinT = (bf16_t*)(a.ws + WS_WIN); bf16_t* WoutT = (bf16_t*)(a.ws + WS_WOUT);
    constexpr int I_IN = (DM / 64) * (NPROJ / 256), I_OUT = (DMIX / 64) * (DM / 256);
    for (int it = vcu; it < I_IN + I_OUT; it += G) {
        if (it < I_IN) p0_transpose_tile(a.w_in, WIN_LD, DM, WinT, lds, it / (NPROJ / 256), it % (NPROJ / 256), tid, wave, lane);
        else { const int u = it - I_IN; p0_transpose_tile(a.w_out, DM, DMIX, WoutT, lds, u / (DM / 256), u % (DM / 256), tid, wave, lane); }
    }
}

__device__ __forceinline__ unsigned p3a_touch(const Args& a, int t, int tid) {
    const bf16_t* PROJ = (const bf16_t*)(a.ws + WS_PROJ);
    const unsigned* p;
    if (t < 1024) { const int b = t >> 7, c = (t >> 2) & 31, h = t & 3;
        p = (const unsigned*)(PROJ + ml_tile(4, b, c, h) + (tid & 255) * 64); }
    else { const int u = t - 1024, b = u >> 8, c = (u >> 3) & 31, h = u & 7;
        if (tid < 256) p = (const unsigned*)((const float*)(a.ws + WS_LOGF) + ((size_t)((b * NCH + c) * 8 + h) << 13) + tid * 32);
        else p = (const unsigned*)(PROJ + hg_tile(0, b, c, h) + (tid & 127) * 64); }
    return *p;
}
__device__ __forceinline__ void p3a_hgrn(const Args& a, LAS unsigned char* lds, int b, int c, int h, int tid, int wave, int lane, int tnext) {
    constexpr unsigned RS = 272, OQT = 8192, OKT = 8192 + 17408;
    bf16_t* PROJ = (bf16_t*)(a.ws + WS_PROJ);
    const float* LOGF = (const float*)(a.ws + WS_LOGF);
    const size_t r0 = (size_t)b * TP + (size_t)c * 64;
    const size_t task = ((size_t)b * NCH + c) * 8 + h;
    const int cq = tid & 31, tseg = tid >> 5;
    f32x4 lf[4]; u32x2 qw[4];
#pragma unroll
    for (int i = 0; i < 4; ++i) { const int t = 4 * tseg + i; lf[i] = *(const f32x4*)(LOGF + (task << 13) + t * 128 + 4 * cq); qw[i] = *(const u32x2*)(PROJ + hg_tile(0, b, c, h) + t * 128 + 4 * cq); }
    const unsigned pf = (tnext >= 0) ? p3a_touch(a, tnext, tid) : 0u;
    f32x4 gl[4]; gl[0] = lf[0]; gl[1] = gl[0] + lf[1]; gl[2] = gl[1] + lf[2]; gl[3] = gl[2] + lf[3];
    *LDSP(f32x4, (tseg * 128 + 4 * cq) * 4) = gl[3];
    __syncthreads();
    f32x4 off = {0.f, 0.f, 0.f, 0.f}, Gm = off, GL = off;
#pragma unroll
    for (int sg = 0; sg < 16; ++sg) { const f32x4 v = *LDSP(const f32x4, (sg * 128 + 4 * cq) * 4); GL += v; if (sg < 8) Gm += v; if (sg < tseg) off += v; }
#pragma unroll
    for (int i = 0; i < 4; ++i) { const int t = 4 * tseg + i;
        const f32x4 G = off + gl[i];
        const float q[4] = {bflo(qw[i].x), bfhi(qw[i].x), bflo(qw[i].y), bfhi(qw[i].y)};
        float qe[4], ke[4], qt[4], kt[4];
#pragma unroll
        for (int e = 0; e < 4; ++e) { const float kk = 1.f - __expf(lf[i][e]);
            qe[e] = q[e] * __expf(G[e]); ke[e] = kk * __expf(GL[e] - G[e]); qt[e] = q[e] * __expf(G[e] - Gm[e]); kt[e] = kk * __expf(Gm[e] - G[e]); }
        bf16_t* qp = PROJ + hg_tile(0, b, c, h) + t * 128 + 4 * cq;
        u32x2 o; o.x = pk2(qe[0], qe[1]); o.y = pk2(qe[2], qe[3]); *(u32x2*)qp = o;
        o.x = pk2(ke[0], ke[1]); o.y = pk2(ke[2], ke[3]); *(u32x2*)(qp + SEGSZ) = o;
        o.x = pk2(qt[0], qt[1]); o.y = pk2(qt[2], qt[3]); *LDSP(u32x2, OQT + t * RS + 8 * cq) = o;
        o.x = pk2(kt[0], kt[1]); o.y = pk2(kt[2], kt[3]); *LDSP(u32x2, OKT + t * RS + 8 * cq) = o;
    }
    if (tseg == 15) { f32x4 d; d.x = __expf(GL.x); d.y = __expf(GL.y); d.z = __expf(GL.z); d.w = __expf(GL.w); *(f32x4*)((float*)(a.ws + WS_DEC) + task * 128 + 4 * cq) = d; }
    __syncthreads();
    bf16_t* AH = (bf16_t*)(a.ws + WS_AH) + task * 4096;
    if (wave < 4) {
        const int ti = (wave == 0 || wave == 3) ? 0 : 1, tj = (wave == 2 || wave == 3) ? 1 : 0;
        const int hh = lane >> 5, c31 = lane & 31;
        f32x16 acc = {0.f, 0.f, 0.f, 0.f, 0.f, 0.f, 0.f, 0.f, 0.f, 0.f, 0.f, 0.f, 0.f, 0.f, 0.f, 0.f};
        if (wave < 3) {
            unsigned oa = OQT + lp_row(lane, RS) + 32u * ti * RS, ob = OKT + lp_row(lane, RS) + 32u * tj * RS;
#pragma unroll 4
            for (int ks = 0; ks < 8; ++ks) { acc = MFMA32(frag_row(lds, oa), frag_row(lds, ob), acc); oa += 32; ob += 32; }
        }
#pragma unroll
        for (int i = 0; i < 16; ++i) { const int t = 32 * ti + accrow(i, hh), j = 32 * tj + c31;
            AH[t * 64 + j] = f2bf((wave < 3 && j <= t) ? acc[i] : 0.f); }
    }
    asm volatile("" :: "v"(pf));
    __syncthreads();
}
__device__ __forceinline__ void p3a_mlstm(const Args& a, LAS unsigned char* lds, int b, int c, int h, int tid, int wave, int lane, int tnext) {
    constexpr unsigned RS = 528, OK_ = 33792, ORS_ = 67584, OCS_ = 67584 + 256;
    const bf16_t* PROJ = (const bf16_t*)(a.ws + WS_PROJ);
    const float* GATE = (const float*)(a.ws + WS_GATE);
    const size_t r0 = (size_t)b * TP + (size_t)c * 64;
    const size_t task = ((size_t)b * NCH + c) * 4 + h;
    if (tid < 64) *LDSP(float, ORS_ + tid * 4) = 0.f;
    const int tg = tid & 7, g = tid >> 3, ch = h * 256 + 4 * g, gg = h * 64 + g;
    const float ig = GATE[(r0 + lane) * 8 + h], lfg = GATE[(r0 + lane) * 8 + 4 + h];
    u32x2 muw[11];
#pragma unroll
    for (int rr = 0; rr < 11; ++rr) { const int t = 8 * tg - 3 + rr; const bool pad = (c == 0 && t < 0);
        const int tt_ = pad ? 0 : t;
        const u32x2 w = *(const u32x2*)(PROJ + ml_tile(4, b, tt_ < 0 ? c - 1 : c, h) + (tt_ & 63) * 256 + 4 * g);
        muw[rr].x = pad ? 0u : w.x; muw[rr].y = pad ? 0u : w.y; }
    float cw[4][4], cb[4], wq[4][4], wk[4][4], wv[4][4];
#pragma unroll
    for (int w = 0; w < 4; ++w) { const f32x4 t = *(const f32x4*)(a.conv_w + w * 1024 + ch); cw[w][0] = t.x; cw[w][1] = t.y; cw[w][2] = t.z; cw[w][3] = t.w; }
    { const f32x4 t = *(const f32x4*)(a.conv_b + ch); cb[0] = t.x; cb[1] = t.y; cb[2] = t.z; cb[3] = t.w; }
#pragma unroll
    for (int i = 0; i < 4; ++i) { const f32x4 t0 = *(const f32x4*)(a.wq + gg * 16 + 4 * i), t1 = *(const f32x4*)(a.wk + gg * 16 + 4 * i), t2 = *(const f32x4*)(a.wv + gg * 16 + 4 * i);
#pragma unroll
        for (int j = 0; j < 4; ++j) { wq[i][j] = t0[j]; wk[i][j] = t1[j] * 0.0625f; wv[i][j] = t2[j]; } }
    const unsigned pf = (tnext >= 0) ? p3a_touch(a, tnext, tid) : 0u;
    float bt = lfg;
#pragma unroll
    for (int o = 1; o < 64; o <<= 1) { const float n = __shfl_up(bt, o); if (lane >= o) bt += n; }
    const float av = ig - bt; float R = av;
#pragma unroll
    for (int o = 1; o < 64; o <<= 1) R = fmaxf(R, __shfl_xor(R, o));
    const float wtok = __expf(av - R);
    if (wave == 0) { ((float*)(a.ws + WS_BT))[task * 64 + lane] = bt; if (lane == 0) ((float*)(a.ws + WS_RL))[task] = R; }
    {
        bf16_t* XC = (bf16_t*)(a.ws + WS_XC); bf16_t* QM = (bf16_t*)(a.ws + WS_QM); bf16_t* KM = (bf16_t*)(a.ws + WS_KM); bf16_t* VM = (bf16_t*)(a.ws + WS_VM);
        float cs[4] = {0.f, 0.f, 0.f, 0.f};
        u32x4 kT[4], vT[4];
#pragma unroll
        for (int tp = 0; tp < 4; ++tp) { float k2[2][4], v2[2][4];
#pragma unroll
          for (int u = 0; u < 2; ++u) { const int tt = 2 * tp + u; const int t = 8 * tg + tt; const float wt = __shfl(wtok, t);
            float m0[4], m1[4], m2[4], m3[4];
            m0[0] = bflo(muw[tt].x); m0[1] = bfhi(muw[tt].x); m0[2] = bflo(muw[tt].y); m0[3] = bfhi(muw[tt].y);
            m1[0] = bflo(muw[tt + 1].x); m1[1] = bfhi(muw[tt + 1].x); m1[2] = bflo(muw[tt + 1].y); m1[3] = bfhi(muw[tt + 1].y);
            m2[0] = bflo(muw[tt + 2].x); m2[1] = bfhi(muw[tt + 2].x); m2[2] = bflo(muw[tt + 2].y); m2[3] = bfhi(muw[tt + 2].y);
            m3[0] = bflo(muw[tt + 3].x); m3[1] = bfhi(muw[tt + 3].x); m3[2] = bflo(muw[tt + 3].y); m3[3] = bfhi(muw[tt + 3].y);
            float xc[4], q[4], k[4];
#pragma unroll
            for (int i = 0; i < 4; ++i) { const float cv = cb[i] + cw[0][i] * m0[i] + cw[1][i] * m1[i] + cw[2][i] * m2[i] + cw[3][i] * m3[i]; xc[i] = cv * sigmoidf_(cv); }
#pragma unroll
            for (int j = 0; j < 4; ++j) { q[j] = xc[0] * wq[0][j] + xc[1] * wq[1][j] + xc[2] * wq[2][j] + xc[3] * wq[3][j];
                k[j] = (xc[0] * wk[0][j] + xc[1] * wk[1][j] + xc[2] * wk[2][j] + xc[3] * wk[3][j]) * wt;
                v2[u][j] = m3[0] * wv[0][j] + m3[1] * wv[1][j] + m3[2] * wv[2][j] + m3[3] * wv[3][j]; cs[j] += k[j]; k2[u][j] = k[j]; }
            const size_t go = (task << 14) + t * 256 + 4 * g;
            u32x2 o; o.x = pk2(xc[0], xc[1]); o.y = pk2(xc[2], xc[3]); *(u32x2*)(XC + go) = o;
            o.x = pk2(q[0], q[1]); o.y = pk2(q[2], q[3]); *(u32x2*)(QM + go) = o; *LDSP(u32x2, t * RS + 8 * g) = o;
            o.x = pk2(k[0], k[1]); o.y = pk2(k[2], k[3]); *LDSP(u32x2, OK_ + t * RS + 8 * g) = o;
          }
#pragma unroll
          for (int j = 0; j < 4; ++j) { kT[j][tp] = pk2(k2[0][j], k2[1][j]); vT[j][tp] = pk2(v2[0][j], v2[1][j]); }
        }
#pragma unroll
        for (int j = 0; j < 4; ++j) { const size_t go = (task << 14) + (size_t)(4 * g + j) * 64 + 8 * tg;
            *(u32x4*)(KM + go) = kT[j]; *(u32x4*)(VM + go) = vT[j]; }
#pragma unroll
        for (int j = 0; j < 4; ++j) { cs[j] += __shfl_xor(cs[j], 1); cs[j] += __shfl_xor(cs[j], 2); cs[j] += __shfl_xor(cs[j], 4); }
        if (tg == 0) *LDSP(f32x4, OCS_ + 16 * g) = (f32x4){cs[0], cs[1], cs[2], cs[3]};
        if (c == NCH - 1 && tg == 7) {
#pragma unroll
            for (int j = 0; j < 3; ++j) *(f32x4*)(a.out + O_VP + ((size_t)b * 3 + j) * 1024 + ch) = (f32x4){bflo(muw[8 + j].x), bfhi(muw[8 + j].x), bflo(muw[8 + j].y), bfhi(muw[8 + j].y)};
        }
    }
    __syncthreads();
    bf16_t* AM = (bf16_t*)(a.ws + WS_AM) + task * 4096;
    if (wave < 4) {
        const int ti = (wave == 0 || wave == 3) ? 0 : 1, tj = (wave == 2 || wave == 3) ? 1 : 0;
        const int hh = lane >> 5, c31 = lane & 31;
        f32x16 acc = {0.f, 0.f, 0.f, 0.f, 0.f, 0.f, 0.f, 0.f, 0.f, 0.f, 0.f, 0.f, 0.f, 0.f, 0.f, 0.f};
        if (wave < 3) {
            unsigned oa = lp_row(lane, RS) + 32u * ti * RS, ob = OK_ + lp_row(lane, RS) + 32u * tj * RS;
#pragma unroll 4
            for (int ks = 0; ks < 16; ++ks) { acc = MFMA32(frag_row(lds, oa), frag_row(lds, ob), acc); oa += 32; ob += 32; }
        }
        float pv[16];
#pragma unroll
        for (int i = 0; i < 16; ++i) { const int t = 32 * ti + accrow(i, hh), j = 32 * tj + c31;
            pv[i] = (wave < 3 && j <= t) ? acc[i] : 0.f;
            AM[t * 64 + j] = f2bf(pv[i]); }
        if (wave < 3) {
#pragma unroll
            for (int bit = 8; bit >= 1; bit >>= 1) {
#pragma unroll
                for (int m = 0; m < bit; ++m) { const bool up = (lane & bit) != 0; const float send = up ? pv[m] : pv[m + bit], keep = up ? pv[m + bit] : pv[m];
                    pv[m] = keep + __shfl_xor(send, bit); }
            }
            const float tot = pv[0] + __shfl_xor(pv[0], 16);
            if ((lane & 16) == 0) { const int i = lane & 15; atomicAdd((float*)LDSP(float, ORS_ + (32 * ti + accrow(i, hh)) * 4), tot); }
        }
    }
    asm volatile("" :: "v"(pf));
    __syncthreads();
    if (tid < 64) ((float*)(a.ws + WS_RS))[task * 64 + tid] = *LDSP(const float, ORS_ + tid * 4);
    if (tid < 256) ((float*)(a.ws + WS_CSK))[task * 256 + tid] = *LDSP(const float, OCS_ + tid * 4);
    __syncthreads();
}

constexpr int NPART = 4, CPP = NCH / NPART;
constexpr size_t WS_SUMH = 2 * MiB;
constexpr size_t WS_DTOT = 14 * MiB;
constexpr size_t WS_SUMM = 484 * MiB;
constexpr size_t WS_SUMN = 508 * MiB;
constexpr size_t WS_SUMS = 508 * MiB + 512 * 1024;
constexpr size_t WS_STATS = 509 * MiB;
constexpr size_t WS_END2 = 510 * MiB;

template <int MODE>
__device__ __forceinline__ void p3b_hgrn(const Args& a, LAS unsigned char* lds, int b, int hp, int part, int tid, int wave, int lane) {
    constexpr unsigned RS = 272, RSA = 144, HB = 62464;
    constexpr unsigned OKE = 17408, OV = 34816, OA = 52224, ODEC = 61440;
    const int hhd = wave >> 2, vb = wave & 3, hl = lane >> 5, c31 = lane & 31;
    const bf16_t* PROJ = (const bf16_t*)(a.ws + WS_PROJ);
    const bf16_t* AH = (const bf16_t*)(a.ws + WS_AH);
    const float* DEC = (const float*)(a.ws + WS_DEC);
    bf16_t* MIX = (bf16_t*)(a.ws + WS_MIX);
    float* SUMH = (float*)(a.ws + WS_SUMH); float* DTOT = (float*)(a.ws + WS_DTOT);
    f32x16 acc[4];
#pragma unroll
    for (int kt = 0; kt < 4; ++kt)
#pragma unroll
        for (int i = 0; i < 16; ++i) acc[kt][i] = 0.f;
    unsigned hb = (unsigned)hhd * HB;
    unsigned o_perm = hb + lp_perm(lane, RS), o_rowA = hb + OA + lp_row(lane, RSA), o_trV = hb + OV + lp_tr(lane, RS) + 64u * vb, o_trK = hb + OKE + lp_tr(lane, RS);
    unsigned o_dec = hb + ODEC + 16u * hl, o_st = hb + 4u * hl * RS + (32u * vb + c31) * 2u;
    const size_t sbase = ((size_t)b * 4 + hp) * 3;
    if (MODE == 1) {
        for (int q = 0; q < part; ++q) {
            __syncthreads();
            if (tid < 256) *LDSP(float, (tid >> 7) * HB + ODEC + (tid & 127) * 4) = DTOT[(sbase + q) * 256 + tid];
            __syncthreads();
            const float* su = SUMH + ((sbase + q) * 2 + hhd) * 16384 + (size_t)(vb * 4) * 1024 + lane;
#pragma unroll
            for (int kt = 0; kt < 4; ++kt)
#pragma unroll
                for (int g4 = 0; g4 < 4; ++g4) { const f32x4 d = *LDSP(const f32x4, o_dec + (32 * kt + 8 * g4) * 4);
#pragma unroll
                    for (int e = 0; e < 4; ++e) acc[kt][4 * g4 + e] = acc[kt][4 * g4 + e] * d[e] + su[kt * 1024 + (4 * g4 + e) * 64]; }
        }
    }
    float dprod = 1.f;
    constexpr int NT = (MODE == 0) ? 8 : 12;
    u32x4 pre[NT], preA[2]; float preD = 0.f;
#define HG_TILE(idx, tile, head, which) const int tile = (MODE == 0) ? ((idx) >> 10) : ((idx) >> 10), head = (MODE == 0) ? (tile >> 1) : (tile / 3), which = (MODE == 0) ? (1 + (tile & 1)) : (tile % 3)
#define HG_ISSUE(cc) do { \
        _Pragma("unroll") for (int i = 0; i < NT; ++i) { const int idx = tl + NTHR * i; HG_TILE(idx, tile, head, which); const int rem = idx & 1023; \
            pre[i] = *(const u32x4*)(PROJ + hg_tile(which, b, (cc), 2 * hp + head) + rem * 8); } \
        if (MODE == 1) { _Pragma("unroll") for (int i = 0; i < 2; ++i) { const int idx = tl + NTHR * i, head = idx >> 9, rem = idx & 511; \
            preA[i] = *(const u32x4*)(AH + (((size_t)b * NCH + (cc)) * 8 + 2 * hp + head) * 4096 + rem * 8); } } \
        if (tl < 256) preD = DEC[(((size_t)b * NCH + (cc)) * 8 + 2 * hp + (tl >> 7)) * 128 + (tl & 127)]; } while (0)
    { int tl = tid; HG_ISSUE(part * CPP); }
    for (int c = part * CPP; c < (part + 1) * CPP; ++c) {
        int tl = tid; asm volatile("" : "+v"(tl));
        asm volatile("" : "+v"(o_perm), "+v"(o_rowA), "+v"(o_trV), "+v"(o_trK), "+v"(o_dec), "+v"(o_st));
        __syncthreads();
#pragma unroll
        for (int i = 0; i < NT; ++i) { const int idx = tl + NTHR * i; HG_TILE(idx, tile, head, which); const int rem = idx & 1023, row = rem >> 4, ch = rem & 15;
            *LDSP(u32x4, head * HB + which * 17408 + row * RS + 16 * ch) = pre[i]; }
        if (MODE == 1) {
#pragma unroll
            for (int i = 0; i < 2; ++i) { const int idx = tl + NTHR * i, head = idx >> 9, rem = idx & 511, row = rem >> 3, ch = rem & 7;
                *LDSP(u32x4, head * HB + OA + row * RSA + 16 * ch) = preA[i]; } }
        if (tl < 256) { *LDSP(float, (tl >> 7) * HB + ODEC + (tl & 127) * 4) = preD; dprod *= preD; }
        __syncthreads();
        if (c + 1 < (part + 1) * CPP) HG_ISSUE(c + 1);
        f32x16 o0, o1; bf16x8 vf[4];
        if (MODE == 1) {
#pragma unroll
            for (int i = 0; i < 16; ++i) { o0[i] = 0.f; o1[i] = 0.f; }
#pragma unroll
            for (int kt = 0; kt < 4; ++kt) {
                { const bf16x8 bf = acc_frag<0>(acc[kt]);
                  o0 = MFMA32(frag_perm(lds, o_perm + 64 * kt), bf, o0); o1 = MFMA32(frag_perm(lds, o_perm + 32 * RS + 64 * kt), bf, o1); }
                { const bf16x8 bf = acc_frag<1>(acc[kt]);
                  o0 = MFMA32(frag_perm(lds, o_perm + 64 * kt + 32), bf, o0); o1 = MFMA32(frag_perm(lds, o_perm + 32 * RS + 64 * kt + 32), bf, o1); }
                asm volatile("" : "+v"(o0), "+v"(o1) :: "memory");
            }
        }
#pragma unroll
        for (int js = 0; js < 4; ++js) vf[js] = frag_tr<RS>(lds, o_trV + 16 * js * RS);
        if (MODE == 1) {
#pragma unroll
            for (int js = 0; js < 4; ++js) { o0 = MFMA32(frag_row(lds, o_rowA + 32 * js), vf[js], o0); o1 = MFMA32(frag_row(lds, o_rowA + 32 * RSA + 32 * js), vf[js], o1); }
            asm volatile("" : "+v"(o0), "+v"(o1) :: "memory");
        }
#pragma unroll
        for (int kt = 0; kt < 4; ++kt) {
#pragma unroll
            for (int g4 = 0; g4 < 4; ++g4) { const f32x4 d = *LDSP(const f32x4, o_dec + (32 * kt + 8 * g4) * 4);
                acc[kt][4 * g4 + 0] *= d.x; acc[kt][4 * g4 + 1] *= d.y; acc[kt][4 * g4 + 2] *= d.z; acc[kt][4 * g4 + 3] *= d.w; }
            asm volatile("" : "+v"(acc[kt]) :: "memory"); }
#pragma unroll
        for (int kt = 0; kt < 4; ++kt) {
#pragma unroll
            for (int js = 0; js < 4; ++js) acc[kt] = MFMA32(frag_tr<RS>(lds, o_trK + 16 * js * RS + 64 * kt), vf[js], acc[kt]);
            asm volatile("" : "+v"(acc[kt]) :: "memory"); }
        if (MODE == 1) {
            __builtin_amdgcn_sched_barrier(0);
            __syncthreads();
#pragma unroll
            for (int i = 0; i < 16; ++i) {
                *LDSP(bf16_t, o_st + ACCROW0(i) * RS) = f2bf(o0[i]);
                *LDSP(bf16_t, o_st + (32 + ACCROW0(i)) * RS) = f2bf(o1[i]);
            }
            __syncthreads();
            const size_t r0 = (size_t)b * TP + (size_t)c * 64;
#pragma unroll
            for (int i = 0; i < 4; ++i) { const int idx = tl + NTHR * i, head = idx >> 10, rem = idx & 1023, row = rem >> 4, ch = rem & 15;
                const u32x4 w = *LDSP(const u32x4, head * HB + row * RS + 16 * ch);
                float v[8] = {bflo(w.x), bfhi(w.x), bflo(w.y), bfhi(w.y), bflo(w.z), bfhi(w.z), bflo(w.w), bfhi(w.w)};
                float ss = 0.f;
#pragma unroll
                for (int e = 0; e < 8; ++e) ss += v[e] * v[e];
                ss += __shfl_xor(ss, 1); ss += __shfl_xor(ss, 2); ss += __shfl_xor(ss, 4); ss += __shfl_xor(ss, 8);
                const float rn = 1.0f / sqrtf(ss * (1.f / 128.f) + EPS);
                const int col = (2 * hp + head) * 128 + 8 * ch;
                const u32x4 z = *(const u32x4*)(PROJ + hg_tile(3, b, c, 2 * hp + head) + rem * 8);
                const f32x4 g0 = *(const f32x4*)(a.hnorm_g + col), g1 = *(const f32x4*)(a.hnorm_g + col + 4);
                u32x4 o; o.x = pk2(v[0] * rn * g0.x * bflo(z.x), v[1] * rn * g0.y * bfhi(z.x)); o.y = pk2(v[2] * rn * g0.z * bflo(z.y), v[3] * rn * g0.w * bfhi(z.y));
                o.z = pk2(v[4] * rn * g1.x * bflo(z.z), v[5] * rn * g1.y * bfhi(z.z)); o.w = pk2(v[6] * rn * g1.z * bflo(z.w), v[7] * rn * g1.w * bfhi(z.w));
                *(u32x4*)(MIX + (r0 + row) * DMIX + col) = o;
            }
        }
    }
    if (MODE == 0) {
        float* su = SUMH + ((sbase + part) * 2 + hhd) * 16384 + (size_t)(vb * 4) * 1024 + lane;
#pragma unroll
        for (int kt = 0; kt < 4; ++kt)
#pragma unroll
            for (int i = 0; i < 16; ++i) su[kt * 1024 + i * 64] = acc[kt][i];
        if (tid < 256) DTOT[(sbase + part) * 256 + tid] = dprod;
    } else if (part == NPART - 1) {
        float* SP = a.out + O_HP + ((size_t)b * 8 + 2 * hp + hhd) * 128 * 128 + (size_t)(4 * hl) * 128 + 32 * vb + c31;
#pragma unroll
        for (int kt = 0; kt < 4; ++kt)
#pragma unroll
            for (int i = 0; i < 16; ++i) SP[(size_t)(32 * kt + ACCROW0(i)) * 128] = acc[kt][i];
    }
    __syncthreads();
#undef HG_TILE
#undef HG_ISSUE
}

template <int MODE>
__device__ __forceinline__ void p3b_mlstm(const Args& a, LAS unsigned char* lds, int b, int h, int part, int tid, int wave, int lane) {
    constexpr unsigned RS = 528;
    constexpr unsigned OKE = (MODE == 1) ? 33792u : 0u, OV = OKE + 32768u, OA = OV + 32768u;
    constexpr unsigned ON = (MODE == 1) ? OA + 8192u : 131072u, OD = ON + 1024, OBT = OD + 256, ORS = OBT + 256, OCS = ORS + 256, OSTG = OCS + 1024 + 256;
    static_assert(MODE == 0 || OSTG + 64 * RS <= (unsigned)MISC_OFF, "LDS layout");
    const int hl = lane >> 5, c31 = lane & 31;
    const bf16_t* PROJ = (const bf16_t*)(a.ws + WS_PROJ);
    const bf16_t* QM = (const bf16_t*)(a.ws + WS_QM); const bf16_t* KM = (const bf16_t*)(a.ws + WS_KM); const bf16_t* VM = (const bf16_t*)(a.ws + WS_VM); const bf16_t* XC = (const bf16_t*)(a.ws + WS_XC);
    const bf16_t* AM = (const bf16_t*)(a.ws + WS_AM);
    bf16_t* MIX = (bf16_t*)(a.ws + WS_MIX);
    float* SUMM = (float*)(a.ws + WS_SUMM); float* SUMN = (float*)(a.ws + WS_SUMN); float* SUMS = (float*)(a.ws + WS_SUMS);
    f32x16 acc[8];
#pragma unroll
    for (int kt = 0; kt < 8; ++kt)
#pragma unroll
        for (int i = 0; i < 16; ++i) acc[kt][i] = 0.f;
    if (tid < 256) *LDSP(float, ON + tid * 4) = 0.f;
    float mu = 0.f, mrun = (MODE == 0) ? -1e30f : 0.f, bsum = 0.f;
    const size_t sbase = ((size_t)b * 4 + h) * 3;
    if (MODE == 1 && part > 0) {
        float muU[3], Bq[3], Mq[3], cq[3];
#pragma unroll
        for (int q = 0; q < 3; ++q) { const float* s3 = SUMS + (sbase + (q < part ? q : 0)) * 4; muU[q] = s3[0]; Bq[q] = s3[1]; Mq[q] = s3[2]; }
        float sb = 0.f, mus = -1e30f, e[3];
#pragma unroll
        for (int q = 2; q >= 0; --q) { if (q < part) { e[q] = muU[q] + sb; mus = fmaxf(mus, e[q]); sb += Bq[q]; } else e[q] = -1e30f; }
#pragma unroll
        for (int q = 0; q < 3; ++q) { cq[q] = (q < part) ? __expf(e[q] - mus) : 0.f; if (q < part) mrun = fmaxf(mrun + Bq[q], Mq[q]); }
        mu = mus;
        const float* su0 = SUMM + (sbase + 0) * 65536 + (size_t)(wave * 8) * 1024 + lane * 16;
#pragma unroll
        for (int kp = 0; kp < 4; ++kp) {
            f32x4 t[3][2][4];
#pragma unroll
            for (int q = 0; q < 3; ++q) { const float* su = su0 + (size_t)(q < part ? q : 0) * 65536;
#pragma unroll
                for (int k2 = 0; k2 < 2; ++k2)
#pragma unroll
                    for (int g = 0; g < 4; ++g) t[q][k2][g] = *(const f32x4*)(su + (2 * kp + k2) * 1024 + 4 * g); }
#pragma unroll
            for (int k2 = 0; k2 < 2; ++k2)
#pragma unroll
                for (int g = 0; g < 4; ++g)
#pragma unroll
                    for (int e4 = 0; e4 < 4; ++e4) acc[2 * kp + k2][4 * g + e4] = cq[0] * t[0][k2][g][e4] + cq[1] * t[1][k2][g][e4] + cq[2] * t[2][k2][g][e4];
            asm volatile("" : "+v"(acc[2 * kp]), "+v"(acc[2 * kp + 1]) :: "memory");
        }
        if (tid < 256) { float n = 0.f;
#pragma unroll
            for (int q = 0; q < 3; ++q) n += cq[q] * SUMN[(sbase + (q < part ? q : 0)) * 256 + tid];
            *LDSP(float, ON + tid * 4) = n; }
    }
    const unsigned xs_ = (unsigned)((c31 >> 1) & 7);
    const unsigned fb_ = (unsigned)c31 * 128u + (((unsigned)hl ^ (xs_ & 1u)) << 4) + ((xs_ >> 1) << 5);
    unsigned o_perm = lp_perm(lane, RS), o_rowA = OA + fb_, o_trV = OV + 4096u * (unsigned)wave + fb_, o_trK = OKE + fb_;
    unsigned o_st = OSTG + 4u * hl * RS + (32u * wave + c31) * 2u, o_h = 16u * hl;
    const int c_end = (part + 1) * CPP;
    float preRL = 0.f, preC = 0.f, preBL = 0.f;
#define ML_DMA_TILE(gsrc, ldsoff, n) do { const char* g_ = (const char*)(gsrc) + vK; \
        _Pragma("unroll") for (int i_ = 0; i_ < (n); ++i_) __builtin_amdgcn_global_load_lds((const unsigned*)(g_ + i_ * 8192), (LAS unsigned*)(lds + (ldsoff) + i_ * 8192u + 1024u * (unsigned)wave), 16, 0, 0); } while (0)
#define ML_ISSUE(cc, bufo) do { const size_t task_ = ((size_t)b * NCH + (cc)) * 4 + h; \
        const unsigned vK = (unsigned)(tl >> 3) * 128u + ((((unsigned)tl & 7u) ^ (((unsigned)tl >> 4) & 7u)) << 4); \
        ML_DMA_TILE(KM + (task_ << 14), (bufo) + OKE, 4); ML_DMA_TILE(VM + (task_ << 14), (bufo) + OV, 4); \
        if (MODE == 1) { ML_DMA_TILE(AM + task_ * 4096, OA, 1); \
            if (wave < 4) __builtin_amdgcn_global_load_lds((const unsigned*)((const float*)(a.ws + WS_CSK) + task_ * 256 + (tl & 255)), (LAS unsigned*)(lds + OCS + 256u * (unsigned)wave), 4, 0, 0); \
            else if (wave == 4) __builtin_amdgcn_global_load_lds((const unsigned*)((const float*)(a.ws + WS_BT) + task_ * 64 + (tl & 63)), (LAS unsigned*)(lds + OBT), 4, 0, 0); \
            else if (wave == 5) __builtin_amdgcn_global_load_lds((const unsigned*)((const float*)(a.ws + WS_RS) + task_ * 64 + (tl & 63)), (LAS unsigned*)(lds + ORS), 4, 0, 0); \
            _Pragma("unroll") for (int i_ = 0; i_ < 5; ++i_) { if (i_ < 4 || wave == 0) { const unsigned q_ = 512u * i_ + (unsigned)tl, row_ = (q_ * 1986u) >> 16; unsigned cp_ = q_ - 33u * row_; cp_ = cp_ > 31u ? 31u : cp_;   \
                __builtin_amdgcn_global_load_lds((const unsigned*)((const char*)(QM + (task_ << 14)) + (row_ * 32u + cp_) * 16u), (LAS unsigned*)(lds + i_ * 8192u + 1024u * (unsigned)wave), 16, 0, 0); } } } \
        else { preC = ((const float*)(a.ws + WS_CSK))[task_ * 256 + (tl & 255)]; preBL = ((const float*)(a.ws + WS_BT))[task_ * 64 + 63]; } \
        preRL = ((const float*)(a.ws + WS_RL))[task_]; } while (0)
    f32x4 g0 = {0.f, 0.f, 0.f, 0.f}, g1 = g0, k0 = g0, k1 = g0;
    if (MODE == 1) { const int col = h * 256 + 8 * (tid & 31); g0 = *(const f32x4*)(a.mnorm_g + col); g1 = *(const f32x4*)(a.mnorm_g + col + 4); k0 = *(const f32x4*)(a.skip + col); k1 = *(const f32x4*)(a.skip + col + 4);
        asm volatile("" : "+v"(g0), "+v"(g1), "+v"(k0), "+v"(k1)); }
    __syncthreads();
    { int tl = tid; asm volatile("" : "+v"(tl)); ML_ISSUE(part * CPP, 0u); }
    for (int c = part * CPP; c < c_end; ++c) {
        int tl = tid; asm volatile("" : "+v"(tl));
        asm volatile("" : "+v"(o_perm), "+v"(o_rowA), "+v"(o_trV), "+v"(o_trK), "+v"(o_st), "+v"(o_h));
        const size_t r0 = (size_t)b * TP + (size_t)c * 64;
        const size_t task = ((size_t)b * NCH + c) * 4 + h;
        const float R = preRL, cskv = preC, bL0 = preBL;
        if (MODE == 1) {
            if (c == part * CPP) asm volatile("s_waitcnt vmcnt(0)" ::: "memory"); else asm volatile("s_waitcnt vmcnt(4)" ::: "memory");
        } else asm volatile("s_waitcnt vmcnt(0)" ::: "memory");
        asm volatile("s_waitcnt lgkmcnt(0)" ::: "memory");
        __builtin_amdgcn_s_barrier();
        const unsigned bo = (MODE == 0) ? (unsigned)((c - part * CPP) & 1) * 65536u : 0u;
        if (MODE == 0) { if (c + 1 < c_end) ML_ISSUE(c + 1, 65536u - bo); }
        const float sc = __expf(mu - R);
        f32x16 o0, o1; bf16x8 vf[4];
        if (MODE == 1) {
            { const int t = tl >> 3, sub = tl & 7; float p = 0.f;
#pragma unroll
              for (int j = 0; j < 4; ++j) { const u32x4 w = *LDSP(const u32x4, t * RS + (sub * 32 + 8 * j) * 2);
                  const f32x4 n0 = *LDSP(const f32x4, ON + (sub * 32 + 8 * j) * 4), n1 = *LDSP(const f32x4, ON + (sub * 32 + 8 * j + 4) * 4);
                  p += bflo(w.x) * n0.x + bfhi(w.x) * n0.y + bflo(w.y) * n0.z + bfhi(w.y) * n0.w + bflo(w.z) * n1.x + bfhi(w.z) * n1.y + bflo(w.w) * n1.z + bfhi(w.w) * n1.w; }
              p += __shfl_xor(p, 1); p += __shfl_xor(p, 2); p += __shfl_xor(p, 4);
              if (sub == 0) { const float den = fmaxf(fabsf(sc * p + *LDSP(const float, ORS + t * 4)), __expf(-(*LDSP(const float, OBT + t * 4) + R)));
                  *LDSP(float, OD + t * 4) = __builtin_amdgcn_rcpf(den); } }
        }
#pragma unroll
        for (int kt = 0; kt < 8; ++kt)
#pragma unroll
            for (int i = 0; i < 16; ++i) acc[kt][i] *= sc;
        if (MODE == 1) {
#pragma unroll
            for (int i = 0; i < 16; ++i) { o0[i] = 0.f; o1[i] = 0.f; }
#pragma unroll
            for (int kt = 0; kt < 8; ++kt) {
                { const bf16x8 bf = acc_frag<0>(acc[kt]);
                  o0 = MFMA32(frag_perm(lds, o_perm + 64 * kt), bf, o0); o1 = MFMA32(frag_perm(lds, o_perm + 32 * RS + 64 * kt), bf, o1); }
                { const bf16x8 bf = acc_frag<1>(acc[kt]);
                  o0 = MFMA32(frag_perm(lds, o_perm + 64 * kt + 32), bf, o0); o1 = MFMA32(frag_perm(lds, o_perm + 32 * RS + 64 * kt + 32), bf, o1); }
                asm volatile("" : "+v"(o0), "+v"(o1) :: "memory");
            }
        }
#pragma unroll
        for (int js = 0; js < 4; ++js) vf[js] = frag_row(lds, ((o_trV + bo) ^ (32u * js)));
        if (MODE == 1) {
#pragma unroll
            for (int js = 0; js < 4; ++js) { const unsigned oa = o_rowA ^ (32u * js); o0 = MFMA32(frag_row(lds, oa), vf[js], o0); o1 = MFMA32(frag_row(lds, oa + 4096u), vf[js], o1); }
            asm volatile("" : "+v"(o0), "+v"(o1) :: "memory");
        }
        { unsigned okj[4];
#pragma unroll
          for (int js = 0; js < 4; ++js) okj[js] = (o_trK + bo) ^ (32u * js);
#pragma unroll
          for (int kt = 0; kt < 8; ++kt) {
#pragma unroll
            for (int js = 0; js < 4; ++js) acc[kt] = MFMA32(frag_row(lds, okj[js] + 4096u * kt), vf[js], acc[kt]);
            asm volatile("" : "+v"(acc[kt]) :: "memory"); } }
        const float bL = (MODE == 1) ? *LDSP(const float, OBT + 63 * 4) : bL0;
#ifndef RPN
#define RPN 2
#endif
        u32x4 rpm[4], rpz[4], rpx[4];
        if (MODE == 1) {
#pragma unroll
            for (int i = 0; i < RPN; ++i) { const int idx = tl + NTHR * i;
                rpm[i] = *(const u32x4*)(PROJ + ml_tile(6, b, c, h) + idx * 8);
                rpz[i] = *(const u32x4*)(PROJ + ml_tile(5, b, c, h) + idx * 8);
                rpx[i] = *(const u32x4*)(XC + (task << 14) + idx * 8); }
        }
        if (MODE == 0) { if (tl < 256) *LDSP(float, ON + tl * 4) = sc * *LDSP(const float, ON + tl * 4) + cskv; }
        if (MODE == 1) {
            __builtin_amdgcn_sched_barrier(0);
            __syncthreads();
            if (tl < 256) *LDSP(float, ON + tl * 4) = sc * *LDSP(const float, ON + tl * 4) + *LDSP(const float, OCS + tl * 4);
#pragma unroll
            for (int i = 0; i < RPN; ++i) asm volatile("" : "+v"(rpm[i]), "+v"(rpz[i]), "+v"(rpx[i]));
            if (c + 1 < c_end) ML_ISSUE(c + 1, 0u);
#pragma unroll
            for (int g4 = 0; g4 < 4; ++g4) {
                const f32x4 d0 = *LDSP(const f32x4, OD + o_h + 32 * g4), d1 = *LDSP(const f32x4, OD + o_h + 128 + 32 * g4);
#pragma unroll
                for (int e = 0; e < 4; ++e) {
                    *LDSP(bf16_t, o_st + (8 * g4 + e) * RS) = f2bf(o0[4 * g4 + e] * d0[e]);
                    *LDSP(bf16_t, o_st + (32 + 8 * g4 + e) * RS) = f2bf(o1[4 * g4 + e] * d1[e]);
                }
            }
            asm volatile("s_waitcnt lgkmcnt(0)" ::: "memory");
            __builtin_amdgcn_s_barrier();
#define ML_RPLOAD(i, M_, Z_, X_) do { const int idx_ = tl + NTHR * (i); \
                M_ = *(const u32x4*)(PROJ + ml_tile(6, b, c, h) + idx_ * 8); Z_ = *(const u32x4*)(PROJ + ml_tile(5, b, c, h) + idx_ * 8); X_ = *(const u32x4*)(XC + (task << 14) + idx_ * 8); \
                asm volatile("" ::: "memory"); } while (0)
#define ML_ROW(i, MO_, ZZ_, XC_) do { const int idx = tl + NTHR * (i), row = idx >> 5, ch = idx & 31, col = h * 256 + 8 * ch; \
                const u32x4 w = *LDSP(const u32x4, OSTG + row * RS + 16 * ch); \
                float v[8] = {bflo(w.x) * bflo(MO_.x), bfhi(w.x) * bfhi(MO_.x), bflo(w.y) * bflo(MO_.y), bfhi(w.y) * bfhi(MO_.y), bflo(w.z) * bflo(MO_.z), bfhi(w.z) * bfhi(MO_.z), bflo(w.w) * bflo(MO_.w), bfhi(w.w) * bfhi(MO_.w)}; \
                float ss = 0.f; \
                _Pragma("unroll") for (int e = 0; e < 8; ++e) ss += v[e] * v[e]; \
                ss += __shfl_xor(ss, 1); ss += __shfl_xor(ss, 2); ss += __shfl_xor(ss, 4); ss += __shfl_xor(ss, 8); ss += __shfl_xor(ss, 16); \
                const float rn = 1.0f / sqrtf(ss * (1.f / 256.f) + EPS); \
                u32x4 o; \
                o.x = pk2((v[0] * rn * g0.x + k0.x * bflo(XC_.x)) * bflo(ZZ_.x), (v[1] * rn * g0.y + k0.y * bfhi(XC_.x)) * bfhi(ZZ_.x)); \
                o.y = pk2((v[2] * rn * g0.z + k0.z * bflo(XC_.y)) * bflo(ZZ_.y), (v[3] * rn * g0.w + k0.w * bfhi(XC_.y)) * bfhi(ZZ_.y)); \
                o.z = pk2((v[4] * rn * g1.x + k1.x * bflo(XC_.z)) * bflo(ZZ_.z), (v[5] * rn * g1.y + k1.y * bfhi(XC_.z)) * bfhi(ZZ_.z)); \
                o.w = pk2((v[6] * rn * g1.z + k1.z * bflo(XC_.w)) * bflo(ZZ_.w), (v[7] * rn * g1.w + k1.w * bfhi(XC_.w)) * bfhi(ZZ_.w)); \
                *(u32x4*)(MIX + (r0 + row) * DMIX + 1024 + col) = o; } while (0)
            { u32x4 qm, qz, qx, sm, sz, sx;
              ML_RPLOAD(2, qm, qz, qx);
              ML_RPLOAD(3, sm, sz, sx);
              ML_ROW(0, rpm[0], rpz[0], rpx[0]);
              ML_ROW(1, rpm[1], rpz[1], rpx[1]);
              asm volatile("" : "+v"(qm), "+v"(qz), "+v"(qx), "+v"(sm), "+v"(sz), "+v"(sx) :: "memory");
              ML_ROW(2, qm, qz, qx);
              ML_ROW(3, sm, sz, sx); }
#undef ML_ROW
#undef ML_RPLOAD
        }
        mu = bL + R; mrun = bL + fmaxf(mrun, R); bsum += bL;
    }
    __syncthreads();
    if (MODE == 0) {
        float* su = SUMM + (sbase + part) * 65536 + (size_t)(wave * 8) * 1024 + lane * 16;
#pragma unroll
        for (int kt = 0; kt < 8; ++kt)
#pragma unroll
            for (int g = 0; g < 4; ++g) *(f32x4*)(su + kt * 1024 + 4 * g) = (f32x4){acc[kt][4 * g], acc[kt][4 * g + 1], acc[kt][4 * g + 2], acc[kt][4 * g + 3]};
        if (tid < 256) SUMN[(sbase + part) * 256 + tid] = *LDSP(const float, ON + tid * 4);
        if (tid == 0) { float* s3 = SUMS + (sbase + part) * 4; s3[0] = mu; s3[1] = bsum; s3[2] = mrun; }
    } else if (part == NPART - 1) {
        const float fs = __expf(mu - mrun);
        float* CP = a.out + O_CP + ((size_t)b * 4 + h) * 65536 + (size_t)(4 * hl) * 256 + 32 * wave + c31;
#pragma unroll
        for (int kt = 0; kt < 8; ++kt)
#pragma unroll
            for (int i = 0; i < 16; ++i) CP[(size_t)(32 * kt + ACCROW0(i)) * 256] = acc[kt][i] * fs;
        if (tid < 256) a.out[O_NP + ((size_t)b * 4 + h) * 256 + tid] = *LDSP(const float, ON + tid * 4) * fs;
        if (tid == 0) a.out[O_MP + b * 4 + h] = mrun;
    }
    __syncthreads();
#undef ML_ISSUE
#undef ML_DMA_TILE
}

__device__ __forceinline__ void p3b_sample_hgrn(const Args& a, LAS unsigned char* lds, int b, int h, int tid, int wave, int lane) {
    LAS float* sq = (LAS float*)lds; LAS float* sf = sq + 512; LAS float* sk = sf + 512; LAS float* sv = sk + 512;
    LAS float* sPO = sv + 512;
    const bf16_t* PROJ = (const bf16_t*)(a.ws + WS_PROJ) + PS_OFF - (size_t)MP * NPROJ;   const float* LOGFS = (const float*)(a.ws + WS_LOGFS);
    const size_t rb = (size_t)MP + (size_t)b * 4;
    const int vq = tid & 31, kr = tid >> 5;
    const float* S0 = a.st_h + ((size_t)b * 8 + h) * 16384; float* S1 = a.out + O_HS + ((size_t)b * 8 + h) * 16384;
    f32x4 S[8];
#pragma unroll
    for (int i = 0; i < 8; ++i) S[i] = __builtin_nontemporal_load((const f32x4*)(S0 + (size_t)(kr + 16 * i) * 128 + 4 * vq));
    __syncthreads();
    { const int t = tid >> 7, k = tid & 127; const float f = __expf(LOGFS[((size_t)b * 4 + t) * 1024 + h * 128 + k]);
      sf[tid] = f; sk[tid] = 1.f - f; sq[tid] = bf2f(PROJ[(rb + t) * NPROJ + h * 128 + k]); sv[tid] = bf2f(PROJ[(rb + t) * NPROJ + 2048 + h * 128 + k]); }
    __syncthreads();
    f32x4 vv[4], po[4];
#pragma unroll
    for (int t = 0; t < 4; ++t) { vv[t] = *(const LAS f32x4*)(sv + t * 128 + 4 * vq); po[t] = (f32x4){0.f, 0.f, 0.f, 0.f}; }
#pragma unroll
    for (int i = 0; i < 8; ++i) { const int k = kr + 16 * i;
#pragma unroll
        for (int t = 0; t < 4; ++t) { S[i] = S[i] * sf[t * 128 + k] + vv[t] * sk[t * 128 + k]; po[t] += S[i] * sq[t * 128 + k]; }
        __builtin_nontemporal_store(S[i], (f32x4*)(S1 + (size_t)k * 128 + 4 * vq)); }
#pragma unroll
    for (int t = 0; t < 4; ++t) *(LAS f32x4*)(sPO + (kr * 4 + t) * 128 + 4 * vq) = po[t];
    __syncthreads();
    if (wave < 4) { const int t = wave; float o[2]; float ss = 0.f;
#pragma unroll
        for (int j = 0; j < 2; ++j) { const int v = lane + 64 * j; float s = 0.f;
#pragma unroll
            for (int r = 0; r < 16; ++r) s += sPO[(r * 4 + t) * 128 + v];
            o[j] = s; ss += s * s; }
        ss = wave_sum(ss); const float rn = 1.0f / sqrtf(ss * (1.f / 128.f) + EPS);
#pragma unroll
        for (int j = 0; j < 2; ++j) { const int col = h * 128 + lane + 64 * j;
            const float z = bf2f(PROJ[(rb + t) * NPROJ + 3072 + col]);
            ((bf16_t*)(a.ws + WS_MIX))[(rb + t) * DMIX + col] = f2bf(o[j] * rn * a.hnorm_g[col] * z); }
    }
}
__device__ __forceinline__ void p3b_sample_hgrn4(const Args& a, LAS unsigned char* lds, int b, int hq, int tid, int wave, int lane) {
    LAS float* sT = (LAS float*)lds;
    LAS float* sPO = sT + 8192;
    const bf16_t* PROJ = (const bf16_t*)(a.ws + WS_PROJ) + PS_OFF - (size_t)MP * NPROJ; const float* LOGFS = (const float*)(a.ws + WS_LOGFS);
    const size_t rb = (size_t)MP + (size_t)b * 4;
    const int vq = tid & 31, kr = tid >> 5, h0 = 4 * hq;
    const float* S0 = a.st_h + ((size_t)b * 8 + h0) * 16384; float* S1 = a.out + O_HS + ((size_t)b * 8 + h0) * 16384;
    f32x4 S[8], Sn[8];
#pragma unroll
    for (int i = 0; i < 8; ++i) S[i] = __builtin_nontemporal_load((const f32x4*)(S0 + (size_t)(kr + 16 * i) * 128 + 4 * vq));
    float lf[4], qv[4], vvv[4], zr[4][2], gr[4][2];
    { const int t = tid >> 7, k = tid & 127;
#pragma unroll
      for (int hh = 0; hh < 4; ++hh) { const int col = (h0 + hh) * 128 + k;
          lf[hh] = LOGFS[((size_t)b * 4 + t) * 1024 + col]; qv[hh] = bf2f(PROJ[(rb + t) * NPROJ + col]); vvv[hh] = bf2f(PROJ[(rb + t) * NPROJ + 2048 + col]); } }
    { const int t = wave & 3;
#pragma unroll
      for (int hh = 0; hh < 4; ++hh)
#pragma unroll
          for (int j = 0; j < 2; ++j) { const int col = (h0 + hh) * 128 + lane + 64 * j; zr[hh][j] = bf2f(PROJ[(rb + t) * NPROJ + 3072 + col]); gr[hh][j] = a.hnorm_g[col]; } }
    __syncthreads();
#pragma unroll
    for (int hh = 0; hh < 4; ++hh) { const float f = __expf(lf[hh]); LAS float* p = sT + hh * 2048 + tid;
        p[0] = qv[hh]; p[512] = f; p[1024] = 1.f - f; p[1536] = vvv[hh]; }
    __syncthreads();
#pragma unroll
    for (int hh = 0; hh < 4; ++hh) {
        const LAS float* sq = sT + hh * 2048; const LAS float* sf = sq + 512; const LAS float* sk = sf + 512; const LAS float* sv = sk + 512;
        LAS float* po_ = sPO + (hh & 1) * 8192;
        if (hh < 3) {
#pragma unroll
            for (int i = 0; i < 8; ++i) Sn[i] = __builtin_nontemporal_load((const f32x4*)(S0 + (size_t)(hh + 1) * 16384 + (size_t)(kr + 16 * i) * 128 + 4 * vq));
        }
        f32x4 vv[4], po[4];
#pragma unroll
        for (int t = 0; t < 4; ++t) { vv[t] = *(const LAS f32x4*)(sv + t * 128 + 4 * vq); po[t] = (f32x4){0.f, 0.f, 0.f, 0.f}; }
#pragma unroll
        for (int i = 0; i < 8; ++i) { const int k = kr + 16 * i;
#pragma unroll
            for (int t = 0; t < 4; ++t) { S[i] = S[i] * sf[t * 128 + k] + vv[t] * sk[t * 128 + k]; po[t] += S[i] * sq[t * 128 + k]; }
            __builtin_nontemporal_store(S[i], (f32x4*)(S1 + (size_t)hh * 16384 + (size_t)k * 128 + 4 * vq)); }
#pragma unroll
        for (int t = 0; t < 4; ++t) *(LAS f32x4*)(po_ + (kr * 4 + t) * 128 + 4 * vq) = po[t];
        __syncthreads();
        if (wave < 4) { const int t = wave; float o[2]; float ss = 0.f;
#pragma unroll
            for (int j = 0; j < 2; ++j) { const int v = lane + 64 * j; float s_ = 0.f;
#pragma unroll
                for (int r = 0; r < 16; ++r) s_ += po_[(r * 4 + t) * 128 + v];
                o[j] = s_; ss += s_ * s_; }
            ss = wave_sum(ss); const float rn = 1.0f / sqrtf(ss * (1.f / 128.f) + EPS);
#pragma unroll
            for (int j = 0; j < 2; ++j) { const int col = (h0 + hh) * 128 + lane + 64 * j;
                ((bf16_t*)(a.ws + WS_MIX))[(rb + t) * DMIX + col] = f2bf(o[j] * rn * gr[hh][j] * zr[hh][j]); }
        }
        if (hh < 3) {
#pragma unroll
            for (int i = 0; i < 8; ++i) S[i] = Sn[i];
        }
    }
}
__device__ __forceinline__ void p3b_sample_mlstm(const Args& a, LAS unsigned char* lds, int b, int h, int tid, int wave, int lane) {
    LAS float* sxc = (LAS float*)lds; LAS float* sq = sxc + 1024; LAS float* sk = sq + 1024; LAS float* sv = sk + 1024;
    LAS float* sDen = sv + 1024;
    LAS float* sPN = sDen + 16;
    const bf16_t* PROJ = (const bf16_t*)(a.ws + WS_PROJ) + PS_OFF - (size_t)MP * NPROJ;   const float* GATE = (const float*)(a.ws + WS_GATE);
    const size_t rb = (size_t)MP + (size_t)b * 4;
    const int vq = tid & 63, kr = tid >> 6;
    const float* C0 = a.st_C + ((size_t)b * 4 + h) * 65536; float* C1 = a.out + O_CS + ((size_t)b * 4 + h) * 65536;
    f32x4 Ca[8], Cb[8];
#pragma unroll
    for (int i = 0; i < 8; ++i) { Ca[i] = __builtin_nontemporal_load((const f32x4*)(C0 + (size_t)(kr + 8 * i) * 256 + 4 * vq)); Cb[i] = __builtin_nontemporal_load((const f32x4*)(C0 + (size_t)(kr + 8 * (8 + i)) * 256 + 4 * vq)); }
    __syncthreads();
    if (tid < 256) {
        const int t = tid >> 6, g = tid & 63, ch = h * 256 + 4 * g, gg = h * 64 + g;
        float e[4][4];
#pragma unroll
        for (int w = 0; w < 4; ++w) { const int idx = t + w;
            if (idx < 3) { const f32x4 x = *(const f32x4*)(a.st_conv + ((size_t)b * 3 + idx) * 1024 + ch); e[w][0] = x.x; e[w][1] = x.y; e[w][2] = x.z; e[w][3] = x.w; }
            else { const u32x2 x = *(const u32x2*)(PROJ + (rb + idx - 3) * NPROJ + 4096 + ch); e[w][0] = bflo(x.x); e[w][1] = bfhi(x.x); e[w][2] = bflo(x.y); e[w][3] = bfhi(x.y); } }
        float xc[4];
#pragma unroll
        for (int i = 0; i < 4; ++i) { float cv = a.conv_b[ch + i];
#pragma unroll
            for (int w = 0; w < 4; ++w) cv += a.conv_w[w * 1024 + ch + i] * e[w][i];
            xc[i] = cv * sigmoidf_(cv); }
#pragma unroll
        for (int j = 0; j < 4; ++j) { float q = 0.f, k = 0.f, v = 0.f;
#pragma unroll
            for (int i = 0; i < 4; ++i) { q += xc[i] * a.wq[gg * 16 + 4 * i + j]; k += xc[i] * a.wk[gg * 16 + 4 * i + j]; v += e[3][i] * a.wv[gg * 16 + 4 * i + j]; }
            sxc[t * 256 + 4 * g + j] = xc[j]; sq[t * 256 + 4 * g + j] = q; sk[t * 256 + 4 * g + j] = k * 0.0625f; sv[t * 256 + 4 * g + j] = v; }
        if (t == 3) {
#pragma unroll
            for (int j = 0; j < 3; ++j) *(f32x4*)(a.out + O_VS + ((size_t)b * 3 + j) * 1024 + ch) = (f32x4){e[1 + j][0], e[1 + j][1], e[1 + j][2], e[1 + j][3]};
        }
    }
    float fd[4], iw[4], mt[4];
    { float m = a.st_m[b * 4 + h];
#pragma unroll
      for (int t = 0; t < 4; ++t) { const float ig = GATE[(rb + t) * 8 + h], lf = GATE[(rb + t) * 8 + 4 + h]; const float mn = fmaxf(lf + m, ig);
          fd[t] = __expf(lf + m - mn); iw[t] = __expf(ig - mn); mt[t] = mn; m = mn; } }
    __syncthreads();
    if (tid < 256) { float n = a.st_n[((size_t)b * 4 + h) * 256 + tid]; float pd[4];
#pragma unroll
        for (int t = 0; t < 4; ++t) { n = fd[t] * n + iw[t] * sk[t * 256 + tid]; pd[t] = sq[t * 256 + tid] * n; }
        a.out[O_NS + ((size_t)b * 4 + h) * 256 + tid] = n;
#pragma unroll
        for (int t = 0; t < 4; ++t) { const float s = wave_sum(pd[t]); if (lane == 0) sDen[wave * 4 + t] = s; } }
    f32x4 vv[4], pn[4];
#pragma unroll
    for (int t = 0; t < 4; ++t) { vv[t] = *(const LAS f32x4*)(sv + t * 256 + 4 * vq) * iw[t]; pn[t] = (f32x4){0.f, 0.f, 0.f, 0.f}; }
#define SM_BATCH(C, bi, reload) do { \
        _Pragma("unroll") for (int i = 0; i < 8; ++i) { const int k = kr + 8 * (8 * (bi) + i); \
            _Pragma("unroll") for (int t = 0; t < 4; ++t) { C[i] = C[i] * fd[t] + vv[t] * sk[t * 256 + k]; pn[t] += C[i] * sq[t * 256 + k]; } \
            __builtin_nontemporal_store(C[i], (f32x4*)(C1 + (size_t)k * 256 + 4 * vq)); \
            if (reload) C[i] = __builtin_nontemporal_load((const f32x4*)(C0 + (size_t)(kr + 8 * (8 * ((bi) + 2) + i)) * 256 + 4 * vq)); } } while (0)
    SM_BATCH(Ca, 0, true); SM_BATCH(Cb, 1, true); SM_BATCH(Ca, 2, false); SM_BATCH(Cb, 3, false);
#undef SM_BATCH
#pragma unroll
    for (int t = 0; t < 4; ++t) *(LAS f32x4*)(sPN + (kr * 4 + t) * 256 + 4 * vq) = pn[t];
    __syncthreads();
    if (wave < 4) { const int t = wave;
        const float den = sDen[t] + sDen[4 + t] + sDen[8 + t] + sDen[12 + t];
        const float hden = fmaxf(fabsf(den), __expf(-mt[t]));
        float hm[4]; float ss = 0.f;
#pragma unroll
        for (int j = 0; j < 4; ++j) { const int v = lane + 64 * j; float s = 0.f;
#pragma unroll
            for (int r = 0; r < 8; ++r) s += sPN[(r * 4 + t) * 256 + v];
            hm[j] = s / hden * bf2f(PROJ[(rb + t) * NPROJ + 6144 + h * 256 + v]); ss += hm[j] * hm[j]; }
        ss = wave_sum(ss); const float rn = 1.0f / sqrtf(ss * (1.f / 256.f) + EPS);
#pragma unroll
        for (int j = 0; j < 4; ++j) { const int v = lane + 64 * j, col = h * 256 + v;
            const float z = bf2f(PROJ[(rb + t) * NPROJ + 5120 + col]);
            ((bf16_t*)(a.ws + WS_MIX))[(rb + t) * DMIX + 1024 + col] = f2bf((hm[j] * rn * a.mnorm_g[col] + a.skip[col] * sxc[t * 256 + v]) * z); }
        if (t == 3 && lane == 0) a.out[O_MS + b * 4 + h] = mt[3];
    }
}

typedef float f32x4v __attribute__((ext_vector_type(4)));
__device__ __forceinline__ void small_gemm_out(const Args& a, int vcu, int G, int wave, int lane, unsigned* cnt_s) {
    const bf16_t* MIX = (const bf16_t*)(a.ws + WS_MIX); const bf16_t* WoutT = (const bf16_t*)(a.ws + WS_WOUT); const float* MOD = (const float*)(a.ws + WS_MOD);
    const int r = lane & 15, kq = lane >> 4;
    for (int t = vcu * NWAVES + wave; t < 32 * 64; t += G * NWAVES) {
        const int mt = t >> 6, nt = t & 63;
        const bf16_t* ap = MIX + (size_t)(MP + 16 * mt + r) * DMIX + 8 * kq;
        const bf16_t* bp = WoutT + (size_t)(16 * nt + r) * DMIX + 8 * kq;
        f32x4v acc = {0.f, 0.f, 0.f, 0.f};
        bf16x8 af[8], bfr[8], an[8], bn[8];
#pragma unroll
        for (int j = 0; j < 8; ++j) { af[j] = *(const bf16x8*)(ap + 32 * j); bfr[j] = *(const bf16x8*)(bp + 32 * j); }
#pragma unroll 1
        for (int k0 = 0; k0 < DMIX; k0 += 512) {
#pragma unroll
            for (int j = 0; j < 8; ++j) { an[j] = *(const bf16x8*)(ap + k0 + 256 + 32 * j); bn[j] = *(const bf16x8*)(bp + k0 + 256 + 32 * j); }
#pragma unroll
            for (int j = 0; j < 8; ++j) acc = __builtin_amdgcn_mfma_f32_16x16x32_bf16(af[j], bfr[j], acc, 0, 0, 0);
            const int kn = (k0 + 512 < DMIX) ? k0 + 512 : k0;
#pragma unroll
            for (int j = 0; j < 8; ++j) { af[j] = *(const bf16x8*)(ap + kn + 32 * j); bfr[j] = *(const bf16x8*)(bp + kn + 32 * j); }
#pragma unroll
            for (int j = 0; j < 8; ++j) acc = __builtin_amdgcn_mfma_f32_16x16x32_bf16(an[j], bn[j], acc, 0, 0, 0);
        }
        const int col = 16 * nt + r;
#pragma unroll
        for (int i = 0; i < 4; ++i) { const int row = 16 * mt + 4 * kq + i;
            const float g = MOD[(size_t)(BP + (row >> 2)) * 3072 + 2048 + col];
            const float v = a.x_s[(size_t)row * DM + col] + g * acc[i];
            if (cnt_s) store_wt_f32(a.out + O_Y + (size_t)(MP + row) * DM + col, v); else a.out[O_Y + (size_t)(MP + row) * DM + col] = v; }
        if (cnt_s) { asm volatile("s_waitcnt vmcnt(0)" ::: "memory"); if (lane == 0) (void)xb_add(cnt_s + 64 * mt, 1u); }
    }
}
__device__ __forceinline__ void rms_row_inplace(const Args& a, size_t r, int lane) {
    float* yr = a.out + O_Y + r * DM;
    f32x4 v[4]; float s = 0.f;
#pragma unroll
    for (int j = 0; j < 4; ++j) { v[j] = *(const f32x4*)(yr + 4 * lane + 256 * j); s += (v[j].x * v[j].x + v[j].y * v[j].y) + (v[j].z * v[j].z + v[j].w * v[j].w); }
    const float rinv = 1.0f / sqrtf(wave_sum(s) * (1.f / DM) + EPS);
#pragma unroll
    for (int j = 0; j < 4; ++j) { const f32x4 g = *(const f32x4*)(a.final_g + 4 * lane + 256 * j); *(f32x4*)(yr + 4 * lane + 256 * j) = v[j] * rinv * g; }
}

__device__ __forceinline__ void phase5(const Args& a, int vcu, int G, int wave, int lane) {
    const int gw = vcu * NWAVES + wave, NGW = G * NWAVES;
    f32x4 nx[4];
    if (gw < MT) {
#pragma unroll
        for (int j = 0; j < 4; ++j) nx[j] = *(const f32x4*)(a.out + O_Y + (size_t)gw * DM + 4 * lane + 256 * j);
    }
    f32x4 g[4];
#pragma unroll
    for (int j = 0; j < 4; ++j) g[j] = *(const f32x4*)(a.final_g + 4 * lane + 256 * j);
    for (int r = gw; r < MT; r += NGW) {
        float* yr = a.out + O_Y + (size_t)r * DM;
        f32x4 v[4]; float s = 0.f;
#pragma unroll
        for (int j = 0; j < 4; ++j) { v[j] = nx[j]; s += (v[j].x * v[j].x + v[j].y * v[j].y) + (v[j].z * v[j].z + v[j].w * v[j].w); }
        if (r + NGW < MT) {
#pragma unroll
            for (int j = 0; j < 4; ++j) nx[j] = *(const f32x4*)(yr + (size_t)NGW * DM + 4 * lane + 256 * j);
        }
        const float rinv = 1.0f / sqrtf(wave_sum(s) * (1.f / DM) + EPS);
#pragma unroll
        for (int j = 0; j < 4; ++j) *(f32x4*)(yr + 4 * lane + 256 * j) = v[j] * rinv * g[j];
    }
}

__global__ void __launch_bounds__(NTHR, 2) mk_fwd(Args a) {
    extern __shared__ __attribute__((aligned(16))) unsigned char lds_raw[];
    LAS unsigned char* lds = (LAS unsigned char*)lds_raw;
    volatile LAS unsigned* MISC = (volatile LAS unsigned*)(lds + MISC_OFF);
    int tid = threadIdx.x, lane = tid & 63, wave = __builtin_amdgcn_readfirstlane(tid >> 6);
#define RELAUNDER() do { asm volatile("" : "+v"(tid)); lane = tid & 63; wave = __builtin_amdgcn_readfirstlane(tid >> 6); } while (0)
    const int G = gridDim.x; const int bx = blockIdx.x; const int vcu = (G % 8 == 0) ? (bx % 8) * (G / 8) + bx / 8 : bx;
    for (int u = tid; u < (LDS_BYTES - MISC_OFF) / 4; u += NTHR) ((LAS unsigned*)(lds + MISC_OFF))[u] = 0u;
    __syncthreads();
    XcdBarrier bar = xcd_barrier_post((unsigned*)(a.ws + WS_CTL) + CW_BAR, MISC + 8);

    phase0(a, lds, vcu, G, tid, wave, lane);
    xcd_barrier(bar); RELAUNDER();
    phase1(a, lds, vcu, G, tid, wave, lane);
    xcd_barrier(bar); RELAUNDER();
    {
        pg8::Gemm g{(const bf16_t*)(a.ws + WS_XN), (const bf16_t*)(a.ws + WS_WIN), MT, NPROJ, DM};
        pg8::StaticOrder S; S.init(MT, NPROJ, G, bx);
        EpiProj E{(bf16_t*)(a.ws + WS_PROJ), (float*)(a.ws + WS_LOGF), (float*)(a.ws + WS_LOGFS), a.b_in, a.lb_logits};
        pg8::gemm_phase<EpiProj, pg8::StaticOrder, true, true>(lds, g, S, E);
    }
    xcd_barrier(bar); RELAUNDER();
    for (int t = vcu; t < 3072; t += G) {
        RELAUNDER();
        const int tn = -1;
        if (t < 1024) p3a_mlstm(a, lds, t >> 7, (t >> 2) & 31, t & 3, tid, wave, lane, tn);
        else { const int u = t - 1024; p3a_hgrn(a, lds, u >> 8, (u >> 3) & 31, u & 7, tid, wave, lane, tn); }
    }
    xcd_barrier(bar); RELAUNDER();
    const int rid = bx;
    if (rid < 96) { p3b_mlstm<0>(a, lds, rid / 12, (rid / 3) & 3, rid % 3, tid, wave, lane);
        RELAUNDER(); { const int u = 160 + rid; p3b_sample_hgrn4(a, lds, u >> 1, u & 1, tid, wave, lane); } }
    else if (rid < 192) { const int u = rid - 96; p3b_hgrn<0>(a, lds, u / 12, (u / 3) & 3, u % 3, tid, wave, lane);
        RELAUNDER(); { const int t = 128 + u; p3b_sample_mlstm(a, lds, t >> 2, t & 3, tid, wave, lane); } }
    else {
        for (int k = 0; k < 2; ++k) { RELAUNDER(); const int t = (rid - 192) * 2 + k; p3b_sample_mlstm(a, lds, t >> 2, t & 3, tid, wave, lane); }
    }
    xcd_barrier(bar); RELAUNDER();
    if (rid < 128) p3b_mlstm<1>(a, lds, rid >> 4, (rid >> 2) & 3, rid & 3, tid, wave, lane);
    else { const int u = rid - 128; p3b_hgrn<1>(a, lds, u >> 4, (u >> 2) & 3, u & 3, tid, wave, lane); }
    for (;;) {
        RELAUNDER();
        __syncthreads();
        if (tid == 0) MISC[16] = 224u + __hip_atomic_fetch_add((unsigned*)(a.ws + WS_CTL) + CW_QUEUE, 1u, __ATOMIC_RELAXED, __HIP_MEMORY_SCOPE_AGENT);
        __syncthreads();
        const int t = (int)MISC[16];
        if (t >= 672) break;
        if (t < 512) p3b_sample_mlstm(a, lds, t >> 2, t & 3, tid, wave, lane);
        else { const int u = t - 512; p3b_sample_hgrn4(a, lds, u >> 1, u & 1, tid, wave, lane); }
    }
    xcd_barrier(bar); RELAUNDER();
    {
        pg8::Gemm g{(const bf16_t*)(a.ws + WS_MIX), (const bf16_t*)(a.ws + WS_WOUT), MP, DM, DMIX};
        pg8::StaticOrder S; S.init(MP, DM, G, bx);
        unsigned* ctl = (unsigned*)(a.ws + WS_CTL);
        if (G == 256) {
            EpiOutFused E{a.out + O_Y, a.x_p, (const float*)(a.ws + WS_MOD), a.final_g, (float*)(a.ws + WS_STATS), ctl + CW_PANEL};
            pg8::gemm_phase<EpiOutFused, pg8::StaticOrder, true, true>(lds, g, S, E);
            small_gemm_out(a, vcu, G, wave, lane, ctl + CW_SROW);
            { const int t = vcu * NWAVES + wave;
              if ((t & 3) == 0) { unsigned* cs = ctl + CW_SROW + 64 * (t >> 6); unsigned sp = 0;
                  while (xb_ld(cs) < 64u) { __builtin_amdgcn_s_sleep(1); if (++sp > (1u << 20)) break; }
                  __builtin_amdgcn_fence(__ATOMIC_ACQUIRE, "agent"); asm volatile("s_waitcnt vmcnt(0)" ::: "memory");
                  rms_row_inplace(a, (size_t)MP + (t >> 2), lane); } }
        } else {
            EpiOut E{a.out + O_Y, a.x_p, a.x_s, (const float*)(a.ws + WS_MOD)};
            pg8::gemm_phase<EpiOut, pg8::StaticOrder, true, true>(lds, g, S, E);
            small_gemm_out(a, vcu, G, wave, lane, nullptr);
            xcd_barrier(bar); RELAUNDER();
            phase5(a, vcu, G, wave, lane);
        }
    }
}

extern "C" void kernel_launch(void* const* d_in, const int* in_sizes, int n_in, void* d_out, int out_size, void* d_ws, size_t ws_size, hipStream_t stream) {
    static int grid = 0;
    if (grid == 0) {
        if (n_in != 25 || (size_t)out_size != O_END || ws_size < WS_END2) { fprintf(stderr, "kernel_launch: unexpected shapes: n_in %d out %d (want %zu) ws %zu (want %zu)\n", n_in, out_size, (size_t)O_END, ws_size, (size_t)WS_END); grid = -1; return; }
        int dev = 0, cus = 0, per_cu = 0;
        if (hipGetDevice(&dev) != hipSuccess || hipDeviceGetAttribute(&cus, hipDeviceAttributeMultiprocessorCount, dev) != hipSuccess) { grid = -1; return; }
        if (hipFuncSetAttribute((const void*)mk_fwd, hipFuncAttributeMaxDynamicSharedMemorySize, LDS_BYTES) != hipSuccess) { fprintf(stderr, "hipFuncSetAttribute failed\n"); grid = -1; return; }
        if (hipOccupancyMaxActiveBlocksPerMultiprocessor(&per_cu, (const void*)mk_fwd, NTHR, LDS_BYTES) != hipSuccess || per_cu < 1) { fprintf(stderr, "occupancy query: %d\n", per_cu); grid = -1; return; }
        (void)hipGetLastError();
        grid = cus;
    }
    if (grid < 0) return;
    (void)hipMemsetAsync((char*)d_ws + WS_CTL, 0, CTL_ZERO_BYTES, stream);
    Args a{};
    const float** ap = (const float**)&a;
    for (int i = 0; i < 25; ++i) ap[i] = (const float*)d_in[i];
    a.out = (float*)d_out; a.ws = (unsigned char*)d_ws;
    void* args[] = {&a};
    hipError_t e = hipLaunchCooperativeKernel((const void*)mk_fwd, dim3(grid), dim3(NTHR), args, LDS_BYTES, stream);
    if (e != hipSuccess) fprintf(stderr, "cooperative launch failed: %s (grid %d)\n", hipGetErrorString(e), grid);
}
```
